# Optimizing an MI355X kernel written in HIP

```python
import math
import jax, jax.numpy as jnp
from jax import lax
import numpy as np


D_MODEL = 2048
BATCH = 1
SEQ = 16384
DEPTH = 2

N_A_LAYERS = DEPTH // 2
N_B_LAYERS = DEPTH - N_A_LAYERS
N_DENSE = (DEPTH + 1) // 2
N_MOE = DEPTH // 2

POOL_WINDOWS = (2, 4, 8, 16)
N_POOL_GROUPS = len(POOL_WINDOWS)
POOL_GROUP = D_MODEL // N_POOL_GROUPS

N_HEADS = 8
HEAD_DIM = 128
V_HEAD_DIM = 2 * HEAD_DIM
QK_WIDTH = N_HEADS * 2 * HEAD_DIM
V_WIDTH = N_HEADS * V_HEAD_DIM
Q_BLOCK = 128
ROPE_THETA = 10000.0

D_FF = 5632
N_EXPERTS = 8
TOP_K = 2
D_EXPERT = 7168
EXPERT_BLOCK = 512

NORM_EPS = 1e-6
SUBLN_EPS = 1e-5

kernel_name = "yoco_pool_diffattn_moe_hybrid"

F32 = jnp.float32


def rms_norm(x, g, eps=NORM_EPS):
    xf = x.astype(F32)
    y = xf * lax.rsqrt(jnp.mean(xf * xf, axis=-1, keepdims=True) + eps)
    return (y * g.astype(F32)).astype(x.dtype)


def apply_rope(t, positions):
    inv_freq = ROPE_THETA ** (-jnp.arange(0, HEAD_DIM, 2, dtype=F32) / HEAD_DIM)
    ang = positions.astype(F32)[..., None] * inv_freq
    cos = jnp.cos(ang)[:, :, None, None, :]
    sin = jnp.sin(ang)[:, :, None, None, :]
    tf = t.astype(F32)
    t1, t2 = tf[..., : HEAD_DIM // 2], tf[..., HEAD_DIM // 2:]
    out = jnp.concatenate([t1 * cos - t2 * sin, t2 * cos + t1 * sin], axis=-1)
    return out.astype(t.dtype)


def pool_mixer(h, pool_w, pool_scale):
    B, S, D = h.shape
    hg = h.reshape(B, S, N_POOL_GROUPS, POOL_GROUP).astype(F32)
    t_idx = jnp.arange(S)
    pooled = []
    for g, w in enumerate(POOL_WINDOWS):
        c = jnp.cumsum(hg[:, :, g], axis=1)
        prev = jnp.pad(c, ((0, 0), (w, 0), (0, 0)))[:, :S]
        cnt = jnp.minimum(t_idx + 1, w).astype(F32)[None, :, None]
        pooled.append((c - prev) / cnt)
    m = jnp.stack(pooled, axis=2) - hg
    y = jnp.einsum('bsgc,gce->bsge', m.astype(h.dtype), pool_w)
    return y.reshape(B, S, D) * pool_scale


def shared_kv(x, norm_kv, w_k, w_v, positions):
    B, S, _ = x.shape
    h = rms_norm(x, norm_kv)
    k = apply_rope((h @ w_k).reshape(B, S, N_HEADS, 2, HEAD_DIM), positions)
    v = (h @ w_v).reshape(B, S, N_HEADS, V_HEAD_DIM)
    return k, v


def diff_attention(h, k, v, positions, w_q, lq1, lk1, lq2, lk2, subln_w, w_o, lambda_init):
    B, S, _ = h.shape
    q = apply_rope((h @ w_q).reshape(B, S, N_HEADS, 2, HEAD_DIM), positions)
    lam = (jnp.exp(jnp.sum(lq1.astype(F32) * lk1.astype(F32)))
           - jnp.exp(jnp.sum(lq2.astype(F32) * lk2.astype(F32))) + lambda_init)
    nq = S // Q_BLOCK
    q_blocks = q.reshape(B, nq, Q_BLOCK, N_HEADS, 2, HEAD_DIM).transpose(1, 0, 2, 3, 4, 5)
    key_pos = jnp.arange(S)
    scale = HEAD_DIM ** -0.5

    def attend(args):
        qb, bi = args
        s = jnp.einsum('bqhcd,bkhcd->bhcqk', qb, k, preferred_element_type=F32) * scale
        q_pos = bi * Q_BLOCK + jnp.arange(Q_BLOCK)
        s = jnp.where(key_pos[None, :] <= q_pos[:, None], s, -jnp.inf)
        p = jax.nn.softmax(s, axis=-1)
        wts = p[:, :, 0] - lam * p[:, :, 1]
        return jnp.einsum('bhqk,bkhe->bqhe', wts.astype(v.dtype), v)

    o = lax.map(attend, (q_blocks, jnp.arange(nq)))
    o = o.transpose(1, 0, 2, 3, 4).reshape(B, S, N_HEADS, V_HEAD_DIM)
    o = rms_norm(o, subln_w, SUBLN_EPS) * (1.0 - lambda_init)
    return o.reshape(B, S, V_WIDTH) @ w_o


def swiglu(h, w_gate, w_up, w_down):
    return (jax.nn.silu(h @ w_gate) * (h @ w_up)) @ w_down


def moe_swiglu(h, router_w, w_gate, w_up, w_down):
    T, D = h.shape
    logits = (h @ router_w).astype(F32)
    top_logits, top_idx = lax.top_k(logits, TOP_K)
    gates = jax.nn.softmax(top_logits, axis=-1)
    n_assign = T * TOP_K
    flat_e = top_idx.reshape(-1)
    flat_tok = jnp.repeat(jnp.arange(T, dtype=jnp.int32), TOP_K)
    flat_g = gates.reshape(-1)
    order = jnp.argsort(flat_e)
    se, stok, sg = flat_e[order], flat_tok[order], flat_g[order]
    sizes = jnp.bincount(flat_e, length=N_EXPERTS)
    starts = jnp.cumsum(sizes) - sizes
    psizes = (sizes + EXPERT_BLOCK - 1) // EXPERT_BLOCK * EXPERT_BLOCK
    pstarts = jnp.cumsum(psizes) - psizes
    pends = pstarts + psizes
    dest = pstarts[se] + (jnp.arange(n_assign) - starts[se])
    n_blocks = -(-n_assign // EXPERT_BLOCK) + N_EXPERTS
    cap = n_blocks * EXPERT_BLOCK
    tok_pad = jnp.full((cap,), T, dtype=jnp.int32).at[dest].set(stok)
    gate_pad = jnp.zeros((cap,), h.dtype).at[dest].set(sg.astype(h.dtype))
    block_e = jnp.minimum(
        jnp.searchsorted(pends, jnp.arange(n_blocks) * EXPERT_BLOCK, side='right'),
        N_EXPERTS - 1)
    h_pad = jnp.concatenate([h, jnp.zeros((1, D), h.dtype)], axis=0)
    xb = h_pad[tok_pad].reshape(n_blocks, EXPERT_BLOCK, D)

    def expert_block(args):
        xblk, e = args
        return swiglu(xblk, w_gate[e], w_up[e], w_down[e])

    yb = lax.map(expert_block, (xb, block_e)).reshape(cap, D)
    out = jnp.zeros((T + 1, D), h.dtype).at[tok_pad].add(yb * gate_pad[:, None])
    return out[:T]


def setup_inputs(seed: int = 0) -> dict:
    key = jax.random.key(seed)
    ks = jax.random.split(key, 32)

    def w(k, shape, fan_in):
        return jax.random.normal(k, shape, F32) * (fan_in ** -0.5)

    def gain(k, shape, base=1.0, noise=0.02):
        return base + noise * jax.random.normal(k, shape, F32)

    D = D_MODEL
    return {
        "x": jax.random.normal(ks[0], (BATCH, SEQ, D), F32),
        "positions": jnp.broadcast_to(jnp.arange(SEQ, dtype=jnp.int32)[None, :], (BATCH, SEQ)),
        "norm_mix_a": gain(ks[1], (N_A_LAYERS, D)),
        "pool_w": w(ks[2], (N_A_LAYERS, N_POOL_GROUPS, POOL_GROUP, POOL_GROUP), POOL_GROUP),
        "pool_scale": gain(ks[3], (N_A_LAYERS, D), noise=0.1),
        "norm_kv": gain(ks[4], (D,)),
        "w_k": w(ks[5], (D, QK_WIDTH), D),
        "w_v": w(ks[6], (D, V_WIDTH), D),
        "norm_mix_b": gain(ks[7], (N_B_LAYERS, D)),
        "w_q": w(ks[8], (N_B_LAYERS, D, QK_WIDTH), D),
        "lambda_q1": 0.1 * jax.random.normal(ks[9], (N_B_LAYERS, HEAD_DIM), F32),
        "lambda_k1": 0.1 * jax.random.normal(ks[10], (N_B_LAYERS, HEAD_DIM), F32),
        "lambda_q2": 0.1 * jax.random.normal(ks[11], (N_B_LAYERS, HEAD_DIM), F32),
        "lambda_k2": 0.1 * jax.random.normal(ks[12], (N_B_LAYERS, HEAD_DIM), F32),
        "subln_w": gain(ks[13], (N_B_LAYERS, V_HEAD_DIM)),
        "w_o": w(ks[14], (N_B_LAYERS, V_WIDTH, D), V_WIDTH),
        "norm_ffn": gain(ks[15], (DEPTH, D)),
        "dense_w_gate": w(ks[16], (N_DENSE, D, D_FF), D),
        "dense_w_up": w(ks[17], (N_DENSE, D, D_FF), D),
        "dense_w_down": w(ks[18], (N_DENSE, D_FF, D), D_FF),
        "router_w": w(ks[19], (N_MOE, D, N_EXPERTS), D),
        "moe_w_gate": w(ks[20], (N_MOE, N_EXPERTS, D, D_EXPERT), D),
        "moe_w_up": w(ks[21], (N_MOE, N_EXPERTS, D, D_EXPERT), D),
        "moe_w_down": w(ks[22], (N_MOE, N_EXPERTS, D_EXPERT, D), D_EXPERT),
        "norm_final": gain(ks[23], (D,)),
    }


def reference(x, positions, norm_mix_a, pool_w, pool_scale, norm_kv, w_k, w_v,
              norm_mix_b, w_q, lambda_q1, lambda_k1, lambda_q2, lambda_k2, subln_w, w_o,
              norm_ffn, dense_w_gate, dense_w_up, dense_w_down,
              router_w, moe_w_gate, moe_w_up, moe_w_down, norm_final):
    B, S, D = x.shape
    k_shared = None
    v_shared = None
    for layer in range(DEPTH):
        if layer < N_A_LAYERS:
            a = layer
            x = x + pool_mixer(rms_norm(x, norm_mix_a[a]), pool_w[a], pool_scale[a])
        else:
            b = layer - N_A_LAYERS
            if k_shared is None:
                k_shared, v_shared = shared_kv(x, norm_kv, w_k, w_v, positions)
            lambda_init = 0.8 - 0.6 * math.exp(-0.3 * layer)
            x = x + diff_attention(rms_norm(x, norm_mix_b[b]), k_shared, v_shared, positions,
                                   w_q[b], lambda_q1[b], lambda_k1[b], lambda_q2[b],
                                   lambda_k2[b], subln_w[b], w_o[b], lambda_init)
        h = rms_norm(x, norm_ffn[layer])
        if layer % 2 == 0:
            i = layer // 2
            x = x + swiglu(h, dense_w_gate[i], dense_w_up[i], dense_w_down[i])
        else:
            i = layer // 2
            y = moe_swiglu(h.reshape(B * S, D), router_w[i], moe_w_gate[i], moe_w_up[i],
                           moe_w_down[i])
            x = x + y.reshape(B, S, D)
    return rms_norm(x, norm_final)
```

```cpp
#include <hip/hip_runtime.h>
#include <hip/hip_bf16.h>
#include <cstdio>
#include <cstdint>

__device__ __forceinline__ int fresh_lane() { int l; asm volatile("v_mbcnt_lo_u32_b32 %0, -1, 0\n\tv_mbcnt_hi_u32_b32 %0, -1, %0" : "=v"(l)); return l; }

namespace pg8 {
#define PG8_LAS __attribute__((address_space(3)))
typedef unsigned short bf16_t;
typedef short bf16x8 __attribute__((ext_vector_type(8)));
typedef float f32x4 __attribute__((ext_vector_type(4)));
typedef unsigned u32x4 __attribute__((ext_vector_type(4)));
typedef int i32x4 __attribute__((ext_vector_type(4)));
typedef int i32x8 __attribute__((ext_vector_type(8)));
typedef unsigned u32x2 __attribute__((ext_vector_type(2)));
constexpr int BM = 256, BK = 64, HALF = 128, HTB = HALF * BK * 2  , STAGE_BYTES = 8 * HTB, NXCD = 8, WGM = 8;

__host__ __device__ __forceinline__ int lds_byte(int r, int c) { const int st = (r >> 4) * 2 + (c >> 5), rr = r & 15, cc = c & 31, ob = rr * 64 + cc * 2; return st * 1024 + (ob ^ (((ob >> 9) & 1) << 5)); }
__host__ __device__ __forceinline__ void stage_rc(int b, int& R, int& C) { const int st = b / 1024, sb = b % 1024, swz = sb ^ (((sb >> 9) & 1) << 5); R = (st >> 1) * 16 + swz / 64; C = (st & 1) * 32 + (swz % 64) / 2; }
__host__ __device__ __forceinline__ int perm32(int rho) { const int n = rho >> 4, i = rho & 15; return 8 * (i >> 2) + 4 * n + (i & 3); }

struct Unit { int pm, pn, aux; const char* A; const char* B; };

struct GemmOrder {
    int nM, nN, nwg, G, c, ashift, rep; const char* A; const char* B; size_t tstepA, tstepB, astride;
    __device__ __forceinline__ void init(int nM_, int nN_, int G_, int c_, const void* A_, const void* B_, int K, int ashift_, size_t astride_) {
        nM = nM_; nN = nN_; nwg = nM * nN; G = G_; c = c_; A = (const char*)A_; B = (const char*)B_; tstepA = (size_t)BM * K * 2;     tstepB = tstepA; ashift = ashift_; astride = astride_; rep = 1; }
    __device__ __forceinline__ bool next(int i, Unit& u) const {
        const long L = (long)i * G + c; if (L >= (long)nwg * rep) return false;
        int wgid = (int)(L % nwg); { const int q = nwg / NXCD, r = nwg % NXCD, xcd = wgid % NXCD, off = wgid / NXCD; wgid = (xcd < r ? xcd * (q + 1) : r * (q + 1) + (xcd - r) * q) + off; }
        const int nig = WGM * nN, gid = wgid / nig, fm = gid * WGM, gsz = (nM - fm) < WGM ? (nM - fm) : WGM;
        u.pm = fm + ((wgid % nig) % gsz); u.pn = (wgid % nig) / gsz; u.aux = 0;
        u.A = A + (size_t)(u.pn >> ashift) * astride + (size_t)u.pm * tstepA; u.B = B + (size_t)u.pn * tstepB; return true;
    }
    __device__ __forceinline__ void a_ready(const Unit&) const {}
    __device__ __forceinline__ void done(const Unit&) const {}
};
struct MoeOrder {
    int nM, nN, nwg, G, c, rep; int ts[9]; const char* A; const char* B; size_t tstepA, tstepB, estride;
    __device__ __forceinline__ bool next(int i, Unit& u) const {
        const long L = (long)i * G + c; if (L >= (long)nwg * rep) return false;
        int wgid = (int)(L % nwg); { const int q = nwg / NXCD, r = nwg % NXCD, xcd = wgid % NXCD, off = wgid / NXCD; wgid = (xcd < r ? xcd * (q + 1) : r * (q + 1) + (xcd - r) * q) + off; }
        const int nig = WGM * nN, gid = wgid / nig, fm = gid * WGM, gsz = (nM - fm) < WGM ? (nM - fm) : WGM;
        u.pm = fm + ((wgid % nig) % gsz); u.pn = (wgid % nig) / gsz;
        int e = 0;
#pragma unroll
        for (int j = 1; j < 8; ++j) e += (u.pm >= ts[j]) ? 1 : 0;
        u.aux = e;
        u.A = A + (size_t)u.pm * tstepA; u.B = B + (size_t)e * estride + (size_t)u.pn * tstepB; return true;
    }
    __device__ __forceinline__ void a_ready(const Unit&) const {}
    __device__ __forceinline__ void done(const Unit&) const {}
};

struct SplitOrder {
    int R, SK, nsub, G, c, klen; int ts[9]; const char* A; const char* B; size_t tstepA, tstepB, estride;
    __device__ __forceinline__ bool next(int i, Unit& u) const {
        const long L = (long)i * G + c; if (L >= nsub) return false;
        const int sk = (int)(L % SK), unit = (int)(L / SK), rtl = unit >> 3, pm = 128 + rtl;
        int e = 0;
#pragma unroll
        for (int j = 1; j < 8; ++j) e += (pm >= ts[j]) ? 1 : 0;
        u.pm = sk * R + rtl; u.pn = unit & 7; u.aux = e;
        u.A = A + (size_t)pm * tstepA + (size_t)sk * klen; u.B = B + (size_t)e * estride + (size_t)u.pn * tstepB + (size_t)sk * klen; return true;
    }
    __device__ __forceinline__ void a_ready(const Unit&) const {}
    __device__ __forceinline__ void done(const Unit&) const {}
};

__device__ __forceinline__ unsigned cvt_pk_bf16(float lo, float hi) { unsigned r; asm volatile("v_cvt_pk_bf16_f32 %0, %1, %2" : "=v"(r) : "v"(lo), "v"(hi)); return r; }

struct EpiResF32 {
    static constexpr bool PERM = false, AFTER_DRAIN = false;
    const float* base; float* out; int ldc; const float* scale;
    __device__ __forceinline__ void operator()(const f32x4 (&acc)[2][2][4][2], const Unit& u, int wr, int wc, int fr, int fq) const {
        const int row0 = u.pm * BM + wr * 64 + fr, col0 = u.pn * BM + wc * 32 + 4 * fq;
        f32x4 sv[2][2];
#pragma unroll
        for (int bj = 0; bj < 2; ++bj)
#pragma unroll
            for (int n = 0; n < 2; ++n) sv[bj][n] = scale ? *(const f32x4*)(scale + col0 + bj * HALF + n * 16) : (f32x4){1.f, 1.f, 1.f, 1.f};
#pragma unroll
        for (int ai = 0; ai < 2; ++ai)
#pragma unroll
            for (int m = 0; m < 4; ++m) { const size_t off = (size_t)(row0 + ai * HALF + m * 16) * ldc + col0;
#pragma unroll
                for (int bj = 0; bj < 2; ++bj)
#pragma unroll
                    for (int n = 0; n < 2; ++n) { const f32x4 bs = *(const f32x4*)(base + off + bj * HALF + n * 16); *(f32x4*)(out + off + bj * HALF + n * 16) = bs + acc[ai][bj][m][n] * sv[bj][n]; }
                asm volatile("" ::: "memory"); }
    }
};
struct EpiResF32N {
    static constexpr bool PERM = false, AFTER_DRAIN = false;
    const float* base; float* out; int ldc; const float* scale; bf16_t* xb; float* ssp; PG8_LAS float* tab;
    __device__ __forceinline__ void operator()(const f32x4 (&acc)[2][2][4][2], const Unit& u, int wr, int wc, int fr, int fq) const {
        const int row0 = u.pm * BM + wr * 64 + fr, col0 = u.pn * BM + wc * 32 + 4 * fq;
        f32x4 sv[2][2];
#pragma unroll
        for (int bj = 0; bj < 2; ++bj)
#pragma unroll
            for (int n = 0; n < 2; ++n) sv[bj][n] = scale ? *(const f32x4*)(scale + col0 + bj * HALF + n * 16) : (f32x4){1.f, 1.f, 1.f, 1.f};
#pragma unroll
        for (int ai = 0; ai < 2; ++ai)
#pragma unroll
            for (int m = 0; m < 4; ++m) { const int row = row0 + ai * HALF + m * 16; const size_t off = (size_t)row * ldc + col0; float q = 0.f;
#pragma unroll
                for (int bj = 0; bj < 2; ++bj)
#pragma unroll
                    for (int n = 0; n < 2; ++n) { const f32x4 bs = *(const f32x4*)(base + off + bj * HALF + n * 16); const f32x4 v = bs + acc[ai][bj][m][n] * sv[bj][n];
                        *(f32x4*)(out + off + bj * HALF + n * 16) = v; q += (v[0] * v[0] + v[1] * v[1]) + (v[2] * v[2] + v[3] * v[3]);
                        u32x2 w; w.x = cvt_pk_bf16(v[0], v[1]); w.y = cvt_pk_bf16(v[2], v[3]); *(u32x2*)(xb + off + bj * HALF + n * 16) = w; }
                q += __shfl_xor(q, 16); q += __shfl_xor(q, 32);
                if (fq == 0) tab[(ai * HALF + wr * 64 + m * 16 + fr) * 4 + wc] = q;
                asm volatile("" ::: "memory"); }
        asm volatile("s_waitcnt lgkmcnt(0)" ::: "memory"); __builtin_amdgcn_s_barrier(); asm volatile("" ::: "memory");
        const int t = (wr * 4 + wc) * 64 + fq * 16 + fr;
        if (t < BM) { const PG8_LAS f32x4* p = (const PG8_LAS f32x4*)(tab + t * 4); const f32x4 s = *p; ssp[(size_t)(u.pm * BM + t) * 8 + u.pn] = ((s[0] + s[1]) + s[2]) + s[3]; }
    }
};
struct EpiBf16S {
    static constexpr bool PERM = true, AFTER_DRAIN = false;
    bf16_t* O; int ldc; float sc;
    __device__ __forceinline__ void operator()(const f32x4 (&acc)[2][2][4][2], const Unit& u, int wr, int wc, int fr, int fq) const {
        const int row0 = u.pm * BM + wr * 64 + fr, col0 = u.pn * BM + wc * 32 + 8 * fq;
#pragma unroll
        for (int ai = 0; ai < 2; ++ai)
#pragma unroll
            for (int m = 0; m < 4; ++m) { bf16_t* rowp = O + (size_t)(row0 + ai * HALF + m * 16) * ldc + col0;
#pragma unroll
                for (int bj = 0; bj < 2; ++bj) { const f32x4 v0 = acc[ai][bj][m][0] * sc, v1 = acc[ai][bj][m][1] * sc;
                    u32x4 w; w.x = cvt_pk_bf16(v0[0], v0[1]); w.y = cvt_pk_bf16(v0[2], v0[3]); w.z = cvt_pk_bf16(v1[0], v1[1]); w.w = cvt_pk_bf16(v1[2], v1[3]);
                    *(u32x4*)(rowp + bj * HALF) = w; } }
    }
};
struct EpiF32 {
    static constexpr bool PERM = false, AFTER_DRAIN = false;
    float* out; int ldc; float sc;
    __device__ __forceinline__ void operator()(const f32x4 (&acc)[2][2][4][2], const Unit& u, int wr, int wc, int fr, int fq) const {
        const int row0 = u.pm * BM + wr * 64 + fr, col0 = u.pn * BM + wc * 32 + 4 * fq;
#pragma unroll
        for (int ai = 0; ai < 2; ++ai)
#pragma unroll
            for (int m = 0; m < 4; ++m) { float* rowp = out + (size_t)(row0 + ai * HALF + m * 16) * ldc + col0;
#pragma unroll
                for (int bj = 0; bj < 2; ++bj)
#pragma unroll
                    for (int n = 0; n < 2; ++n) *(f32x4*)(rowp + bj * HALF + n * 16) = acc[ai][bj][m][n] * sc; }
    }
};
__device__ __forceinline__ float row_rstd(const float* ssp, int row, float inv_n, float eps) { const f32x4 a = *(const f32x4*)(ssp + (size_t)row * 8), b = *(const f32x4*)(ssp + (size_t)row * 8 + 4);
    return 1.0f / sqrtf((((a[0] + a[1]) + (a[2] + a[3])) + ((b[0] + b[1]) + (b[2] + b[3]))) * inv_n + eps); }
__device__ __forceinline__ float silu_mul(float g, float u) { return g * u * __builtin_amdgcn_rcpf(1.0f + __builtin_amdgcn_exp2f(-1.4426950408889634f * g)); }
struct EpiSwiGLU {
    static constexpr bool PERM = true, AFTER_DRAIN = false;
    bf16_t* O; int ldc; const float* ssp; float inv_n, eps;
    __device__ __forceinline__ void operator()(const f32x4 (&acc)[2][2][4][2], const Unit& u, int wr, int wc, int fr, int fq) const {
        const int row0 = u.pm * BM + wr * 64 + fr, col0 = u.pn * HALF + wc * 32 + 8 * fq;
#pragma unroll
        for (int ai = 0; ai < 2; ++ai)
#pragma unroll
            for (int m = 0; m < 4; ++m) { const int row = row0 + ai * HALF + m * 16; bf16_t* rowp = O + (size_t)row * ldc + col0; const float rs = row_rstd(ssp, row, inv_n, eps);
                const f32x4 g0 = acc[ai][0][m][0] * rs, g1 = acc[ai][0][m][1] * rs, u0 = acc[ai][1][m][0] * rs, u1 = acc[ai][1][m][1] * rs;
                u32x4 w; w.x = cvt_pk_bf16(silu_mul(g0[0], u0[0]), silu_mul(g0[1], u0[1])); w.y = cvt_pk_bf16(silu_mul(g0[2], u0[2]), silu_mul(g0[3], u0[3]));
                w.z = cvt_pk_bf16(silu_mul(g1[0], u1[0]), silu_mul(g1[1], u1[1])); w.w = cvt_pk_bf16(silu_mul(g1[2], u1[2]), silu_mul(g1[3], u1[3]));
                *(u32x4*)rowp = w; }
    }
};
__device__ __forceinline__ unsigned pk4_fp8(float a, float b, float c, float d) {
    a = __builtin_amdgcn_fmed3f(a, -448.f, 448.f); b = __builtin_amdgcn_fmed3f(b, -448.f, 448.f); c = __builtin_amdgcn_fmed3f(c, -448.f, 448.f); d = __builtin_amdgcn_fmed3f(d, -448.f, 448.f);
    int r = __builtin_amdgcn_cvt_pk_fp8_f32(a, b, 0, false); r = __builtin_amdgcn_cvt_pk_fp8_f32(c, d, r, true); return (unsigned)r; }
struct EpiSwiGLU8 {
    static constexpr bool PERM = true, AFTER_DRAIN = false;
    unsigned char* O; int ldc; float sin, sout;
    __device__ __forceinline__ void operator()(const f32x4 (&acc)[2][2][4][2], const Unit& u, int wr, int wc, int fr, int fq) const {
        const int row0 = u.pm * BM + wr * 64 + fr, col0 = u.pn * HALF + wc * 32 + 8 * fq;
#pragma unroll
        for (int ai = 0; ai < 2; ++ai)
#pragma unroll
            for (int m = 0; m < 4; ++m) { unsigned char* rowp = O + (size_t)(row0 + ai * HALF + m * 16) * ldc + col0;
                const f32x4 g0 = acc[ai][0][m][0] * sin, g1 = acc[ai][0][m][1] * sin, u0 = acc[ai][1][m][0] * (sin * sout), u1 = acc[ai][1][m][1] * (sin * sout);
                u32x2 w; w.x = pk4_fp8(silu_mul(g0[0], u0[0]), silu_mul(g0[1], u0[1]), silu_mul(g0[2], u0[2]), silu_mul(g0[3], u0[3]));
                w.y = pk4_fp8(silu_mul(g1[0], u1[0]), silu_mul(g1[1], u1[1]), silu_mul(g1[2], u1[2]), silu_mul(g1[3], u1[3]));
                *(u32x2*)rowp = w; }
    }
};
struct EpiKVQ {
    static constexpr bool PERM = true, AFTER_DRAIN = false;
    bf16_t* K16; bf16_t* V16; bf16_t* Q16; const float* rope; int S; const float* ssp; float inv_n, eps;
    __device__ __forceinline__ void operator()(const f32x4 (&acc)[2][2][4][2], const Unit& u, int wr, int wc, int fr, int fq) const {
        const int row0 = u.pm * BM + wr * 64 + fr;
        const int kind = u.pn >> 3, head = u.pn & 7;
        if (kind == 1) {
#pragma unroll
            for (int ai = 0; ai < 2; ++ai)
#pragma unroll
                for (int m = 0; m < 4; ++m) { const int row = row0 + ai * HALF + m * 16; const float rs = row_rstd(ssp, row, inv_n, eps);
#pragma unroll
                    for (int bj = 0; bj < 2; ++bj) { const f32x4 v0 = acc[ai][bj][m][0] * rs, v1 = acc[ai][bj][m][1] * rs;
                        u32x4 w; w.x = cvt_pk_bf16(v0[0], v0[1]); w.y = cvt_pk_bf16(v0[2], v0[3]); w.z = cvt_pk_bf16(v1[0], v1[1]); w.w = cvt_pk_bf16(v1[2], v1[3]);
                        *(u32x4*)(V16 + ((size_t)head * S + row) * 256 + bj * 128 + wc * 32 + 8 * fq) = w; } }
        } else {
            bf16_t* dst = (kind == 0 ? K16 : Q16) + (size_t)(head * 2 + (wc >> 1)) * S * 128;
            const int d0 = (wc & 1) * 32 + 8 * fq;
#pragma unroll
            for (int ai = 0; ai < 2; ++ai)
#pragma unroll
                for (int m = 0; m < 4; ++m) { const int row = row0 + ai * HALF + m * 16; const float rs = row_rstd(ssp, row, inv_n, eps);
                    const f32x4* cs = (const f32x4*)(rope + ((size_t)row * 64 + d0) * 2);
                    const f32x4 c01 = cs[0], c23 = cs[1], c45 = cs[2], c67 = cs[3];
                    const f32x4 a0 = acc[ai][0][m][0] * rs, a1 = acc[ai][0][m][1] * rs, b0 = acc[ai][1][m][0] * rs, b1 = acc[ai][1][m][1] * rs;
                    float o1[8], o2[8];
                    o1[0] = a0[0] * c01[0] - b0[0] * c01[1]; o2[0] = b0[0] * c01[0] + a0[0] * c01[1];
                    o1[1] = a0[1] * c01[2] - b0[1] * c01[3]; o2[1] = b0[1] * c01[2] + a0[1] * c01[3];
                    o1[2] = a0[2] * c23[0] - b0[2] * c23[1]; o2[2] = b0[2] * c23[0] + a0[2] * c23[1];
                    o1[3] = a0[3] * c23[2] - b0[3] * c23[3]; o2[3] = b0[3] * c23[2] + a0[3] * c23[3];
                    o1[4] = a1[0] * c45[0] - b1[0] * c45[1]; o2[4] = b1[0] * c45[0] + a1[0] * c45[1];
                    o1[5] = a1[1] * c45[2] - b1[1] * c45[3]; o2[5] = b1[1] * c45[2] + a1[1] * c45[3];
                    o1[6] = a1[2] * c67[0] - b1[2] * c67[1]; o2[6] = b1[2] * c67[0] + a1[2] * c67[1];
                    o1[7] = a1[3] * c67[2] - b1[3] * c67[3]; o2[7] = b1[3] * c67[2] + a1[3] * c67[3];
                    u32x4 w1, w2; w1.x = cvt_pk_bf16(o1[0], o1[1]); w1.y = cvt_pk_bf16(o1[2], o1[3]); w1.z = cvt_pk_bf16(o1[4], o1[5]); w1.w = cvt_pk_bf16(o1[6], o1[7]);
                    w2.x = cvt_pk_bf16(o2[0], o2[1]); w2.y = cvt_pk_bf16(o2[2], o2[3]); w2.z = cvt_pk_bf16(o2[4], o2[5]); w2.w = cvt_pk_bf16(o2[6], o2[7]);
                    bf16_t* rp = dst + (size_t)row * 128 + d0;
                    *(u32x4*)rp = w1; *(u32x4*)(rp + 64) = w2; }
        }
    }
};

template <class Epi, class Sched, bool ALIGN_EPI = false, bool SP2 = false, bool F8 = false>
__device__ __forceinline__ void gemm_phase(PG8_LAS unsigned char* lds, const int rowbytes  , const Sched& S, const Epi& E, const int wave_id, const int kbytes = 0  ) {
    const int lane = fresh_lane(), wid = wave_id, tid = wid * 64 + lane, wr = wid >> 2, wc = wid & 3, fr = lane & 15, fq = lane >> 4;
    const int nt = (kbytes ? kbytes : rowbytes) / (BK * 2);
    unsigned voffA[2], voffB[2];
#pragma unroll
    for (int i = 0; i < 2; ++i) { int R, C; stage_rc(tid * 16 + i * 8192, R, C); const int Rb = Epi::PERM ? ((R & ~31) + perm32(R & 31)) : R;
        voffA[i] = (unsigned)(R * rowbytes + C * 2); voffB[i] = (unsigned)(Rb * rowbytes + C * 2); }
    const size_t kstep = (size_t)(BK * 2);
    const size_t hstep = (size_t)HALF * rowbytes;
    const unsigned ldsw = (unsigned)wid * 1024u;
    const int aoff = lds_byte(wr * 64 + fr, fq * 8), boff = lds_byte(wc * 32 + fr, fq * 8);
#define PG8_SA(b, h) (((b) * 2 + (h)) * HTB)
#define PG8_SB(b, h) ((4 + (b) * 2 + (h)) * HTB)
#define PG8_STAGE(bufoff, gbase, voff) do { _Pragma("unroll") for (int _i = 0; _i < 2; ++_i) \
        __builtin_amdgcn_global_load_lds((const unsigned*)((const char*)(gbase) + (voff)[_i]), (PG8_LAS unsigned*)(lds + (bufoff) + ldsw + _i * 8192), 16, 0, 0); } while (0)
#define PG8_LDA(dst, b, h) do { _Pragma("unroll") for (int m = 0; m < 4; ++m) { if constexpr (F8) { dst##8[m] = __builtin_shufflevector(*(const PG8_LAS i32x4*)(lds + PG8_SA(b, h) + aoff + m * 2048), *(const PG8_LAS i32x4*)(lds + PG8_SA(b, h) + aoff + m * 2048 + 1024), 0, 1, 2, 3, 4, 5, 6, 7); } \
        else { _Pragma("unroll") for (int k = 0; k < 2; ++k) dst[m][k] = *(const PG8_LAS bf16x8*)(lds + PG8_SA(b, h) + aoff + m * 2048 + k * 1024); } } } while (0)
#define PG8_LDB(dst, b, h) do { _Pragma("unroll") for (int n = 0; n < 2; ++n) { if constexpr (F8) { dst##8[n] = __builtin_shufflevector(*(const PG8_LAS i32x4*)(lds + PG8_SB(b, h) + boff + n * 2048), *(const PG8_LAS i32x4*)(lds + PG8_SB(b, h) + boff + n * 2048 + 1024), 0, 1, 2, 3, 4, 5, 6, 7); } \
        else { _Pragma("unroll") for (int k = 0; k < 2; ++k) dst[n][k] = *(const PG8_LAS bf16x8*)(lds + PG8_SB(b, h) + boff + n * 2048 + k * 1024); } } } while (0)
#define PG8_MMA(ai, bj, At, Bt) do { __builtin_amdgcn_s_setprio(1); _Pragma("unroll") for (int m = 0; m < 4; ++m) _Pragma("unroll") for (int n = 0; n < 2; ++n) { \
        if constexpr (F8) { asm volatile("v_mfma_scale_f32_16x16x128_f8f6f4 %0, %1, %2, %0, %3, %3 op_sel_hi:[0,0,0]" : "+v"(acc[ai][bj][m][n]) : "v"(Bt##8[n]), "v"(At##8[m]), "v"(sc1)); }     \
        else { _Pragma("unroll") for (int k = 0; k < 2; ++k) acc[ai][bj][m][n] = __builtin_amdgcn_mfma_f32_16x16x32_bf16(Bt[n][k], At[m][k], acc[ai][bj][m][n], 0, 0, 0); } } \
        __builtin_amdgcn_s_setprio(0); } while (0)
#define PG8_WAIT_V(n) asm volatile("s_waitcnt vmcnt(" #n ")" ::: "memory")
#define PG8_WAIT_L(n) asm volatile("s_waitcnt lgkmcnt(" #n ")" ::: "memory")
#define PG8_BAR __builtin_amdgcn_s_barrier()
#define PG8_SCHED __builtin_amdgcn_sched_barrier(0)
    Unit cur, nxt; int ui = 0;
    if (!S.next(0, cur)) return;
    f32x4 acc[2][2][4][2];
#pragma unroll
    for (int a = 0; a < 2; ++a)
#pragma unroll
        for (int b = 0; b < 2; ++b)
#pragma unroll
            for (int m = 0; m < 4; ++m)
#pragma unroll
                for (int n = 0; n < 2; ++n) acc[a][b][m][n] = (f32x4){0.f, 0.f, 0.f, 0.f};
    const int sc1 = 0x7f7f7f7f;
    bf16x8 At[4][2], B0[2][2], B1[2][2]; i32x8 At8[4], B08[2], B18[2];
    const char* cA = cur.A; const char* cB = cur.B;
    S.a_ready(cur);
    if constexpr (SP2) {
        PG8_STAGE(PG8_SB(0, 0), cB, voffB); PG8_STAGE(PG8_SB(0, 1), cB + hstep, voffB); PG8_STAGE(PG8_SA(0, 0), cA, voffA); PG8_STAGE(PG8_SA(0, 1), cA + hstep, voffA);
        if (wr == 1) PG8_BAR;
        PG8_WAIT_V(2); PG8_BAR;
        PG8_STAGE(PG8_SB(1, 0), cB + kstep, voffB); PG8_STAGE(PG8_SA(1, 0), cA + kstep, voffA); PG8_STAGE(PG8_SB(1, 1), cB + hstep + kstep, voffB);
        PG8_WAIT_V(6); PG8_BAR;
    } else {
        PG8_STAGE(PG8_SB(0, 0), cB, voffB); PG8_STAGE(PG8_SA(0, 0), cA, voffA); PG8_STAGE(PG8_SB(0, 1), cB + hstep, voffB); PG8_STAGE(PG8_SA(0, 1), cA + hstep, voffA);
        if (wr == 1) PG8_BAR;
        PG8_WAIT_V(4); PG8_BAR;
        PG8_STAGE(PG8_SB(1, 0), cB + kstep, voffB); PG8_STAGE(PG8_SA(1, 0), cA + kstep, voffA); PG8_STAGE(PG8_SB(1, 1), cB + hstep + kstep, voffB);
        PG8_WAIT_V(6); PG8_BAR;
    }
    for (;;) {
        const bool has_next = S.next(ui + 1, nxt);
        const char* nA = has_next ? nxt.A : cA; const char* nB = has_next ? nxt.B : cB;
        for (int t = 0; t < nt; t += 2) {
            const bool last = (t == nt - 2);
            const char* a1 = cA + (size_t)(t + 1) * kstep;
            const char* a2 = last ? nA : cA + (size_t)(t + 2) * kstep; const char* b2 = last ? nB : cB + (size_t)(t + 2) * kstep;
            const char* a3 = a2 + kstep; const char* b3 = b2 + kstep;
            if (last && has_next) S.a_ready(nxt);
            if constexpr (SP2) {
            PG8_LDB(B0, 0, 0); PG8_LDB(B1, 0, 1); PG8_SCHED; PG8_LDA(At, 0, 0); PG8_STAGE(PG8_SA(1, 1), a1 + hstep, voffA);
            PG8_WAIT_V(8); PG8_WAIT_L(0); PG8_BAR; PG8_MMA(0, 0, At, B0); PG8_MMA(0, 1, At, B1); PG8_BAR; PG8_SCHED;
            PG8_LDA(At, 0, 1); PG8_STAGE(PG8_SB(0, 0), b2, voffB); PG8_STAGE(PG8_SB(0, 1), b2 + hstep, voffB); PG8_STAGE(PG8_SA(0, 0), a2, voffA);
            PG8_WAIT_V(8); PG8_WAIT_L(0); PG8_BAR; PG8_MMA(1, 0, At, B0); PG8_MMA(1, 1, At, B1); PG8_BAR; PG8_SCHED;
            PG8_LDB(B0, 1, 0); PG8_LDB(B1, 1, 1); PG8_SCHED; PG8_LDA(At, 1, 0); PG8_STAGE(PG8_SA(0, 1), a2 + hstep, voffA);
            PG8_WAIT_V(8); PG8_WAIT_L(0); PG8_BAR; PG8_MMA(0, 0, At, B0); PG8_MMA(0, 1, At, B1); PG8_BAR; PG8_SCHED;
            PG8_LDA(At, 1, 1); PG8_STAGE(PG8_SB(1, 0), b3, voffB); PG8_STAGE(PG8_SB(1, 1), b3 + hstep, voffB); PG8_STAGE(PG8_SA(1, 0), a3, voffA);
            PG8_WAIT_V(8); PG8_WAIT_L(0); PG8_BAR; PG8_MMA(1, 0, At, B0); PG8_MMA(1, 1, At, B1); PG8_BAR; PG8_SCHED;
            } else {
            PG8_LDB(B0, 0, 0); PG8_SCHED; PG8_LDA(At, 0, 0); PG8_STAGE(PG8_SA(1, 1), a1 + hstep, voffA);
            PG8_WAIT_L(8); PG8_BAR; PG8_WAIT_L(0); PG8_MMA(0, 0, At, B0); PG8_BAR; PG8_SCHED;
            PG8_LDB(B1, 0, 1); PG8_STAGE(PG8_SB(0, 0), b2, voffB);
            PG8_BAR; PG8_WAIT_L(0); PG8_MMA(0, 1, At, B1); PG8_BAR;
            PG8_LDA(At, 0, 1); PG8_STAGE(PG8_SA(0, 0), a2, voffA);
            PG8_BAR; PG8_WAIT_L(0); PG8_MMA(1, 0, At, B0); PG8_BAR; PG8_SCHED;
            PG8_STAGE(PG8_SB(0, 1), b2 + hstep, voffB);
            PG8_WAIT_V(6); PG8_BAR; PG8_MMA(1, 1, At, B1); PG8_BAR;
            PG8_LDB(B0, 1, 0); PG8_SCHED; PG8_LDA(At, 1, 0); PG8_STAGE(PG8_SA(0, 1), a2 + hstep, voffA);
            PG8_WAIT_L(8); PG8_BAR; PG8_WAIT_L(0); PG8_MMA(0, 0, At, B0); PG8_BAR; PG8_SCHED;
            PG8_LDB(B1, 1, 1); PG8_STAGE(PG8_SB(1, 0), b3, voffB);
            PG8_BAR; PG8_WAIT_L(0); PG8_MMA(0, 1, At, B1); PG8_BAR;
            PG8_LDA(At, 1, 1); PG8_STAGE(PG8_SA(1, 0), a3, voffA);
            PG8_BAR; PG8_WAIT_L(0); PG8_MMA(1, 0, At, B0); PG8_BAR; PG8_SCHED;
            PG8_STAGE(PG8_SB(1, 1), b3 + hstep, voffB);
            PG8_WAIT_V(6); PG8_BAR; PG8_MMA(1, 1, At, B1); PG8_BAR;
            }
        }
        if constexpr (ALIGN_EPI) { if (wr == 0) PG8_BAR; }
        if constexpr (F8) { asm volatile("s_nop 15\n\ts_nop 15" ::: "memory"); }
        if constexpr (!Epi::AFTER_DRAIN) { const int le_ = fresh_lane(); E(acc, cur, wr, wc, le_ & 15, le_ >> 4); S.done(cur); }
        if (!has_next) break;
#pragma unroll
        for (int a = 0; a < 2; ++a)
#pragma unroll
            for (int b = 0; b < 2; ++b)
#pragma unroll
                for (int m = 0; m < 4; ++m)
#pragma unroll
                    for (int n = 0; n < 2; ++n) acc[a][b][m][n] = (f32x4){0.f, 0.f, 0.f, 0.f};
        if constexpr (F8) { asm volatile("s_nop 7" ::: "memory"); }
        cur = nxt; cA = nA; cB = nB; ++ui;
        if constexpr (ALIGN_EPI) { if (wr == 1) PG8_BAR; }
    }
    PG8_WAIT_V(0);
    if constexpr (!ALIGN_EPI) { if (wr == 0) PG8_BAR; }
    PG8_BAR;
    if constexpr (Epi::AFTER_DRAIN) { E.fused(acc, cur, wr, wc, fr, fq, lds, wid, lane); S.done(cur); }
#undef PG8_SA
#undef PG8_SB
#undef PG8_STAGE
#undef PG8_LDA
#undef PG8_LDB
#undef PG8_MMA
#undef PG8_WAIT_V
#undef PG8_WAIT_L
#undef PG8_BAR
#undef PG8_SCHED
}

}

namespace attn {
constexpr int D = 128; constexpr float THR = 8.f; constexpr bool WSKIP = false;
constexpr float SCALE = 0.08838834764831845f;
constexpr int NW = 8, QBLK = 32, KVBLK = 64, QB = NW * QBLK;
constexpr int DV = 256;
constexpr int SHM_V = KVBLK * DV * 2, SHM_K = KVBLK * D * 2;
constexpr int LDS_BYTES = 2 * SHM_V + 2 * SHM_K + NW * 64 * 4;

using bf16 = __hip_bfloat16;
typedef short bf16x8 __attribute__((ext_vector_type(8)));
typedef short s16x4 __attribute__((ext_vector_type(4)));
typedef float f32x16 __attribute__((ext_vector_type(16)));
typedef float f32x4 __attribute__((ext_vector_type(4)));
typedef unsigned u32x4 __attribute__((ext_vector_type(4)));
template <class A, class Bt> struct same_t { static constexpr bool v = false; };
template <class A> struct same_t<A, A> { static constexpr bool v = true; };

#define KSWZ(row, colB) ((row) * 256 + ((colB) ^ (((row) & 7) << 4)))
#define SBAR() __builtin_amdgcn_sched_barrier(0)
__device__ __forceinline__ int v_st(int k, int c) { const int kk = (k & ~0xC) | ((k & 4) << 1) | ((k & 8) >> 1); return ((kk >> 3) * 4 + (c >> 5)) * 512 + ((kk & 7) * 32 + (c & 31)) * 2; }
__device__ __forceinline__ int v_rd_base(int lane) { return ((lane & 3) << 3) | (((lane >> 2) & 3) << 6) | (((lane >> 4) & 1) << 5) | (((lane >> 5) & 1) << 8); }
constexpr int v_rd_off(int d0, int ks, int half) { return d0 * 512 + ks * 4096 + half * 2048; }
__device__ __forceinline__ int crow(int r, int hi) { return (r & 3) + 8 * (r >> 2) + 4 * hi; }
__device__ __forceinline__ unsigned cvtpk(float lo, float hi) {
    unsigned r; asm volatile("v_cvt_pk_bf16_f32 %0, %1, %2" : "=v"(r) : "v"(lo), "v"(hi)); return r;
}
__device__ __forceinline__ bf16x8 pack8(f32x4 a, f32x4 b) {
    u32x4 w = {cvtpk(a[0], a[1]), cvtpk(a[2], a[3]), cvtpk(b[0], b[1]), cvtpk(b[2], b[3])};
    return *reinterpret_cast<bf16x8*>(&w);
}
template <class T> __device__ __forceinline__ bf16x8 load8(const T* p) {
    if constexpr (same_t<T, float>::v) { return pack8(*(const f32x4*)p, *(const f32x4*)(p + 4)); }
    else { return *reinterpret_cast<const bf16x8*>(p); }
}
__device__ __forceinline__ void mask_tile(f32x16& p0, f32x16& p1, int dq, unsigned W) {
    const float NEG = -__builtin_inff();
#pragma unroll
    for (int r = 0; r < 16; ++r) {
        const int c = (r & 3) + 8 * (r >> 2);
        if ((unsigned)(dq - c) >= W) p0[r] = NEG;
        if ((unsigned)(dq - c - 32) >= W) p1[r] = NEG;
    }
}
__device__ __forceinline__ void partialSM(f32x16& p0, f32x16& p1, float& m_reg, float& mn, float& alpha) {
    float pmax = p0[0]; for (int r = 1; r < 16; ++r) pmax = fmaxf(pmax, p0[r]); for (int r = 0; r < 16; ++r) pmax = fmaxf(pmax, p1[r]);
    { auto rr = __builtin_amdgcn_permlane32_swap(__float_as_uint(pmax), __float_as_uint(pmax), false, false);
      pmax = fmaxf(__uint_as_float(rr[0]), __uint_as_float(rr[1])); }
    constexpr float C2 = 1.4426950408889634f * SCALE;
    if (__builtin_expect(__all((pmax - m_reg) * SCALE <= THR), 1)) { mn = m_reg; alpha = 1.f; }
    else { mn = fmaxf(m_reg, pmax); alpha = __builtin_amdgcn_exp2f((m_reg - mn) * C2); m_reg = mn; }
    const float mnL = -mn * C2;
    for (int r = 0; r < 16; ++r) p0[r] = fmaf(p0[r], C2, mnL); for (int r = 0; r < 16; ++r) p1[r] = fmaf(p1[r], C2, mnL);
    for (int r = 0; r < 16; ++r) p0[r] = __builtin_amdgcn_exp2f(p0[r]);
}
__device__ __forceinline__ void finishSM(f32x16& p0, f32x16& p1, float alpha, float& l_reg, bf16x8& pa0, bf16x8& pa1, bf16x8& pa2, bf16x8& pa3) {
    for (int r = 0; r < 16; ++r) p1[r] = __builtin_amdgcn_exp2f(p1[r]);
    float ps = 0; for (int r = 0; r < 16; ++r) ps += p0[r]; for (int r = 0; r < 16; ++r) ps += p1[r];
    { auto rr = __builtin_amdgcn_permlane32_swap(__float_as_uint(ps), __float_as_uint(ps), false, false);
      ps = __uint_as_float(rr[0]) + __uint_as_float(rr[1]); }
    l_reg = l_reg * alpha + ps;
#define PK4(P, B_, OUT) do { unsigned a0 = cvtpk(P[B_+0], P[B_+1]), a1 = cvtpk(P[B_+2], P[B_+3]);                          \
        unsigned b0 = cvtpk(P[B_+4], P[B_+5]), b1 = cvtpk(P[B_+6], P[B_+7]);                                             \
        auto r0 = __builtin_amdgcn_permlane32_swap(a0, b0, false, false); auto r1 = __builtin_amdgcn_permlane32_swap(a1, b1, false, false); \
        u32x4 w = {r0[0], r1[0], r0[1], r1[1]}; OUT = *reinterpret_cast<bf16x8*>(&w); } while (0)
    PK4(p0, 0, pa0); PK4(p0, 8, pa1); PK4(p1, 0, pa2); PK4(p1, 8, pa3);
#undef PK4
}
template <int KB, bool SK>
__device__ __forceinline__ void qkt(f32x16& p0, f32x16& p1, const char* K_lds, int r32, int hi, const bf16x8* qr, bool act) {
    if (SK && !act) { const float NEG = -__builtin_inff();
#pragma unroll
        for (int r = 0; r < 16; ++r) { p0[r] = NEG; p1[r] = NEG; } return; }
    p0 = f32x16{}; p1 = f32x16{};
    const char* kb[4];
#pragma unroll
    for (int dd = 0; dd < 4; ++dd) kb[dd] = K_lds + KB * SHM_K + KSWZ(r32, (dd * 16 + hi * 8) * 2);
#pragma unroll
    for (int d0 = 0; d0 < 8; ++d0) { const char* a = kb[d0 & 3] + (d0 >> 2) * 128;
        bf16x8 b0 = *reinterpret_cast<const bf16x8*>(a);
        bf16x8 b1 = *reinterpret_cast<const bf16x8*>(a + 32 * 256);
        p0 = __builtin_amdgcn_mfma_f32_32x32x16_bf16(b0, qr[d0], p0, 0, 0, 0);
        p1 = __builtin_amdgcn_mfma_f32_32x32x16_bf16(b1, qr[d0], p1, 0, 0, 0); }
}


#define AT2_LAS __attribute__((address_space(3)))
template <int VB>
__device__ __forceinline__ void pv_tile8(f32x16* o, const AT2_LAS char* vb, bf16x8 pa0, bf16x8 pa1, bf16x8 pa2, bf16x8 pa3) {
#define TRR(off) __builtin_amdgcn_ds_read_tr16_b64_v4i16((AT2_LAS s16x4*)(vb + (off)))
#pragma unroll
    for (int d0 = 0; d0 < 8; ++d0) { const int b_ = VB * SHM_V + d0 * 512;
        const s16x4 l0 = TRR(b_), h0 = TRR(b_ + 4096), l1 = TRR(b_ + 8192), h1 = TRR(b_ + 12288), l2 = TRR(b_ + 16384), h2 = TRR(b_ + 20480), l3 = TRR(b_ + 24576), h3 = TRR(b_ + 28672);
        o[d0] = __builtin_amdgcn_mfma_f32_32x32x16_bf16(pa0, (bf16x8){l0[0], l0[1], l0[2], l0[3], h0[0], h0[1], h0[2], h0[3]}, o[d0], 0, 0, 0);
        o[d0] = __builtin_amdgcn_mfma_f32_32x32x16_bf16(pa1, (bf16x8){l1[0], l1[1], l1[2], l1[3], h1[0], h1[1], h1[2], h1[3]}, o[d0], 0, 0, 0);
        o[d0] = __builtin_amdgcn_mfma_f32_32x32x16_bf16(pa2, (bf16x8){l2[0], l2[1], l2[2], l2[3], h2[0], h2[1], h2[2], h2[3]}, o[d0], 0, 0, 0);
        o[d0] = __builtin_amdgcn_mfma_f32_32x32x16_bf16(pa3, (bf16x8){l3[0], l3[1], l3[2], l3[3], h3[0], h3[1], h3[2], h3[3]}, o[d0], 0, 0, 0); }
#undef TRR
}
__device__ __forceinline__ void softmax_main(f32x16& p0, f32x16& p1, float& m_reg, float& alpha, float& ps) {
    float pmax = p0[0];
#pragma unroll
    for (int r = 1; r < 16; ++r) pmax = fmaxf(pmax, p0[r]);
#pragma unroll
    for (int r = 0; r < 16; ++r) pmax = fmaxf(pmax, p1[r]);
    { auto rr = __builtin_amdgcn_permlane32_swap(__float_as_uint(pmax), __float_as_uint(pmax), false, false);
      pmax = fmaxf(__uint_as_float(rr[0]), __uint_as_float(rr[1])); }
    constexpr float C2 = 1.4426950408889634f * SCALE;
    const bool keep = __all((pmax - m_reg) * SCALE <= THR);
    const float mn = keep ? m_reg : fmaxf(m_reg, pmax);
    alpha = __builtin_amdgcn_exp2f((m_reg - mn) * C2);
    m_reg = mn;
    const float mnL = -mn * C2;
#pragma unroll
    for (int r = 0; r < 16; ++r) { p0[r] = __builtin_amdgcn_exp2f(fmaf(p0[r], C2, mnL)); p1[r] = __builtin_amdgcn_exp2f(fmaf(p1[r], C2, mnL)); }
    float s = 0.f;
#pragma unroll
    for (int r = 0; r < 16; ++r) s += p0[r];
#pragma unroll
    for (int r = 0; r < 16; ++r) s += p1[r];
    { auto rr = __builtin_amdgcn_permlane32_swap(__float_as_uint(s), __float_as_uint(s), false, false);
      ps = __uint_as_float(rr[0]) + __uint_as_float(rr[1]); }
}
__device__ __forceinline__ void pack_p(const f32x16& p0, const f32x16& p1, bf16x8& pa0, bf16x8& pa1, bf16x8& pa2, bf16x8& pa3) {
#define PK4(P, B_, OUT) do { unsigned a0 = cvtpk(P[B_+0], P[B_+1]), a1 = cvtpk(P[B_+2], P[B_+3]);                          \
        unsigned b0 = cvtpk(P[B_+4], P[B_+5]), b1 = cvtpk(P[B_+6], P[B_+7]);                                             \
        auto r0 = __builtin_amdgcn_permlane32_swap(a0, b0, false, false); auto r1 = __builtin_amdgcn_permlane32_swap(a1, b1, false, false); \
        u32x4 w = {r0[0], r1[0], r0[1], r1[1]}; OUT = *reinterpret_cast<bf16x8*>(&w); } while (0)
    PK4(p0, 0, pa0); PK4(p0, 8, pa1); PK4(p1, 0, pa2); PK4(p1, 8, pa3);
#undef PK4
}
struct Block2 { const bf16* Q; const bf16* K; const bf16* V; unsigned short* O; int P0; };
__device__ __forceinline__ void attn_block2(const Block2& cur, char* lds, AT2_LAS unsigned char* L, const int wave_id) {
    const int lane = fresh_lane(), wid = wave_id, r32 = lane & 31, hi = lane >> 5;
    const int NT = (cur.P0 + QB - 1) / KVBLK + 1;
    const int qlo = cur.P0 + wid * QBLK;
    char* K_lds = lds + 2 * SHM_V;
    float* ws = (float*)(lds + 2 * SHM_V + 2 * SHM_K) + wid * 64; float* li_l = ws, * al_l = ws + 32;
#define AT2_GLDS(g, l) __builtin_amdgcn_global_load_lds((const unsigned*)(g), (AT2_LAS unsigned*)(l), 16, 0, 0)
#define AT2_DMA_K(t, b) do { const char* kg_ = (const char*)cur.K + (size_t)(t) * (KVBLK * D * 2); const unsigned ln_ = (unsigned)fresh_lane(), kr0 = 8u * wid + (ln_ >> 4), kr1 = kr0 + 4u; \
        const unsigned koff0 = kr0 * 256u + (((ln_ & 15u) ^ (kr0 & 7u)) << 4), koff1 = kr1 * 256u + (((ln_ & 15u) ^ (kr1 & 7u)) << 4); \
        AT2_GLDS(kg_ + koff0, L + 2 * SHM_V + (b) * SHM_K + (2 * wid) * 1024); AT2_GLDS(kg_ + koff1, L + 2 * SHM_V + (b) * SHM_K + (2 * wid + 1) * 1024); } while (0)
#define AT2_DMA_V(t, b) do { const char* vg_ = (const char*)cur.V + (size_t)(t) * (KVBLK * DV * 2); const unsigned ln_ = (unsigned)fresh_lane(), kkv = 8u * wid + ((ln_ & 31u) >> 2); \
        const unsigned keyv = (kkv & ~0xCu) | ((kkv & 4u) << 1) | ((kkv & 8u) >> 1), voff = keyv * 512u + (ln_ >> 5) * 64u + (ln_ & 3u) * 16u; \
        _Pragma("unroll") for (int i_ = 0; i_ < 4; ++i_) AT2_GLDS(vg_ + i_ * 128 + voff, L + (b) * SHM_V + (4 * wid + i_) * 1024); } while (0)
    bf16x8 qr[8];
#pragma unroll
    for (int d0 = 0; d0 < 8; ++d0) qr[d0] = load8<bf16>(cur.Q + (size_t)(wid * QBLK + r32) * D + d0 * 16 + hi * 8);
    AT2_DMA_K(0, 0);
    float m_reg = -1e30f, l_reg = 0; f32x16 o[8] = {};
    f32x16 p0, p1; float al, ps; bf16x8 pa0, pa1, pa2, pa3;
#define RESC(a) do { if (__any((a) < 1.f)) { const int lr_ = fresh_lane(), hr_ = lr_ >> 5; if (hr_ == 0) al_l[lr_ & 31] = (a); asm volatile("s_waitcnt lgkmcnt(0)" ::: "memory");              \
                     for (int d_ = 0; d_ < 8; ++d_) for (int r = 0; r < 16; ++r) o[d_][r] *= al_l[crow(r, hr_)]; } } while (0)
#define AT2_TRR(off) __builtin_amdgcn_ds_read_tr16_b64_v4i16((AT2_LAS s16x4*)(vb + (off)))
#define MX3(a_, b_, c_) fmaxf(fmaxf((a_), (b_)), (c_))
#define AT2_PV_SM(VB) do { const AT2_LAS char* vb = (const AT2_LAS char*)L + v_rd_base(fresh_lane()); constexpr float C2_ = 1.4426950408889634f * SCALE; float mxa, mxb, mnL_; ps = 0.f; s16x4 fl0, fh0, fl1, fh1, fl2, fh2, fl3, fh3; \
        constexpr int vbo_ = (VB) * SHM_V; \
        fl0 = AT2_TRR(vbo_ + 0); fh0 = AT2_TRR(vbo_ + 4096); \
        fl1 = AT2_TRR(vbo_ + 8192); fh1 = AT2_TRR(vbo_ + 12288); \
        fl2 = AT2_TRR(vbo_ + 16384); fh2 = AT2_TRR(vbo_ + 20480); \
        fl3 = AT2_TRR(vbo_ + 24576); fh3 = AT2_TRR(vbo_ + 28672); \
        SBAR(); \
        o[0] = __builtin_amdgcn_mfma_f32_32x32x16_bf16(pa0, (bf16x8){fl0[0], fl0[1], fl0[2], fl0[3], fh0[0], fh0[1], fh0[2], fh0[3]}, o[0], 0, 0, 0); fl0 = AT2_TRR(vbo_ + 512); fh0 = AT2_TRR(vbo_ + 4608); mxa = MX3(p0[0], p0[1], p0[2]); mxb = MX3(p1[0], p1[1], p1[2]); mxa = MX3(mxa, p0[3], p0[4]); mxb = MX3(mxb, p1[3], p1[4]); SBAR(); \
        o[0] = __builtin_amdgcn_mfma_f32_32x32x16_bf16(pa1, (bf16x8){fl1[0], fl1[1], fl1[2], fl1[3], fh1[0], fh1[1], fh1[2], fh1[3]}, o[0], 0, 0, 0); fl1 = AT2_TRR(vbo_ + 8704); fh1 = AT2_TRR(vbo_ + 12800); mxa = MX3(mxa, p0[5], p0[6]); mxb = MX3(mxb, p1[5], p1[6]); mxa = MX3(mxa, p0[7], p0[8]); mxb = MX3(mxb, p1[7], p1[8]); SBAR(); \
        o[0] = __builtin_amdgcn_mfma_f32_32x32x16_bf16(pa2, (bf16x8){fl2[0], fl2[1], fl2[2], fl2[3], fh2[0], fh2[1], fh2[2], fh2[3]}, o[0], 0, 0, 0); fl2 = AT2_TRR(vbo_ + 16896); fh2 = AT2_TRR(vbo_ + 20992); mxa = MX3(mxa, p0[9], p0[10]); mxb = MX3(mxb, p1[9], p1[10]); mxa = MX3(mxa, p0[11], p0[12]); mxb = MX3(mxb, p1[11], p1[12]); SBAR(); \
        o[0] = __builtin_amdgcn_mfma_f32_32x32x16_bf16(pa3, (bf16x8){fl3[0], fl3[1], fl3[2], fl3[3], fh3[0], fh3[1], fh3[2], fh3[3]}, o[0], 0, 0, 0); fl3 = AT2_TRR(vbo_ + 25088); fh3 = AT2_TRR(vbo_ + 29184); mxa = MX3(mxa, p0[13], p0[14]); mxb = MX3(mxb, p1[13], p1[14]); mxa = fmaxf(mxa, p0[15]); mxb = fmaxf(mxb, p1[15]); SBAR(); \
        o[1] = __builtin_amdgcn_mfma_f32_32x32x16_bf16(pa0, (bf16x8){fl0[0], fl0[1], fl0[2], fl0[3], fh0[0], fh0[1], fh0[2], fh0[3]}, o[1], 0, 0, 0); fl0 = AT2_TRR(vbo_ + 1024); fh0 = AT2_TRR(vbo_ + 5120); mxa = fmaxf(mxa, mxb); { auto rr_ = __builtin_amdgcn_permlane32_swap(__float_as_uint(mxa), __float_as_uint(mxa), false, false); mxa = fmaxf(__uint_as_float(rr_[0]), __uint_as_float(rr_[1])); } SBAR(); \
        o[1] = __builtin_amdgcn_mfma_f32_32x32x16_bf16(pa1, (bf16x8){fl1[0], fl1[1], fl1[2], fl1[3], fh1[0], fh1[1], fh1[2], fh1[3]}, o[1], 0, 0, 0); fl1 = AT2_TRR(vbo_ + 9216); fh1 = AT2_TRR(vbo_ + 13312); { const bool keep_ = __all((mxa - m_reg) * SCALE <= THR); const float mn_ = keep_ ? m_reg : fmaxf(m_reg, mxa); al = __builtin_amdgcn_exp2f((m_reg - mn_) * C2_); m_reg = mn_; mnL_ = -mn_ * C2_; } SBAR(); \
        o[1] = __builtin_amdgcn_mfma_f32_32x32x16_bf16(pa2, (bf16x8){fl2[0], fl2[1], fl2[2], fl2[3], fh2[0], fh2[1], fh2[2], fh2[3]}, o[1], 0, 0, 0); fl2 = AT2_TRR(vbo_ + 17408); fh2 = AT2_TRR(vbo_ + 21504); p0[0] = __builtin_amdgcn_exp2f(fmaf(p0[0], C2_, mnL_)); p0[1] = __builtin_amdgcn_exp2f(fmaf(p0[1], C2_, mnL_)); SBAR(); \
        o[1] = __builtin_amdgcn_mfma_f32_32x32x16_bf16(pa3, (bf16x8){fl3[0], fl3[1], fl3[2], fl3[3], fh3[0], fh3[1], fh3[2], fh3[3]}, o[1], 0, 0, 0); fl3 = AT2_TRR(vbo_ + 25600); fh3 = AT2_TRR(vbo_ + 29696); ps += p0[0]; ps += p0[1]; p0[2] = __builtin_amdgcn_exp2f(fmaf(p0[2], C2_, mnL_)); SBAR(); \
        o[2] = __builtin_amdgcn_mfma_f32_32x32x16_bf16(pa0, (bf16x8){fl0[0], fl0[1], fl0[2], fl0[3], fh0[0], fh0[1], fh0[2], fh0[3]}, o[2], 0, 0, 0); fl0 = AT2_TRR(vbo_ + 1536); fh0 = AT2_TRR(vbo_ + 5632); ps += p0[2]; p0[3] = __builtin_amdgcn_exp2f(fmaf(p0[3], C2_, mnL_)); p0[4] = __builtin_amdgcn_exp2f(fmaf(p0[4], C2_, mnL_)); SBAR(); \
        o[2] = __builtin_amdgcn_mfma_f32_32x32x16_bf16(pa1, (bf16x8){fl1[0], fl1[1], fl1[2], fl1[3], fh1[0], fh1[1], fh1[2], fh1[3]}, o[2], 0, 0, 0); fl1 = AT2_TRR(vbo_ + 9728); fh1 = AT2_TRR(vbo_ + 13824); ps += p0[3]; ps += p0[4]; p0[5] = __builtin_amdgcn_exp2f(fmaf(p0[5], C2_, mnL_)); SBAR(); \
        o[2] = __builtin_amdgcn_mfma_f32_32x32x16_bf16(pa2, (bf16x8){fl2[0], fl2[1], fl2[2], fl2[3], fh2[0], fh2[1], fh2[2], fh2[3]}, o[2], 0, 0, 0); fl2 = AT2_TRR(vbo_ + 17920); fh2 = AT2_TRR(vbo_ + 22016); ps += p0[5]; p0[6] = __builtin_amdgcn_exp2f(fmaf(p0[6], C2_, mnL_)); p0[7] = __builtin_amdgcn_exp2f(fmaf(p0[7], C2_, mnL_)); SBAR(); \
        o[2] = __builtin_amdgcn_mfma_f32_32x32x16_bf16(pa3, (bf16x8){fl3[0], fl3[1], fl3[2], fl3[3], fh3[0], fh3[1], fh3[2], fh3[3]}, o[2], 0, 0, 0); fl3 = AT2_TRR(vbo_ + 26112); fh3 = AT2_TRR(vbo_ + 30208); ps += p0[6]; ps += p0[7]; p0[8] = __builtin_amdgcn_exp2f(fmaf(p0[8], C2_, mnL_)); SBAR(); \
        o[3] = __builtin_amdgcn_mfma_f32_32x32x16_bf16(pa0, (bf16x8){fl0[0], fl0[1], fl0[2], fl0[3], fh0[0], fh0[1], fh0[2], fh0[3]}, o[3], 0, 0, 0); fl0 = AT2_TRR(vbo_ + 2048); fh0 = AT2_TRR(vbo_ + 6144); ps += p0[8]; p0[9] = __builtin_amdgcn_exp2f(fmaf(p0[9], C2_, mnL_)); p0[10] = __builtin_amdgcn_exp2f(fmaf(p0[10], C2_, mnL_)); SBAR(); \
        o[3] = __builtin_amdgcn_mfma_f32_32x32x16_bf16(pa1, (bf16x8){fl1[0], fl1[1], fl1[2], fl1[3], fh1[0], fh1[1], fh1[2], fh1[3]}, o[3], 0, 0, 0); fl1 = AT2_TRR(vbo_ + 10240); fh1 = AT2_TRR(vbo_ + 14336); ps += p0[9]; ps += p0[10]; p0[11] = __builtin_amdgcn_exp2f(fmaf(p0[11], C2_, mnL_)); SBAR(); \
        o[3] = __builtin_amdgcn_mfma_f32_32x32x16_bf16(pa2, (bf16x8){fl2[0], fl2[1], fl2[2], fl2[3], fh2[0], fh2[1], fh2[2], fh2[3]}, o[3], 0, 0, 0); fl2 = AT2_TRR(vbo_ + 18432); fh2 = AT2_TRR(vbo_ + 22528); ps += p0[11]; p0[12] = __builtin_amdgcn_exp2f(fmaf(p0[12], C2_, mnL_)); p0[13] = __builtin_amdgcn_exp2f(fmaf(p0[13], C2_, mnL_)); SBAR(); \
        o[3] = __builtin_amdgcn_mfma_f32_32x32x16_bf16(pa3, (bf16x8){fl3[0], fl3[1], fl3[2], fl3[3], fh3[0], fh3[1], fh3[2], fh3[3]}, o[3], 0, 0, 0); fl3 = AT2_TRR(vbo_ + 26624); fh3 = AT2_TRR(vbo_ + 30720); ps += p0[12]; ps += p0[13]; p0[14] = __builtin_amdgcn_exp2f(fmaf(p0[14], C2_, mnL_)); SBAR(); \
        o[4] = __builtin_amdgcn_mfma_f32_32x32x16_bf16(pa0, (bf16x8){fl0[0], fl0[1], fl0[2], fl0[3], fh0[0], fh0[1], fh0[2], fh0[3]}, o[4], 0, 0, 0); fl0 = AT2_TRR(vbo_ + 2560); fh0 = AT2_TRR(vbo_ + 6656); ps += p0[14]; p0[15] = __builtin_amdgcn_exp2f(fmaf(p0[15], C2_, mnL_)); p1[0] = __builtin_amdgcn_exp2f(fmaf(p1[0], C2_, mnL_)); SBAR(); \
        o[4] = __builtin_amdgcn_mfma_f32_32x32x16_bf16(pa1, (bf16x8){fl1[0], fl1[1], fl1[2], fl1[3], fh1[0], fh1[1], fh1[2], fh1[3]}, o[4], 0, 0, 0); fl1 = AT2_TRR(vbo_ + 10752); fh1 = AT2_TRR(vbo_ + 14848); ps += p0[15]; ps += p1[0]; p1[1] = __builtin_amdgcn_exp2f(fmaf(p1[1], C2_, mnL_)); SBAR(); \
        o[4] = __builtin_amdgcn_mfma_f32_32x32x16_bf16(pa2, (bf16x8){fl2[0], fl2[1], fl2[2], fl2[3], fh2[0], fh2[1], fh2[2], fh2[3]}, o[4], 0, 0, 0); fl2 = AT2_TRR(vbo_ + 18944); fh2 = AT2_TRR(vbo_ + 23040); ps += p1[1]; p1[2] = __builtin_amdgcn_exp2f(fmaf(p1[2], C2_, mnL_)); p1[3] = __builtin_amdgcn_exp2f(fmaf(p1[3], C2_, mnL_)); SBAR(); \
        o[4] = __builtin_amdgcn_mfma_f32_32x32x16_bf16(pa3, (bf16x8){fl3[0], fl3[1], fl3[2], fl3[3], fh3[0], fh3[1], fh3[2], fh3[3]}, o[4], 0, 0, 0); fl3 = AT2_TRR(vbo_ + 27136); fh3 = AT2_TRR(vbo_ + 31232); ps += p1[2]; ps += p1[3]; p1[4] = __builtin_amdgcn_exp2f(fmaf(p1[4], C2_, mnL_)); SBAR(); \
        o[5] = __builtin_amdgcn_mfma_f32_32x32x16_bf16(pa0, (bf16x8){fl0[0], fl0[1], fl0[2], fl0[3], fh0[0], fh0[1], fh0[2], fh0[3]}, o[5], 0, 0, 0); fl0 = AT2_TRR(vbo_ + 3072); fh0 = AT2_TRR(vbo_ + 7168); ps += p1[4]; p1[5] = __builtin_amdgcn_exp2f(fmaf(p1[5], C2_, mnL_)); p1[6] = __builtin_amdgcn_exp2f(fmaf(p1[6], C2_, mnL_)); SBAR(); \
        o[5] = __builtin_amdgcn_mfma_f32_32x32x16_bf16(pa1, (bf16x8){fl1[0], fl1[1], fl1[2], fl1[3], fh1[0], fh1[1], fh1[2], fh1[3]}, o[5], 0, 0, 0); fl1 = AT2_TRR(vbo_ + 11264); fh1 = AT2_TRR(vbo_ + 15360); ps += p1[5]; ps += p1[6]; p1[7] = __builtin_amdgcn_exp2f(fmaf(p1[7], C2_, mnL_)); SBAR(); \
        o[5] = __builtin_amdgcn_mfma_f32_32x32x16_bf16(pa2, (bf16x8){fl2[0], fl2[1], fl2[2], fl2[3], fh2[0], fh2[1], fh2[2], fh2[3]}, o[5], 0, 0, 0); fl2 = AT2_TRR(vbo_ + 19456); fh2 = AT2_TRR(vbo_ + 23552); ps += p1[7]; p1[8] = __builtin_amdgcn_exp2f(fmaf(p1[8], C2_, mnL_)); p1[9] = __builtin_amdgcn_exp2f(fmaf(p1[9], C2_, mnL_)); SBAR(); \
        o[5] = __builtin_amdgcn_mfma_f32_32x32x16_bf16(pa3, (bf16x8){fl3[0], fl3[1], fl3[2], fl3[3], fh3[0], fh3[1], fh3[2], fh3[3]}, o[5], 0, 0, 0); fl3 = AT2_TRR(vbo_ + 27648); fh3 = AT2_TRR(vbo_ + 31744); ps += p1[8]; ps += p1[9]; p1[10] = __builtin_amdgcn_exp2f(fmaf(p1[10], C2_, mnL_)); SBAR(); \
        o[6] = __builtin_amdgcn_mfma_f32_32x32x16_bf16(pa0, (bf16x8){fl0[0], fl0[1], fl0[2], fl0[3], fh0[0], fh0[1], fh0[2], fh0[3]}, o[6], 0, 0, 0); fl0 = AT2_TRR(vbo_ + 3584); fh0 = AT2_TRR(vbo_ + 7680); ps += p1[10]; p1[11] = __builtin_amdgcn_exp2f(fmaf(p1[11], C2_, mnL_)); p1[12] = __builtin_amdgcn_exp2f(fmaf(p1[12], C2_, mnL_)); SBAR(); \
        o[6] = __builtin_amdgcn_mfma_f32_32x32x16_bf16(pa1, (bf16x8){fl1[0], fl1[1], fl1[2], fl1[3], fh1[0], fh1[1], fh1[2], fh1[3]}, o[6], 0, 0, 0); fl1 = AT2_TRR(vbo_ + 11776); fh1 = AT2_TRR(vbo_ + 15872); ps += p1[11]; ps += p1[12]; p1[13] = __builtin_amdgcn_exp2f(fmaf(p1[13], C2_, mnL_)); SBAR(); \
        o[6] = __builtin_amdgcn_mfma_f32_32x32x16_bf16(pa2, (bf16x8){fl2[0], fl2[1], fl2[2], fl2[3], fh2[0], fh2[1], fh2[2], fh2[3]}, o[6], 0, 0, 0); fl2 = AT2_TRR(vbo_ + 19968); fh2 = AT2_TRR(vbo_ + 24064); ps += p1[13]; p1[14] = __builtin_amdgcn_exp2f(fmaf(p1[14], C2_, mnL_)); p1[15] = __builtin_amdgcn_exp2f(fmaf(p1[15], C2_, mnL_)); SBAR(); \
        o[6] = __builtin_amdgcn_mfma_f32_32x32x16_bf16(pa3, (bf16x8){fl3[0], fl3[1], fl3[2], fl3[3], fh3[0], fh3[1], fh3[2], fh3[3]}, o[6], 0, 0, 0); fl3 = AT2_TRR(vbo_ + 28160); fh3 = AT2_TRR(vbo_ + 32256); ps += p1[14]; ps += p1[15]; { auto rr_ = __builtin_amdgcn_permlane32_swap(__float_as_uint(ps), __float_as_uint(ps), false, false); ps = __uint_as_float(rr_[0]) + __uint_as_float(rr_[1]); } SBAR(); \
        o[7] = __builtin_amdgcn_mfma_f32_32x32x16_bf16(pa0, (bf16x8){fl0[0], fl0[1], fl0[2], fl0[3], fh0[0], fh0[1], fh0[2], fh0[3]}, o[7], 0, 0, 0);  SBAR(); \
        o[7] = __builtin_amdgcn_mfma_f32_32x32x16_bf16(pa1, (bf16x8){fl1[0], fl1[1], fl1[2], fl1[3], fh1[0], fh1[1], fh1[2], fh1[3]}, o[7], 0, 0, 0);  SBAR(); \
        o[7] = __builtin_amdgcn_mfma_f32_32x32x16_bf16(pa2, (bf16x8){fl2[0], fl2[1], fl2[2], fl2[3], fh2[0], fh2[1], fh2[2], fh2[3]}, o[7], 0, 0, 0);  SBAR(); \
        o[7] = __builtin_amdgcn_mfma_f32_32x32x16_bf16(pa3, (bf16x8){fl3[0], fl3[1], fl3[2], fl3[3], fh3[0], fh3[1], fh3[2], fh3[3]}, o[7], 0, 0, 0);  SBAR(); \
        } while (0)
#define AT2_STEP(t, b, HASPV) do { \
        asm volatile("s_waitcnt vmcnt(0)" ::: "memory"); __builtin_amdgcn_s_barrier(); asm volatile("" ::: "memory");     \
        if ((t) + 1 < NT) AT2_DMA_K((t) + 1, 1 - (b)); \
        AT2_DMA_V((t), (b)); \
        SBAR(); { const int lq_ = fresh_lane(); qkt<b, false>(p0, p1, K_lds, lq_ & 31, lq_ >> 5, qr, true); } \
        { const int kb_ = (t) * KVBLK; if (kb_ + KVBLK - 1 > qlo) { const int lm_ = fresh_lane(); mask_tile(p0, p1, qlo + (lm_ & 31) - 4 * (lm_ >> 5) - kb_, 0x7fffffffu); } } \
        SBAR(); \
        if (HASPV) { AT2_PV_SM(1 - (b)); } else { softmax_main(p0, p1, m_reg, al, ps); } \
        SBAR(); \
        RESC(al); l_reg = l_reg * al + ps; pack_p(p0, p1, pa0, pa1, pa2, pa3); } while (0)
    AT2_STEP(0, 0, false);
    for (int t = 1; t + 1 < NT; t += 2) { AT2_STEP(t, 1, true); AT2_STEP(t + 1, 0, true); }
    AT2_STEP(NT - 1, 1, true);
    asm volatile("s_waitcnt vmcnt(0)" ::: "memory"); __builtin_amdgcn_s_barrier(); asm volatile("" ::: "memory");
    pv_tile8<1>(o, (const AT2_LAS char*)L + v_rd_base(fresh_lane()), pa0, pa1, pa2, pa3);
    const int l2_ = fresh_lane(), he_ = l2_ >> 5;
    if (he_ == 0) li_l[l2_ & 31] = l_reg; asm volatile("s_waitcnt lgkmcnt(0)" ::: "memory");
    float rli[16];
#pragma unroll
    for (int r = 0; r < 16; ++r) rli[r] = __builtin_amdgcn_rcpf(li_l[crow(r, he_)]);
    const int loff = 4 * (l2_ >> 5) * DV + (l2_ & 31);
    unsigned short* Ow = cur.O + (size_t)(wid * QBLK) * DV + loff;
    const bool even_ = (l2_ & 1) == 0;
#pragma unroll
    for (int r = 0; r < 16; ++r) { const int orow = (r & 3) + 8 * (r >> 2);
#pragma unroll
        for (int d0 = 0; d0 < 8; ++d0) { const float v = o[d0][r] * rli[r]; const float vn = __shfl_xor(v, 1);
            if (even_) *(unsigned*)(Ow + orow * DV + d0 * 32) = cvtpk(v, vn); } }
    __syncthreads();
#undef RESC
#undef AT2_PV_SM
#undef MX3
#undef AT2_TRR
#undef AT2_STEP
#undef AT2_DMA_K
#undef AT2_DMA_V
#undef AT2_GLDS
}
}

#ifndef MK_N_LAUNCHES
#define MK_N_LAUNCHES 1
#endif
constexpr int N_LAUNCHES = MK_N_LAUNCHES, N_PHASES = 16;
constexpr int NWAVES = 8;

constexpr int S_ = 16384, DM = 2048, FF = 5632, DE = 7168, NE = 8, NHEAD = 8;
constexpr float NORM_EPS = 1e-6f, SUBLN_EPS = 1e-5f;
constexpr float LAMBDA_INIT = 0.35550906759096934f;
constexpr float SA_X = 16.f, SW_GU = 1024.f, SA_H = 16.f, SW_D = 2048.f;
constexpr int CAP_ROWS = 2 * S_ + NE * 256;

constexpr size_t MiB = 1u << 20;
constexpr size_t WS_CTL = 0, CTL_ZERO_BYTES = 1 * MiB;
constexpr size_t WS_SS1 = 1 * MiB, WS_SS2 = WS_SS1 + 524288;
constexpr size_t WS_RS0 = 1 * MiB;
constexpr size_t WS_RS1 = 2 * MiB;
constexpr size_t WS_TOKI = WS_RS1 + 65536;
constexpr size_t WS_TOKG = WS_TOKI + 262144;
constexpr size_t WS_ROPE = 3 * MiB;
constexpr size_t WS_WPOOL = 11 * MiB;
constexpr size_t WS_WKVQ = 13 * MiB;
constexpr size_t WS_WO = 37 * MiB;
constexpr size_t WS_WGU = 45 * MiB;
constexpr size_t WS_WD = 89 * MiB;
constexpr size_t WS_WEGU = 111 * MiB;
constexpr size_t WS_WED = 559 * MiB;
constexpr size_t WS_X1 = 783 * MiB;
constexpr size_t WS_H = 911 * MiB;
constexpr size_t WS_SCR = 975 * MiB;
constexpr size_t WS_HID = WS_SCR, WS_MG = WS_SCR + 176 * MiB;
constexpr size_t WS_H2 = WS_SCR, WS_K16 = WS_SCR + 64 * MiB, WS_V16 = WS_SCR + 128 * MiB, WS_Q16 = WS_SCR + 192 * MiB, WS_O32 = WS_SCR + 256 * MiB, WS_ON = WS_SCR + 512 * MiB;
constexpr size_t WS_HIDE = WS_SCR, WS_XG = WS_SCR + 476 * MiB, WS_Y = WS_SCR + 476 * MiB;
constexpr size_t WS_YPART = WS_SCR + 300 * MiB;
constexpr size_t WS_END = WS_SCR + 748 * MiB;
static_assert((size_t)CAP_ROWS * DE * 2 == 476 * MiB && (size_t)CAP_ROWS * DM * 4 == 272 * MiB, "expert buffers");
constexpr int CW_TMO = 0, CW_BAR = 4096, CW_CNT = 8192, CW_AQ = 9216;

constexpr int RING_BYTES = 131072, LDSCTL_OFF = 151552, MISC_OFF = LDSCTL_OFF + 320, LDS_BYTES = 155648;


#define GAS __attribute__((address_space(1)))
#define LAS __attribute__((address_space(3)))
typedef unsigned short bf16;
typedef unsigned v4u __attribute__((ext_vector_type(4)));
typedef unsigned v2u __attribute__((ext_vector_type(2)));
typedef float f32x4 __attribute__((ext_vector_type(4)));
typedef float f32x2 __attribute__((ext_vector_type(2)));
typedef int i32x4 __attribute__((ext_vector_type(4)));
typedef GAS unsigned gu32;
#define RLX_AGENT __ATOMIC_RELAXED, __HIP_MEMORY_SCOPE_AGENT
#define LDS_WAIT() asm volatile("s_waitcnt lgkmcnt(0)" ::: "memory")
#define VM_WAIT() asm volatile("s_waitcnt vmcnt(0)" ::: "memory")
__device__ __forceinline__ unsigned pk2(float lo, float hi) { return pg8::cvt_pk_bf16(lo, hi); }

#define XB_TMO      128
#define XB_XCNT(j)  (256  + 64 * (j))
#define XB_XSUB(j)  (1280 + 64 * (j))
#define XB_XGEN(j)  (2304 + 64 * (j))
#define XB_TOP      3328
#define XB_TOPGEN   3392
#define XCD_BAR_WORDS 3456
#define XB_SPIN_CAP (1u << 18)

__device__ __forceinline__ unsigned xb_ld(unsigned* p)              { return __hip_atomic_load(p, __ATOMIC_RELAXED, __HIP_MEMORY_SCOPE_AGENT); }
__device__ __forceinline__ unsigned xb_add(unsigned* p, unsigned v) { return __hip_atomic_fetch_add(p, v, __ATOMIC_RELAXED, __HIP_MEMORY_SCOPE_AGENT); }
__device__ __forceinline__ unsigned xb_xcc_id() { return (unsigned)__builtin_amdgcn_s_getreg((3 << 11) | 20) & 0xFu; }
#define XB_SPIN(cond, bar) do { unsigned _sp = 0; while (cond) { __builtin_amdgcn_s_sleep(1); \
    if ((++_sp & 255u) == 0u) { if (xb_ld(&(bar)[XB_TMO])) break; if (_sp > XB_SPIN_CAP) { atomicAdd(&(bar)[XB_TMO], 1u); break; } } } } while (0)

struct XcdBarrier {
    unsigned* bar; unsigned x; int w;
    volatile LAS unsigned* st;
};

__device__ __forceinline__ XcdBarrier xcd_barrier_post(unsigned* bar, volatile LAS unsigned* st, int wave_id) {
    XcdBarrier b; b.bar = bar; b.x = xb_xcc_id(); b.st = st; b.w = wave_id;
    if (threadIdx.x == 0) (void)xb_add(&bar[XB_XCNT(b.x)], 1u);
    return b;
}
__device__ __forceinline__ void xcd_barrier_complete(unsigned* bar, unsigned x, unsigned& nloc, unsigned& nx) {
    const unsigned G = gridDim.x * gridDim.y * gridDim.z;
    unsigned sum, cnt, mine, sp = 0u;
    for (;;) {
        sum = 0u; cnt = 0u; mine = 0u;
#pragma unroll
        for (unsigned j = 0; j < 16; ++j) { const unsigned c = xb_ld(&bar[XB_XCNT(j)]); sum += c; cnt += (c > 0u) ? 1u : 0u; mine = (j == x) ? c : mine; }
        if (sum == G) break;
        __builtin_amdgcn_s_sleep(1);
        if ((++sp & 255u) == 0u) { if (xb_ld(&bar[XB_TMO])) break; if (sp > XB_SPIN_CAP) { atomicAdd(&bar[XB_TMO], 1u); break; } }
    }
    nloc = mine > 0u ? mine : 1u; nx = cnt > 0u ? cnt : 1u;
}

__device__ __forceinline__ void xcd_barrier(const XcdBarrier& b) {
    asm volatile("s_waitcnt vmcnt(0)" ::: "memory");
    __syncthreads();
    if (b.w == 0 && fresh_lane() == 0) {
        unsigned* bar = b.bar;
        __builtin_amdgcn_s_waitcnt(0);
        unsigned nloc = b.st[0], nx = b.st[1];
        if (nloc == 0u) { xcd_barrier_complete(bar, b.x, nloc, nx); b.st[0] = nloc; b.st[1] = nx; }
        const unsigned old = xb_add(&bar[XB_XSUB(b.x)], 1u);
        const unsigned gen = old / nloc;
        if (old + 1u == (gen + 1u) * nloc) {
            __builtin_amdgcn_fence(__ATOMIC_RELEASE, "agent");
            asm volatile("s_waitcnt vmcnt(0)" ::: "memory");
            const unsigned og = xb_add(&bar[XB_TOP], 1u);
            const unsigned tg = og / nx;
            if (og + 1u == (tg + 1u) * nx) xb_add(&bar[XB_TOPGEN], 1u);
            else XB_SPIN(xb_ld(&bar[XB_TOPGEN]) == tg, bar);
            __builtin_amdgcn_fence(__ATOMIC_ACQUIRE, "agent");
            xb_add(&bar[XB_XGEN(b.x)], 1u);
            asm volatile("s_waitcnt vmcnt(0)" ::: "memory");
        } else {
            XB_SPIN(xb_ld(&bar[XB_XGEN(b.x)]) == gen, bar);
            __builtin_amdgcn_fence(__ATOMIC_ACQUIRE, "agent");
            asm volatile("s_waitcnt vmcnt(0)" ::: "memory");
        }
    }
    __syncthreads();
}

__device__ __forceinline__ float wave_sum(float v) {
#pragma unroll
    for (int o = 1; o < 64; o <<= 1) v += __shfl_xor(v, o);
    return v;
}
__device__ __forceinline__ float dot4(f32x4 a, f32x4 b) { return (a.x * b.x + a.y * b.y) + (a.z * b.z + a.w * b.w); }

__device__ __forceinline__ void tr_item(const float* W, int N, int k0, int n0, bf16* dst, int ldd, LAS float* scr, int lane) {
    const float* src = W + (size_t)(k0 + (lane >> 4)) * N + n0 + 4 * (lane & 15);
    f32x4 v[16];
#pragma unroll
    for (int i = 0; i < 16; ++i) v[i] = *(const f32x4*)(src + (size_t)(4 * i) * N);
#pragma unroll
    for (int i = 0; i < 16; ++i) { LAS float* p = scr + (4 * i + (lane >> 4)) * 65 + 4 * (lane & 15); p[0] = v[i].x; p[1] = v[i].y; p[2] = v[i].z; p[3] = v[i].w; }
    LDS_WAIT(); asm volatile("" ::: "memory");
    const int c = lane & 7;
#pragma unroll
    for (int q = 0; q < 8; ++q) { const int n = (lane >> 3) + 8 * q; const LAS float* s = scr + (8 * c) * 65 + n;
        v4u o; o.x = pk2(s[0 * 65], s[1 * 65]); o.y = pk2(s[2 * 65], s[3 * 65]); o.z = pk2(s[4 * 65], s[5 * 65]); o.w = pk2(s[6 * 65], s[7 * 65]);
        *(v4u*)(dst + (size_t)n * ldd + 8 * c) = o; }
    LDS_WAIT(); asm volatile("" ::: "memory");
}
__device__ __forceinline__ void tr_item8(const float* W, int N, int k0, int n0, unsigned char* dst, int ldd, float scale, LAS float* scr, int lane) {
    const float* src = W + (size_t)(k0 + (lane >> 4)) * N + n0 + 4 * (lane & 15);
    f32x4 v[16];
#pragma unroll
    for (int i = 0; i < 16; ++i) v[i] = *(const f32x4*)(src + (size_t)(4 * i) * N);
#pragma unroll
    for (int i = 0; i < 16; ++i) { LAS float* p = scr + (4 * i + (lane >> 4)) * 65 + 4 * (lane & 15); p[0] = v[i].x * scale; p[1] = v[i].y * scale; p[2] = v[i].z * scale; p[3] = v[i].w * scale; }
    LDS_WAIT(); asm volatile("" ::: "memory");
    const int c = lane & 3;
#pragma unroll
    for (int q = 0; q < 4; ++q) { const int n = (lane >> 2) + 16 * q; const LAS float* s = scr + (16 * c) * 65 + n;
        v4u o; o.x = pg8::pk4_fp8(s[0 * 65], s[1 * 65], s[2 * 65], s[3 * 65]); o.y = pg8::pk4_fp8(s[4 * 65], s[5 * 65], s[6 * 65], s[7 * 65]);
        o.z = pg8::pk4_fp8(s[8 * 65], s[9 * 65], s[10 * 65], s[11 * 65]); o.w = pg8::pk4_fp8(s[12 * 65], s[13 * 65], s[14 * 65], s[15 * 65]);
        *(v4u*)(dst + (size_t)n * ldd + 16 * c) = o; }
    LDS_WAIT(); asm volatile("" ::: "memory");
}
template <int MODE> __device__ __forceinline__ void tr_matrix_item8(const float* W, int K, int N, unsigned char* dstbase, float scale, int r, LAS float* scr, int lane) {
    const int nblk = N / 64, kb = r / nblk, nb = r % nblk, k0 = 64 * kb, n0 = 64 * nb;
    int row;
    if (MODE == 0) row = n0;
    else if (MODE == 1) row = 256 * (n0 >> 7) + (n0 & 127);
    else row = 256 * (n0 >> 7) + 128 + (n0 & 127);
    tr_item8(W, N, k0, n0, dstbase + (size_t)row * K + k0, K, scale, scr, lane);
}
template <int MODE> __device__ __forceinline__ void tr_matrix_item(const float* W, int K, int N, bf16* dstbase, int r, LAS float* scr, int lane) {
    const int nblk = N / 64, kb = r / nblk, nb = r % nblk, k0 = 64 * kb, n0 = 64 * nb;
    int row;
    if (MODE == 0) row = n0;
    else if (MODE == 1) row = 256 * (n0 >> 7) + (n0 & 127);
    else if (MODE == 2) row = 256 * (n0 >> 7) + 128 + (n0 & 127);
    else { const int h = n0 >> 8, rr = n0 & 255, map = rr >> 7, d = rr & 127; row = 256 * h + (d < 64 ? map * 64 : 128 + map * 64); }
    tr_item(W, N, k0, n0, dstbase + (size_t)row * K + k0, K, scr, lane);
}
struct TrDesc { const float* src; unsigned char* dst; const float* gain; int N, pitch, f8; float scale; };
__device__ __forceinline__ void tr_load(const TrDesc& d, f32x4 (&v)[16], int lane) {
    const float* s = d.src + (size_t)(lane >> 4) * d.N + 4 * (lane & 15);
#pragma unroll
    for (int i = 0; i < 16; ++i) v[i] = *(const f32x4*)(s + (size_t)(4 * i) * d.N);
}
__device__ __forceinline__ void tr_store(const TrDesc& d, const f32x4 (&v)[16], LAS float* scr, int lane) {
    if (d.gain) {
#pragma unroll
        for (int i = 0; i < 16; ++i) { const float gk = d.gain[4 * i + (lane >> 4)]; LAS float* p = scr + (4 * i + (lane >> 4)) * 65 + 4 * (lane & 15); p[0] = v[i].x * gk; p[1] = v[i].y * gk; p[2] = v[i].z * gk; p[3] = v[i].w * gk; }
    } else {
#pragma unroll
        for (int i = 0; i < 16; ++i) { LAS float* p = scr + (4 * i + (lane >> 4)) * 65 + 4 * (lane & 15); p[0] = v[i].x * d.scale; p[1] = v[i].y * d.scale; p[2] = v[i].z * d.scale; p[3] = v[i].w * d.scale; }
    }
    LDS_WAIT(); asm volatile("" ::: "memory");
    if (d.f8) {
        const int c = lane & 3;
#pragma unroll
        for (int q = 0; q < 4; ++q) { const int n = (lane >> 2) + 16 * q; const LAS float* s = scr + (16 * c) * 65 + n;
            v4u o; o.x = pg8::pk4_fp8(s[0 * 65], s[1 * 65], s[2 * 65], s[3 * 65]); o.y = pg8::pk4_fp8(s[4 * 65], s[5 * 65], s[6 * 65], s[7 * 65]);
            o.z = pg8::pk4_fp8(s[8 * 65], s[9 * 65], s[10 * 65], s[11 * 65]); o.w = pg8::pk4_fp8(s[12 * 65], s[13 * 65], s[14 * 65], s[15 * 65]);
            *(v4u*)(d.dst + (size_t)n * d.pitch + 16 * c) = o; }
    } else {
        const int c = lane & 7;
#pragma unroll
        for (int q = 0; q < 8; ++q) { const int n = (lane >> 3) + 8 * q; const LAS float* s = scr + (8 * c) * 65 + n;
            v4u o; o.x = pk2(s[0 * 65], s[1 * 65]); o.y = pk2(s[2 * 65], s[3 * 65]); o.z = pk2(s[4 * 65], s[5 * 65]); o.w = pk2(s[6 * 65], s[7 * 65]);
            *(v4u*)(d.dst + (size_t)n * d.pitch + 16 * c) = o; }
    }
    LDS_WAIT(); asm volatile("" ::: "memory");
}
__device__ __forceinline__ int tr_row(int mode, int n0) {
    if (mode == 0) return n0;
    if (mode == 1) return 256 * (n0 >> 7) + (n0 & 127);
    if (mode == 2) return 256 * (n0 >> 7) + 128 + (n0 & 127);
    const int h = n0 >> 8, rr = n0 & 255, map = rr >> 7, dd = rr & 127; return 256 * h + (dd < 64 ? map * 64 : 128 + map * 64);
}
__device__ __forceinline__ void sincos_pi(double r, double& s, double& c) {
    const double x2 = r * r;
    double ps = -1.0 / 25852016738884976640000.0;
    ps = ps * x2 + 1.0 / 51090942171709440000.0;  ps = ps * x2 - 1.0 / 121645100408832000.0; ps = ps * x2 + 1.0 / 355687428096000.0; ps = ps * x2 - 1.0 / 1307674368000.0;
    ps = ps * x2 + 1.0 / 6227020800.0; ps = ps * x2 - 1.0 / 39916800.0; ps = ps * x2 + 1.0 / 362880.0; ps = ps * x2 - 1.0 / 5040.0; ps = ps * x2 + 1.0 / 120.0; ps = ps * x2 - 1.0 / 6.0; ps = ps * x2 + 1.0;
    s = ps * r;
    double pc = 1.0 / 1124000727777607680000.0;
    pc = pc * x2 - 1.0 / 2432902008176640000.0; pc = pc * x2 + 1.0 / 6402373705728000.0; pc = pc * x2 - 1.0 / 20922789888000.0; pc = pc * x2 + 1.0 / 87178291200.0;
    pc = pc * x2 - 1.0 / 479001600.0; pc = pc * x2 + 1.0 / 3628800.0; pc = pc * x2 - 1.0 / 40320.0; pc = pc * x2 + 1.0 / 720.0; pc = pc * x2 - 1.0 / 24.0; pc = pc * x2 + 0.5; pc = pc * x2 - 1.0;
    c = -pc;
}
__device__ __forceinline__ void rms_row_bf16(const float* xrow, const float* ga, bf16* oa, const float* gb, bf16* ob, int lane) {
    const f32x4* xr = (const f32x4*)xrow + lane; f32x4 v[8]; float s = 0.f;
#pragma unroll
    for (int j = 0; j < 8; ++j) { v[j] = xr[64 * j]; s += dot4(v[j], v[j]); }
    const float rstd = 1.0f / sqrtf(wave_sum(s) * (1.0f / DM) + NORM_EPS);
#pragma unroll
    for (int j = 0; j < 8; ++j) { const f32x4 g = ((const f32x4*)ga)[lane + 64 * j]; const f32x4 y = v[j] * rstd * g; v2u o; o.x = pk2(y.x, y.y); o.y = pk2(y.z, y.w); ((v2u*)oa)[lane + 64 * j] = o; }
    if (ob) {
#pragma unroll
        for (int j = 0; j < 8; ++j) { const f32x4 g = ((const f32x4*)gb)[lane + 64 * j]; const f32x4 y = v[j] * rstd * g; v2u o; o.x = pk2(y.x, y.y); o.y = pk2(y.z, y.w); ((v2u*)ob)[lane + 64 * j] = o; }
    }
}

__device__ __forceinline__ f32x4 y_chunk(const bf16* YB, const float* YPART, int pr, int R, int SK, int q) {
    const int rt = pr >> 8;
    if (rt < 128) { const v2u u = ((const v2u*)(YB + (size_t)pr * DM))[q];
        return (f32x4){__uint_as_float(u.x << 16), __uint_as_float(u.x & 0xffff0000u), __uint_as_float(u.y << 16), __uint_as_float(u.y & 0xffff0000u)}; }
    f32x4 s = {0.f, 0.f, 0.f, 0.f};
    for (int sk = 0; sk < SK; ++sk) s += ((const f32x4*)(YPART + ((size_t)(sk * R + rt - 128) * 256 + (pr & 255)) * DM))[q];
    return s;
}

struct Args { const void* in[25]; float* out; unsigned char* ws; int ph_lo, ph_hi, li, pad; };
__global__ void __launch_bounds__(NWAVES * 64, 2) yoco_fwd(Args args) {
    extern __shared__ __attribute__((aligned(16))) unsigned char lds[];
    LAS unsigned char* const L = (LAS unsigned char*)lds;
    volatile LAS unsigned* const MISC = (volatile LAS unsigned*)(L + MISC_OFF);
    const int wave = __builtin_amdgcn_readfirstlane((int)threadIdx.x >> 6);
    const int G = gridDim.x, gw = blockIdx.x * NWAVES + wave, NGW = G * NWAVES;
    unsigned char* const ws = args.ws;
    gu32* const ctl = (gu32*)(ws + WS_CTL);
    const float* x = (const float*)args.in[0]; const int* positions = (const int*)args.in[1]; const float* norm_mix_a = (const float*)args.in[2]; const float* pool_w = (const float*)args.in[3];
    const float* pool_scale = (const float*)args.in[4]; const float* norm_kv = (const float*)args.in[5]; const float* w_k = (const float*)args.in[6]; const float* w_v = (const float*)args.in[7];
    const float* norm_mix_b = (const float*)args.in[8]; const float* w_q = (const float*)args.in[9]; const float* lq1 = (const float*)args.in[10]; const float* lk1 = (const float*)args.in[11];
    const float* lq2 = (const float*)args.in[12]; const float* lk2 = (const float*)args.in[13]; const float* subln_w = (const float*)args.in[14]; const float* w_o = (const float*)args.in[15];
    const float* norm_ffn = (const float*)args.in[16]; const float* d_gate = (const float*)args.in[17]; const float* d_up = (const float*)args.in[18]; const float* d_down = (const float*)args.in[19];
    const float* router_w = (const float*)args.in[20]; const float* m_gate = (const float*)args.in[21]; const float* m_up = (const float*)args.in[22]; const float* m_down = (const float*)args.in[23];
    const float* norm_final = (const float*)args.in[24];
    float* SS1 = (float*)(ws + WS_SS1); float* SS2 = (float*)(ws + WS_SS2); float* RS1 = (float*)(ws + WS_RS1); i32x4* TOKI = (i32x4*)(ws + WS_TOKI); f32x2* TOKG = (f32x2*)(ws + WS_TOKG); float* ROPE = (float*)(ws + WS_ROPE);
    bf16* WPOOL = (bf16*)(ws + WS_WPOOL); bf16* WKVQ = (bf16*)(ws + WS_WKVQ); bf16* WO = (bf16*)(ws + WS_WO); bf16* WGU = (bf16*)(ws + WS_WGU); bf16* WD = (bf16*)(ws + WS_WD);
    unsigned char* WEGU8 = ws + WS_WEGU; unsigned char* WED8 = ws + WS_WED; float* X1 = (float*)(ws + WS_X1); bf16* HB = (bf16*)(ws + WS_H);
    bf16* HID = (bf16*)(ws + WS_HID); bf16* MG = (bf16*)(ws + WS_MG); bf16* H2 = (bf16*)(ws + WS_H2); bf16* K16 = (bf16*)(ws + WS_K16); bf16* V16 = (bf16*)(ws + WS_V16); bf16* Q16 = (bf16*)(ws + WS_Q16);
    bf16* O16 = (bf16*)(ws + WS_O32); bf16* ON = (bf16*)(ws + WS_ON); unsigned char* HIDE8 = ws + WS_HIDE; unsigned char* XG8 = ws + WS_XG; bf16* YB = (bf16*)(ws + WS_Y); float* YPART = (float*)(ws + WS_YPART);

    for (int u = threadIdx.x; u < (LDS_BYTES - LDSCTL_OFF) / 4; u += NWAVES * 64) ((LAS unsigned*)(L + LDSCTL_OFF))[u] = 0u;
    __syncthreads();
    XcdBarrier bar; bar.bar = (unsigned*)(ctl + CW_BAR); bar.x = 0; bar.st = nullptr; bar.w = wave;
    if (N_LAUNCHES == 1) bar = xcd_barrier_post((unsigned*)(ctl + CW_BAR), MISC + 8, wave);
#define GRID_BAR(seam) do { if (N_LAUNCHES != 1) { if (wave == 0 && fresh_lane() == 0) __hip_atomic_store(ctl + CW_TMO, 0xBADBA0u | (unsigned)(seam), RLX_AGENT); } else { xcd_barrier(bar); } } while (0)
    const int lo = args.ph_lo, hi = args.ph_hi;
#define FRESH_TID() const int lane = fresh_lane(), tid = wave * 64 + lane; (void)tid; (void)lane
#define IN(k) (lo <= (k) && (k) < hi)
#define BOTH(k) (IN(k) && IN((k) + 1))
#ifndef PROBE_REP_PHASE
#define PROBE_REP_PHASE -1
#endif
#define REPN(k) ((k) == PROBE_REP_PHASE ? 2 : 1)
#define SMALLREP for (int rep_ = 0; rep_ < (PROBE_REP_PHASE == 100 ? 2 : 1); ++rep_)

    if (IN(1)) { FRESH_TID();
        SMALLREP for (int rc = blockIdx.x; rc < S_ / 64; rc += G) {
            const int t0 = rc * 64;
            LAS float* rs = (LAS float*)(L + 135168);
            for (int jr = wave; jr < 79; jr += NWAVES) { const int tt = t0 - 15 + jr;
                if (tt >= 0) { const f32x4* xr = (const f32x4*)(x + (size_t)tt * DM) + lane; float s = 0.f;
#pragma unroll
                    for (int j = 0; j < 8; ++j) { const f32x4 v = xr[64 * j]; s += dot4(v, v); }
                    s = wave_sum(s); if (lane == 0) rs[jr] = 1.0f / sqrtf(s * (1.0f / DM) + NORM_EPS); } }
            __syncthreads();
            const int c = 4 * tid, g = c >> 9, w = 2 << g;
            const f32x4 gn = *(const f32x4*)(norm_mix_a + c);
            f32x4 sum = {0.f, 0.f, 0.f, 0.f};
            for (int j = w - 1; j >= 1; --j) { const int tt = t0 - j; if (tt >= 0) sum += *(const f32x4*)(x + (size_t)tt * DM + c) * rs[15 - j] * gn; }
            bf16* mg = MG + ((size_t)g * S_ + t0) * 512 + (c & 511);
            for (int t = t0; t < t0 + 64; ++t) {
                const f32x4 h = *(const f32x4*)(x + (size_t)t * DM + c) * rs[t - t0 + 15] * gn; sum += h;
                const int cnt = (t + 1 < w) ? t + 1 : w; const f32x4 m = sum * (1.0f / (float)cnt) - h;
                v2u o; o.x = pk2(m.x, m.y); o.y = pk2(m.z, m.w); *(v2u*)mg = o; mg += 512;
                const int tt = t - w + 1; if (tt >= 0) sum -= *(const f32x4*)(x + (size_t)tt * DM + c) * rs[tt - t0 + 15] * gn;
            }
            __syncthreads();
        }
        SMALLREP for (int idx = blockIdx.x * 512 + tid; idx < S_ * 64; idx += G * 512) {
            const int t = idx >> 6, i = idx & 63;
            double f = 1.0; for (int k = 0; k < i; ++k) f *= 0.8659643233600653;
            const float ang = (float)positions[t] * (float)f;
            const double a = (double)ang, kk = __builtin_rint(a * 0.15915494309189535), r = __builtin_fma(-kk, 6.283185307179586, a);
            double sn, cs; sincos_pi(r, sn, cs);
            f32x2 o; o.x = (float)cs; o.y = (float)sn; ((f32x2*)ROPE)[idx] = o;
        }
        {
            LAS float* scr = (LAS float*)(L + wave * 16640);
            constexpr int I_POOL = 64, I_SQ = 32 * 32, I_DG = 32 * 88, I_DD = 88 * 32, I_EG = 32 * 112, I_ED = 112 * 32;
            constexpr int NITEMS = 4 * I_POOL + 4 * I_SQ + 2 * I_DG + I_DD + 16 * I_EG + 8 * I_ED;
#define TR_SET(W_, K_, N_, DST_, MODE_, F8_, SC_, GAIN_, R_) do { const int nblk_ = (N_) / 64, kb_ = (R_) / nblk_, nb_ = (R_) % nblk_, k0_ = 64 * kb_, n0_ = 64 * nb_; const int es_ = (F8_) ? 1 : 2; \
        d_.src = (W_) + (size_t)k0_ * (N_) + n0_; d_.N = (N_); d_.pitch = (K_) * es_; d_.f8 = (F8_); d_.scale = (SC_); d_.gain = (GAIN_) ? (const float*)(GAIN_) + k0_ : nullptr; d_.dst = (unsigned char*)(DST_) + ((size_t)tr_row(MODE_, n0_) * (K_) + k0_) * es_; } while (0)
#define TR_DECODE(it_) do { int r = (it_) % NITEMS; \
        if (r < 4 * I_POOL) { const int g = r / I_POOL; TR_SET(pool_w + (size_t)g * 512 * 512, 512, 512, WPOOL + (size_t)g * 512 * 512, 0, 0, 1.0f, (const float*)nullptr, r % I_POOL); break; } r -= 4 * I_POOL; \
        if (r < I_SQ) { TR_SET(w_k, DM, DM, WKVQ, 3, 0, 1.0f, norm_kv, r); break; } r -= I_SQ; \
        if (r < I_SQ) { TR_SET(w_v, DM, DM, WKVQ + (size_t)2048 * DM, 0, 0, 1.0f, norm_kv, r); break; } r -= I_SQ; \
        if (r < I_SQ) { TR_SET(w_q, DM, DM, WKVQ + (size_t)4096 * DM, 3, 0, 1.0f, norm_mix_b, r); break; } r -= I_SQ; \
        if (r < I_SQ) { TR_SET(w_o, DM, DM, WO, 0, 0, 1.0f, (const float*)nullptr, r); break; } r -= I_SQ; \
        if (r < I_DG) { TR_SET(d_gate, DM, FF, WGU, 1, 0, 1.0f, norm_ffn, r); break; } r -= I_DG; \
        if (r < I_DG) { TR_SET(d_up, DM, FF, WGU, 2, 0, 1.0f, norm_ffn, r); break; } r -= I_DG; \
        if (r < I_DD) { TR_SET(d_down, FF, DM, WD, 0, 0, 1.0f, (const float*)nullptr, r); break; } r -= I_DD; \
        if (r < 8 * I_EG) { const int e = r / I_EG; TR_SET(m_gate + (size_t)e * DM * DE, DM, DE, WEGU8 + (size_t)e * 2 * DE * DM, 1, 1, SW_GU, (const float*)nullptr, r % I_EG); break; } r -= 8 * I_EG; \
        if (r < 8 * I_EG) { const int e = r / I_EG; TR_SET(m_up + (size_t)e * DM * DE, DM, DE, WEGU8 + (size_t)e * 2 * DE * DM, 2, 1, SW_GU, (const float*)nullptr, r % I_EG); break; } r -= 8 * I_EG; \
        { const int e = r / I_ED; TR_SET(m_down + (size_t)e * DE * DM, DE, DM, WED8 + (size_t)e * DM * DE, 0, 1, SW_D, (const float*)nullptr, r % I_ED); } } while (0)
            const int NIT_ = NITEMS * REPN(1);
            TrDesc dA, dB; f32x4 vA[16], vB[16];
            int it = gw;
            if (it < NIT_) {
                { TrDesc& d_ = dA; TR_DECODE(it); } tr_load(dA, vA, lane);
                for (;;) {
                    int nx = it + NGW; bool has = nx < NIT_;
                    { TrDesc& d_ = dB; TR_DECODE(has ? nx : it); } tr_load(dB, vB, lane);
                    tr_store(dA, vA, scr, lane);
                    if (!has) break;
                    it = nx; nx = it + NGW; has = nx < NIT_;
                    { TrDesc& d_ = dA; TR_DECODE(has ? nx : it); } tr_load(dA, vA, lane);
                    tr_store(dB, vB, scr, lane);
                    if (!has) break;
                    it = nx;
                }
            }
#undef TR_DECODE
#undef TR_SET
        }
        if (BOTH(1)) GRID_BAR(1);
    }
    if (IN(2)) { FRESH_TID();
        pg8::GemmOrder S; S.init(S_ / 256, 8, G, (int)blockIdx.x, MG, WPOOL, 512, 1, (size_t)S_ * 512 * 2);
        pg8::EpiResF32N E{x, X1, DM, pool_scale, HB, SS1, (LAS float*)(L + RING_BYTES)};
        pg8::gemm_phase<pg8::EpiResF32N, pg8::GemmOrder, true, true>(L, 512 * 2, S, E, wave);
        if (BOTH(2)) GRID_BAR(2);
    }
    if (IN(4)) { FRESH_TID();
        pg8::GemmOrder S; S.init(S_ / 256, 2 * FF / 256, G, (int)blockIdx.x, HB, WGU, DM, 30, 0); S.rep = REPN(4);
        pg8::EpiSwiGLU E{HID, FF, SS1, 1.0f / DM, NORM_EPS};
        pg8::gemm_phase<pg8::EpiSwiGLU, pg8::GemmOrder, true, true>(L, DM * 2, S, E, wave);
        if (BOTH(4)) GRID_BAR(4);
    }
    if (IN(5)) { FRESH_TID();
        pg8::GemmOrder S; S.init(S_ / 256, DM / 256, G, (int)blockIdx.x, HID, WD, FF, 30, 0);
        pg8::EpiResF32N E{X1, X1, DM, nullptr, HB, SS2, (LAS float*)(L + RING_BYTES)};
        pg8::gemm_phase<pg8::EpiResF32N, pg8::GemmOrder, true, true>(L, FF * 2, S, E, wave);
        if (BOTH(5)) GRID_BAR(5);
    }
    if (IN(7)) { FRESH_TID();
        pg8::GemmOrder S; S.init(S_ / 256, 24, G, (int)blockIdx.x, HB, WKVQ, DM, 30, 0); S.rep = REPN(7);
        pg8::EpiKVQ E{K16, V16, Q16, ROPE, S_, SS2, 1.0f / DM, NORM_EPS};
        pg8::gemm_phase<pg8::EpiKVQ, pg8::GemmOrder, true, true>(L, DM * 2, S, E, wave);
        if (BOTH(7)) GRID_BAR(7);
    }
    if (IN(8)) { FRESH_TID();
        constexpr int NIT = 512 * REPN(8);
        for (int Li = blockIdx.x; Li < NIT; Li += G) {
            const int vh = (Li & 7) + 8 * ((Li >> 8) & 1), xp = (Li >> 3) & 31;
            for (int pass = 0; pass < 2; ++pass) {
                const int qb = pass ? xp : 63 - xp;
                attn::Block2 cur;
                cur.Q = (const attn::bf16*)Q16 + ((size_t)vh * S_ + (size_t)qb * 256) * 128; cur.K = (const attn::bf16*)K16 + (size_t)vh * S_ * 128;
                cur.V = (const attn::bf16*)V16 + (size_t)(vh >> 1) * S_ * 256; cur.O = O16 + ((size_t)vh * S_ + (size_t)qb * 256) * 256; cur.P0 = qb * 256;
                attn::attn_block2(cur, (char*)lds, L, wave);
            }
        }
        if (BOTH(8)) GRID_BAR(8);
    }
    if (IN(9)) { FRESH_TID();
        const float s1 = wave_sum(lq1[lane] * lk1[lane] + lq1[lane + 64] * lk1[lane + 64]), s2 = wave_sum(lq2[lane] * lk2[lane] + lq2[lane + 64] * lk2[lane + 64]);
        const float lam = expf(s1) - expf(s2) + LAMBDA_INIT;
        const f32x4 sw = *(const f32x4*)(subln_w + 4 * lane) * (1.0f - LAMBDA_INIT);
        SMALLREP for (int m = gw; m < S_; m += NGW) {
#pragma unroll
            for (int h = 0; h < NHEAD; ++h) {
                const v2u u1 = *(const v2u*)(O16 + ((size_t)(h * 2) * S_ + m) * 256 + 4 * lane), u2 = *(const v2u*)(O16 + ((size_t)(h * 2 + 1) * S_ + m) * 256 + 4 * lane);
                const f32x4 o1 = {__uint_as_float(u1.x << 16), __uint_as_float(u1.x & 0xffff0000u), __uint_as_float(u1.y << 16), __uint_as_float(u1.y & 0xffff0000u)};
                const f32x4 o2 = {__uint_as_float(u2.x << 16), __uint_as_float(u2.x & 0xffff0000u), __uint_as_float(u2.y << 16), __uint_as_float(u2.y & 0xffff0000u)};
                const f32x4 o = o1 - lam * o2;
                const float r = 1.0f / sqrtf(wave_sum(dot4(o, o)) * (1.0f / 256.0f) + SUBLN_EPS);
                const f32x4 y = o * r * sw; v2u w; w.x = pk2(y.x, y.y); w.y = pk2(y.z, y.w);
                *(v2u*)(ON + (size_t)m * DM + h * 256 + 4 * lane) = w;
            }
        }
        if (BOTH(9)) GRID_BAR(9);
    }
    if (IN(10)) { FRESH_TID();
        pg8::GemmOrder S; S.init(S_ / 256, DM / 256, G, (int)blockIdx.x, ON, WO, DM, 30, 0);
        pg8::EpiResF32 E{X1, X1, DM, nullptr};
        pg8::gemm_phase<pg8::EpiResF32, pg8::GemmOrder, true, true>(L, DM * 2, S, E, wave);
        if (BOTH(10)) GRID_BAR(10);
    }
    if (IN(11)) { FRESH_TID();
        LAS float* rw = (LAS float*)L;
        LAS int* lcnt = (LAS int*)(L + 65536); LAS int* gbase = lcnt + 8; LAS int* rinfo = lcnt + 16;
        LAS float* rgate = (LAS float*)(L + 65536 + 64 + 1024);
        for (int i = tid; i < DM * NE / 4; i += NWAVES * 64) ((LAS f32x4*)rw)[i] = ((const f32x4*)router_w)[i];
        if (tid < 8) lcnt[tid] = 0;
        __syncthreads();
        const float* gn = norm_ffn + DM;
        for (int rb = blockIdx.x; rb < S_ / 64; rb += G) {
            for (int rr = 0; rr < 8; ++rr) {
                const int row = rb * 64 + wave * 8 + rr; const float* xr = X1 + (size_t)row * DM + lane;
                float xv[32]; float s = 0.f;
#pragma unroll
                for (int i = 0; i < 32; ++i) { xv[i] = xr[64 * i]; s += xv[i] * xv[i]; }
                const float rstd = 1.0f / sqrtf(wave_sum(s) * (1.0f / DM) + NORM_EPS);
                float acc[8] = {0.f, 0.f, 0.f, 0.f, 0.f, 0.f, 0.f, 0.f};
#pragma unroll
                for (int i = 0; i < 32; ++i) { const float hv = xv[i] * rstd * gn[lane + 64 * i]; const LAS f32x4* wp = (const LAS f32x4*)(rw + (lane + 64 * i) * 8); const f32x4 w0 = wp[0], w1 = wp[1];
                    acc[0] += hv * w0.x; acc[1] += hv * w0.y; acc[2] += hv * w0.z; acc[3] += hv * w0.w; acc[4] += hv * w1.x; acc[5] += hv * w1.y; acc[6] += hv * w1.z; acc[7] += hv * w1.w; }
                float lg[8];
#pragma unroll
                for (int e = 0; e < 8; ++e) lg[e] = wave_sum(acc[e]);
                int e1 = 0; float l1 = lg[0];
#pragma unroll
                for (int e = 1; e < 8; ++e) if (lg[e] > l1) { l1 = lg[e]; e1 = e; }
                int e2 = -1; float l2 = -__builtin_inff();
#pragma unroll
                for (int e = 0; e < 8; ++e) if (e != e1 && lg[e] > l2) { l2 = lg[e]; e2 = e; }
                const float ex = expf(l2 - l1), g1 = 1.0f / (1.0f + ex), g2 = ex / (1.0f + ex);
                if (lane == 0) { const int r1 = __hip_atomic_fetch_add(&lcnt[e1], 1, __ATOMIC_RELAXED, __HIP_MEMORY_SCOPE_WORKGROUP), r2 = __hip_atomic_fetch_add(&lcnt[e2], 1, __ATOMIC_RELAXED, __HIP_MEMORY_SCOPE_WORKGROUP);
                    const int q = wave * 8 + rr; rinfo[q * 4 + 0] = e1; rinfo[q * 4 + 1] = r1; rinfo[q * 4 + 2] = e2; rinfo[q * 4 + 3] = r2; rgate[q * 2] = g1; rgate[q * 2 + 1] = g2; RS1[row] = rstd; }
            }
            __syncthreads();
            if (tid < 8) gbase[tid] = (int)__hip_atomic_fetch_add(ctl + CW_CNT + 64 * tid, (unsigned)lcnt[tid], RLX_AGENT);
            __syncthreads();
            if (tid < 64) { const int row = rb * 64 + tid; const int e1 = rinfo[tid * 4], e2 = rinfo[tid * 4 + 2]; const int sl1 = gbase[e1] + rinfo[tid * 4 + 1], sl2 = gbase[e2] + rinfo[tid * 4 + 3];
                i32x4 ti; ti.x = e1; ti.y = sl1; ti.z = e2; ti.w = sl2; TOKI[row] = ti; f32x2 tg; tg.x = rgate[tid * 2]; tg.y = rgate[tid * 2 + 1]; TOKG[row] = tg; }
            __syncthreads();
            if (tid < 8) lcnt[tid] = 0;
            __syncthreads();
        }
        if (BOTH(11)) GRID_BAR(11);
    }
#define MOE_TS(ts_) do { int tot_ = 0; _Pragma("unroll") for (int e_ = 0; e_ < 8; ++e_) { const int c_ = __builtin_amdgcn_readfirstlane((int)__hip_atomic_load(ctl + CW_CNT + 64 * e_, RLX_AGENT)); (ts_)[e_] = tot_; tot_ += (c_ + 255) >> 8; } (ts_)[8] = tot_; } while (0)
#define MOE_SK(R_) ((R_) <= 2 ? 14 : ((R_) <= 4 ? 7 : 4))
    if (IN(12)) { FRESH_TID();
        int ts[9]; MOE_TS(ts);
        const float* gn = norm_ffn + DM;
        SMALLREP for (int m = gw; m < S_; m += NGW) {
            const i32x4 ti = TOKI[m]; const float rstd = RS1[m];
            int t1 = 0, t2 = 0;
#pragma unroll
            for (int e = 0; e < 8; ++e) { t1 = (ti.x == e) ? ts[e] : t1; t2 = (ti.z == e) ? ts[e] : t2; }
            unsigned* o1 = (unsigned*)(XG8 + (size_t)(256 * t1 + ti.y) * DM) + lane; unsigned* o2 = (unsigned*)(XG8 + (size_t)(256 * t2 + ti.w) * DM) + lane;
            const f32x4* xr = (const f32x4*)(X1 + (size_t)m * DM) + lane;
#pragma unroll
            for (int j = 0; j < 8; ++j) { const f32x4 y = xr[64 * j] * (rstd * SA_X) * ((const f32x4*)gn)[lane + 64 * j]; const unsigned o = pg8::pk4_fp8(y.x, y.y, y.z, y.w); o1[64 * j] = o; o2[64 * j] = o; }
        }
        if (BOTH(12)) GRID_BAR(12);
    }
    if (IN(13)) { FRESH_TID();
        pg8::MoeOrder S; MOE_TS(S.ts); S.rep = REPN(13); S.nM = S.ts[8]; S.nN = 2 * DE / 256; S.nwg = S.nM * S.nN; S.G = G; S.c = (int)blockIdx.x;
        S.A = (const char*)XG8; S.B = (const char*)WEGU8; S.tstepA = (size_t)256 * DM; S.tstepB = (size_t)256 * DM; S.estride = (size_t)2 * DE * DM;
        pg8::EpiSwiGLU8 E{HIDE8, DE, 1.0f / (SA_X * SW_GU), SA_H};
        pg8::gemm_phase<pg8::EpiSwiGLU8, pg8::MoeOrder, true, true, true>(L, DM, S, E, wave);
        if (BOTH(13)) GRID_BAR(13);
    }
    if (IN(14)) { FRESH_TID();
        pg8::MoeOrder S; MOE_TS(S.ts); S.rep = REPN(14); S.nM = S.ts[8] < 128 ? S.ts[8] : 128; S.nN = DM / 256; S.nwg = S.nM * S.nN; S.G = G; S.c = (int)blockIdx.x;
        S.A = (const char*)HIDE8; S.B = (const char*)WED8; S.tstepA = (size_t)256 * DE; S.tstepB = (size_t)256 * DE; S.estride = (size_t)DM * DE;
        pg8::EpiBf16S E{YB, DM, 1.0f / (SA_H * SW_D)};
        pg8::gemm_phase<pg8::EpiBf16S, pg8::MoeOrder, true, true, true>(L, DE, S, E, wave);
        const int R = S.ts[8] - 128;
        if (R > 0) {
            pg8::SplitOrder S2; S2.R = R; S2.SK = MOE_SK(R); S2.nsub = 8 * R * S2.SK; S2.G = G; S2.c = (int)blockIdx.x; S2.klen = DE / S2.SK;
#pragma unroll
            for (int e_ = 0; e_ < 9; ++e_) S2.ts[e_] = S.ts[e_];
            S2.A = S.A; S2.B = S.B; S2.tstepA = S.tstepA; S2.tstepB = S.tstepB; S2.estride = S.estride;
            pg8::EpiF32 E2{YPART, DM, 1.0f / (SA_H * SW_D)};
            pg8::gemm_phase<pg8::EpiF32, pg8::SplitOrder, true, true, true>(L, DE, S2, E2, wave, S2.klen);
        }
        if (BOTH(14)) GRID_BAR(14);
    }
    if (IN(15)) { FRESH_TID();
        int ts[9]; MOE_TS(ts);
        const int Rl = ts[8] - 128, SKl = MOE_SK(Rl);
        unsigned poison = __hip_atomic_load(ctl + CW_TMO, RLX_AGENT) | __hip_atomic_load(ctl + CW_BAR + XB_TMO, RLX_AGENT);
        SMALLREP for (int m = gw; m < S_; m += NGW) {
            const i32x4 ti = TOKI[m]; const f32x2 tg = TOKG[m];
            int t1 = 0, t2 = 0;
#pragma unroll
            for (int e = 0; e < 8; ++e) { t1 = (ti.x == e) ? ts[e] : t1; t2 = (ti.z == e) ? ts[e] : t2; }
            const int pr1 = 256 * t1 + ti.y, pr2 = 256 * t2 + ti.w;
            const f32x4* xr = (const f32x4*)(X1 + (size_t)m * DM) + lane;
            const bool first_lo = ti.x < ti.z;
            f32x4 v[8]; float s = 0.f;
#pragma unroll
            for (int j = 0; j < 8; ++j) { const f32x4 a = y_chunk(YB, YPART, pr1, Rl, SKl, lane + 64 * j) * tg.x, b = y_chunk(YB, YPART, pr2, Rl, SKl, lane + 64 * j) * tg.y;
                v[j] = xr[64 * j] + (first_lo ? (a + b) : (b + a)); s += dot4(v[j], v[j]); }
            float rstd = 1.0f / sqrtf(wave_sum(s) * (1.0f / DM) + NORM_EPS);
            if (poison) rstd = __builtin_nanf("");
            f32x4* o = (f32x4*)(args.out + (size_t)m * DM) + lane;
#pragma unroll
            for (int j = 0; j < 8; ++j) o[64 * j] = v[j] * rstd * ((const f32x4*)norm_final)[lane + 64 * j];
        }
    }
#undef IN
#undef BOTH
#undef GRID_BAR
#undef MOE_TS
}

extern "C" void kernel_launch(void* const* d_in, const int* in_sizes, int n_in, void* d_out, int out_size, void* d_ws, size_t ws_size, hipStream_t stream) {
    static int grid = 0;
    if (grid == 0) {
        if (n_in != 25 || in_sizes[0] != S_ * DM || out_size != S_ * DM || ws_size < WS_END) { fprintf(stderr, "kernel_launch: shape / workspace mismatch (n_in %d, in0 %d, out %d, ws %zu, need %zu); nothing launched\n", n_in, n_in > 0 ? in_sizes[0] : -1, out_size, ws_size, (size_t)WS_END); grid = -1; return; }
        int dev = 0, cus = 0;
        if (hipGetDevice(&dev) != hipSuccess || hipDeviceGetAttribute(&cus, hipDeviceAttributeMultiprocessorCount, dev) != hipSuccess) { fprintf(stderr, "kernel_launch: device query failed\n"); grid = -1; return; }
        if (hipFuncSetAttribute((const void*)yoco_fwd, hipFuncAttributeMaxDynamicSharedMemorySize, LDS_BYTES) != hipSuccess) { fprintf(stderr, "kernel_launch: hipFuncSetAttribute failed\n"); grid = -1; return; }
        int per_cu = 0;
        if (hipOccupancyMaxActiveBlocksPerMultiprocessor(&per_cu, (const void*)yoco_fwd, NWAVES * 64, LDS_BYTES) != hipSuccess || per_cu < 1) { fprintf(stderr, "kernel_launch: occupancy query reports %d workgroups per CU\n", per_cu); }
        (void)hipGetLastError();
        grid = cus;
    }
    if (grid < 0) return;
    if (hipMemsetAsync((char*)d_ws + WS_CTL, 0, CTL_ZERO_BYTES, stream) != hipSuccess) { fprintf(stderr, "kernel_launch: memset failed\n"); return; }
    Args a{};
    for (int i = 0; i < 25; ++i) a.in[i] = d_in[i];
    a.out = (float*)d_out; a.ws = (unsigned char*)d_ws; a.pad = 0;
    if (N_LAUNCHES == 1) { a.ph_lo = 0; a.ph_hi = N_PHASES; a.li = 0; hipLaunchKernelGGL(yoco_fwd, dim3(grid), dim3(NWAVES * 64), LDS_BYTES, stream, a); }
    else { for (int li = 0; li < N_PHASES; ++li) { a.ph_lo = li; a.ph_hi = li + 1; a.li = li; hipLaunchKernelGGL(yoco_fwd, dim3(grid), dim3(NWAVES * 64), LDS_BYTES, stream, a); } }
    const hipError_t le = hipPeekAtLastError();
    if (le != hipSuccess) fprintf(stderr, "kernel_launch: launch failed: %s\n", hipGetErrorName(le));
}
```

```cpp
#include <hip/hip_runtime.h>
#include <hip/hip_bf16.h>
#include <cstdio>
#include <cstdint>

__device__ __forceinline__ int fresh_lane() { int l; asm volatile("v_mbcnt_lo_u32_b32 %0, -1, 0\n\tv_mbcnt_hi_u32_b32 %0, -1, %0" : "=v"(l)); return l; }

namespace pg8 {
#define PG8_LAS __attribute__((address_space(3)))
typedef unsigned short bf16_t;
typedef short bf16x8 __attribute__((ext_vector_type(8)));
typedef float f32x4 __attribute__((ext_vector_type(4)));
typedef unsigned u32x4 __attribute__((ext_vector_type(4)));
typedef int i32x4 __attribute__((ext_vector_type(4)));
typedef int i32x8 __attribute__((ext_vector_type(8)));
typedef unsigned u32x2 __attribute__((ext_vector_type(2)));
constexpr int BM = 256, BK = 64, HALF = 128, HTB = HALF * BK * 2  , STAGE_BYTES = 8 * HTB, NXCD = 8, WGM = 8;

__host__ __device__ __forceinline__ int lds_byte(int r, int c) { const int st = (r >> 4) * 2 + (c >> 5), rr = r & 15, cc = c & 31, ob = rr * 64 + cc * 2; return st * 1024 + (ob ^ (((ob >> 9) & 1) << 5)); }
__host__ __device__ __forceinline__ void stage_rc(int b, int& R, int& C) { const int st = b / 1024, sb = b % 1024, swz = sb ^ (((sb >> 9) & 1) << 5); R = (st >> 1) * 16 + swz / 64; C = (st & 1) * 32 + (swz % 64) / 2; }
__host__ __device__ __forceinline__ int perm32(int rho) { const int n = rho >> 4, i = rho & 15; return 8 * (i >> 2) + 4 * n + (i & 3); }

struct Unit { int pm, pn, aux; const char* A; const char* B; };

struct GemmOrder {
    int nM, nN, nwg, G, c, ashift, rep; const char* A; const char* B; size_t tstepA, tstepB, astride;
    __device__ __forceinline__ void init(int nM_, int nN_, int G_, int c_, const void* A_, const void* B_, int K, int ashift_, size_t astride_) {
        nM = nM_; nN = nN_; nwg = nM * nN; G = G_; c = c_; A = (const char*)A_; B = (const char*)B_; tstepA = (size_t)BM * K * 2;     tstepB = tstepA; ashift = ashift_; astride = astride_; rep = 1; }
    __device__ __forceinline__ bool next(int i, Unit& u) const {
        const long L = (long)i * G + c; if (L >= (long)nwg * rep) return false;
        int wgid = (int)(L % nwg); { const int q = nwg / NXCD, r = nwg % NXCD, xcd = wgid % NXCD, off = wgid / NXCD; wgid = (xcd < r ? xcd * (q + 1) : r * (q + 1) + (xcd - r) * q) + off; }
        const int nig = WGM * nN, gid = wgid / nig, fm = gid * WGM, gsz = (nM - fm) < WGM ? (nM - fm) : WGM;
        u.pm = fm + ((wgid % nig) % gsz); u.pn = (wgid % nig) / gsz; u.aux = 0;
        u.A = A + (size_t)(u.pn >> ashift) * astride + (size_t)u.pm * tstepA; u.B = B + (size_t)u.pn * tstepB; return true;
    }
    __device__ __forceinline__ void a_ready(const Unit&) const {}
    __device__ __forceinline__ void done(const Unit&) const {}
};
struct MoeOrder {
    int nM, nN, nwg, G, c, rep; int ts[9]; const char* A; const char* B; size_t tstepA, tstepB, estride;
    __device__ __forceinline__ bool next(int i, Unit& u) const {
        const long L = (long)i * G + c; if (L >= (long)nwg * rep) return false;
        int wgid = (int)(L % nwg); { const int q = nwg / NXCD, r = nwg % NXCD, xcd = wgid % NXCD, off = wgid / NXCD; wgid = (xcd < r ? xcd * (q + 1) : r * (q + 1) + (xcd - r) * q) + off; }
        const int nig = WGM * nN, gid = wgid / nig, fm = gid * WGM, gsz = (nM - fm) < WGM ? (nM - fm) : WGM;
        u.pm = fm + ((wgid % nig) % gsz); u.pn = (wgid % nig) / gsz;
        int e = 0;
#pragma unroll
        for (int j = 1; j < 8; ++j) e += (u.pm >= ts[j]) ? 1 : 0;
        u.aux = e;
        u.A = A + (size_t)u.pm * tstepA; u.B = B + (size_t)e * estride + (size_t)u.pn * tstepB; return true;
    }
    __device__ __forceinline__ void a_ready(const Unit&) const {}
    __device__ __forceinline__ void done(const Unit&) const {}
};

struct SplitOrder {
    int R, SK, nsub, G, c, klen; int ts[9]; const char* A; const char* B; size_t tstepA, tstepB, estride;
    __device__ __forceinline__ bool next(int i, Unit& u) const {
        const long L = (long)i * G + c; if (L >= nsub) return false;
        const int sk = (int)(L % SK), unit = (int)(L / SK), rtl = unit >> 3, pm = 128 + rtl;
        int e = 0;
#pragma unroll
        for (int j = 1; j < 8; ++j) e += (pm >= ts[j]) ? 1 : 0;
        u.pm = sk * R + rtl; u.pn = unit & 7; u.aux = e;
        u.A = A + (size_t)pm * tstepA + (size_t)sk * klen; u.B = B + (size_t)e * estride + (size_t)u.pn * tstepB + (size_t)sk * klen; return true;
    }
    __device__ __forceinline__ void a_ready(const Unit&) const {}
    __device__ __forceinline__ void done(const Unit&) const {}
};

__device__ __forceinline__ unsigned cvt_pk_bf16(float lo, float hi) { unsigned r; asm volatile("v_cvt_pk_bf16_f32 %0, %1, %2" : "=v"(r) : "v"(lo), "v"(hi)); return r; }

struct EpiResF32 {
    static constexpr bool PERM = false, AFTER_DRAIN = false;
    const float* base; float* out; int ldc; const float* scale;
    __device__ __forceinline__ void operator()(const f32x4 (&acc)[2][2][4][2], const Unit& u, int wr, int wc, int fr, int fq) const {
        const int row0 = u.pm * BM + wr * 64 + fr, col0 = u.pn * BM + wc * 32 + 4 * fq;
        f32x4 sv[2][2];
#pragma unroll
        for (int bj = 0; bj < 2; ++bj)
#pragma unroll
            for (int n = 0; n < 2; ++n) sv[bj][n] = scale ? *(const f32x4*)(scale + col0 + bj * HALF + n * 16) : (f32x4){1.f, 1.f, 1.f, 1.f};
#pragma unroll
        for (int ai = 0; ai < 2; ++ai)
#pragma unroll
            for (int m = 0; m < 4; ++m) { const size_t off = (size_t)(row0 + ai * HALF + m * 16) * ldc + col0;
#pragma unroll
                for (int bj = 0; bj < 2; ++bj)
#pragma unroll
                    for (int n = 0; n < 2; ++n) { const f32x4 bs = *(const f32x4*)(base + off + bj * HALF + n * 16); *(f32x4*)(out + off + bj * HALF + n * 16) = bs + acc[ai][bj][m][n] * sv[bj][n]; }
                asm volatile("" ::: "memory"); }
    }
};
struct EpiResF32N {
    static constexpr bool PERM = false, AFTER_DRAIN = false;
    const float* base; float* out; int ldc; const float* scale; bf16_t* xb; float* ssp; PG8_LAS float* tab;
    __device__ __forceinline__ void operator()(const f32x4 (&acc)[2][2][4][2], const Unit& u, int wr, int wc, int fr, int fq) const {
        const int row0 = u.pm * BM + wr * 64 + fr, col0 = u.pn * BM + wc * 32 + 4 * fq;
        f32x4 sv[2][2];
#pragma unroll
        for (int bj = 0; bj < 2; ++bj)
#pragma unroll
            for (int n = 0; n < 2; ++n) sv[bj][n] = scale ? *(const f32x4*)(scale + col0 + bj * HALF + n * 16) : (f32x4){1.f, 1.f, 1.f, 1.f};
#pragma unroll
        for (int ai = 0; ai < 2; ++ai)
#pragma unroll
            for (int m = 0; m < 4; ++m) { const int row = row0 + ai * HALF + m * 16; const size_t off = (size_t)row * ldc + col0; float q = 0.f;
#pragma unroll
                for (int bj = 0; bj < 2; ++bj)
#pragma unroll
                    for (int n = 0; n < 2; ++n) { const f32x4 bs = *(const f32x4*)(base + off + bj * HALF + n * 16); const f32x4 v = bs + acc[ai][bj][m][n] * sv[bj][n];
                        *(f32x4*)(out + off + bj * HALF + n * 16) = v; q += (v[0] * v[0] + v[1] * v[1]) + (v[2] * v[2] + v[3] * v[3]);
                        u32x2 w; w.x = cvt_pk_bf16(v[0], v[1]); w.y = cvt_pk_bf16(v[2], v[3]); *(u32x2*)(xb + off + bj * HALF + n * 16) = w; }
                q += __shfl_xor(q, 16); q += __shfl_xor(q, 32);
                if (fq == 0) tab[(ai * HALF + wr * 64 + m * 16 + fr) * 4 + wc] = q;
                asm volatile("" ::: "memory"); }
        asm volatile("s_waitcnt lgkmcnt(0)" ::: "memory"); __builtin_amdgcn_s_barrier(); asm volatile("" ::: "memory");
        const int t = (wr * 4 + wc) * 64 + fq * 16 + fr;
        if (t < BM) { const PG8_LAS f32x4* p = (const PG8_LAS f32x4*)(tab + t * 4); const f32x4 s = *p; ssp[(size_t)(u.pm * BM + t) * 8 + u.pn] = ((s[0] + s[1]) + s[2]) + s[3]; }
    }
};
struct EpiBf16S {
    static constexpr bool PERM = true, AFTER_DRAIN = false;
    bf16_t* O; int ldc; float sc;
    __device__ __forceinline__ void operator()(const f32x4 (&acc)[2][2][4][2], const Unit& u, int wr, int wc, int fr, int fq) const {
        const int row0 = u.pm * BM + wr * 64 + fr, col0 = u.pn * BM + wc * 32 + 8 * fq;
#pragma unroll
        for (int ai = 0; ai < 2; ++ai)
#pragma unroll
            for (int m = 0; m < 4; ++m) { bf16_t* rowp = O + (size_t)(row0 + ai * HALF + m * 16) * ldc + col0;
#pragma unroll
                for (int bj = 0; bj < 2; ++bj) { const f32x4 v0 = acc[ai][bj][m][0] * sc, v1 = acc[ai][bj][m][1] * sc;
                    u32x4 w; w.x = cvt_pk_bf16(v0[0], v0[1]); w.y = cvt_pk_bf16(v0[2], v0[3]); w.z = cvt_pk_bf16(v1[0], v1[1]); w.w = cvt_pk_bf16(v1[2], v1[3]);
                    *(u32x4*)(rowp + bj * HALF) = w; } }
    }
};
struct EpiF32 {
    static constexpr bool PERM = false, AFTER_DRAIN = false;
    float* out; int ldc; float sc;
    __device__ __forceinline__ void operator()(const f32x4 (&acc)[2][2][4][2], const Unit& u, int wr, int wc, int fr, int fq) const {
        const int row0 = u.pm * BM + wr * 64 + fr, col0 = u.pn * BM + wc * 32 + 4 * fq;
#pragma unroll
        for (int ai = 0; ai < 2; ++ai)
#pragma unroll
            for (int m = 0; m < 4; ++m) { float* rowp = out + (size_t)(row0 + ai * HALF + m * 16) * ldc + col0;
#pragma unroll
                for (int bj = 0; bj < 2; ++bj)
#pragma unroll
                    for (int n = 0; n < 2; ++n) *(f32x4*)(rowp + bj * HALF + n * 16) = acc[ai][bj][m][n] * sc; }
    }
};
__device__ __forceinline__ float row_rstd(const float* ssp, int row, float inv_n, float eps) { const f32x4 a = *(const f32x4*)(ssp + (size_t)row * 8), b = *(const f32x4*)(ssp + (size_t)row * 8 + 4);
    return 1.0f / sqrtf((((a[0] + a[1]) + (a[2] + a[3])) + ((b[0] + b[1]) + (b[2] + b[3]))) * inv_n + eps); }
__device__ __forceinline__ float silu_mul(float g, float u) { return g * u * __builtin_amdgcn_rcpf(1.0f + __builtin_amdgcn_exp2f(-1.4426950408889634f * g)); }
struct EpiSwiGLU {
    static constexpr bool PERM = true, AFTER_DRAIN = false;
    bf16_t* O; int ldc; const float* ssp; float inv_n, eps;
    __device__ __forceinline__ void operator()(const f32x4 (&acc)[2][2][4][2], const Unit& u, int wr, int wc, int fr, int fq) const {
        const int row0 = u.pm * BM + wr * 64 + fr, col0 = u.pn * HALF + wc * 32 + 8 * fq;
#pragma unroll
        for (int ai = 0; ai < 2; ++ai)
#pragma unroll
            for (int m = 0; m < 4; ++m) { const int row = row0 + ai * HALF + m * 16; bf16_t* rowp = O + (size_t)row * ldc + col0; const float rs = row_rstd(ssp, row, inv_n, eps);
                const f32x4 g0 = acc[ai][0][m][0] * rs, g1 = acc[ai][0][m][1] * rs, u0 = acc[ai][1][m][0] * rs, u1 = acc[ai][1][m][1] * rs;
                u32x4 w; w.x = cvt_pk_bf16(silu_mul(g0[0], u0[0]), silu_mul(g0[1], u0[1])); w.y = cvt_pk_bf16(silu_mul(g0[2], u0[2]), silu_mul(g0[3], u0[3]));
                w.z = cvt_pk_bf16(silu_mul(g1[0], u1[0]), silu_mul(g1[1], u1[1])); w.w = cvt_pk_bf16(silu_mul(g1[2], u1[2]), silu_mul(g1[3], u1[3]));
                *(u32x4*)rowp = w; }
    }
};
__device__ __forceinline__ unsigned pk4_fp8(float a, float b, float c, float d) {
    a = __builtin_amdgcn_fmed3f(a, -448.f, 448.f); b = __builtin_amdgcn_fmed3f(b, -448.f, 448.f); c = __builtin_amdgcn_fmed3f(c, -448.f, 448.f); d = __builtin_amdgcn_fmed3f(d, -448.f, 448.f);
    int r = __builtin_amdgcn_cvt_pk_fp8_f32(a, b, 0, false); r = __builtin_amdgcn_cvt_pk_fp8_f32(c, d, r, true); return (unsigned)r; }
struct EpiSwiGLU8 {
    static constexpr bool PERM = true, AFTER_DRAIN = false;
    unsigned char* O; int ldc; float sin, sout;
    __device__ __forceinline__ void operator()(const f32x4 (&acc)[2][2][4][2], const Unit& u, int wr, int wc, int fr, int fq) const {
        const int row0 = u.pm * BM + wr * 64 + fr, col0 = u.pn * HALF + wc * 32 + 8 * fq;
#pragma unroll
        for (int ai = 0; ai < 2; ++ai)
#pragma unroll
            for (int m = 0; m < 4; ++m) { unsigned char* rowp = O + (size_t)(row0 + ai * HALF + m * 16) * ldc + col0;
                const f32x4 g0 = acc[ai][0][m][0] * sin, g1 = acc[ai][0][m][1] * sin, u0 = acc[ai][1][m][0] * (sin * sout), u1 = acc[ai][1][m][1] * (sin * sout);
                u32x2 w; w.x = pk4_fp8(silu_mul(g0[0], u0[0]), silu_mul(g0[1], u0[1]), silu_mul(g0[2], u0[2]), silu_mul(g0[3], u0[3]));
                w.y = pk4_fp8(silu_mul(g1[0], u1[0]), silu_mul(g1[1], u1[1]), silu_mul(g1[2], u1[2]), silu_mul(g1[3], u1[3]));
                *(u32x2*)rowp = w; }
    }
};
struct EpiKVQ {
    static constexpr bool PERM = true, AFTER_DRAIN = false;
    bf16_t* K16; bf16_t* V16; bf16_t* Q16; const float* rope; int S; const float* ssp; float inv_n, eps;
    __device__ __forceinline__ void operator()(const f32x4 (&acc)[2][2][4][2], const Unit& u, int wr, int wc, int fr, int fq) const {
        const int row0 = u.pm * BM + wr * 64 + fr;
        const int kind = u.pn >> 3, head = u.pn & 7;
        if (kind == 1) {
#pragma unroll
            for (int ai = 0; ai < 2; ++ai)
#pragma unroll
                for (int m = 0; m < 4; ++m) { const int row = row0 + ai * HALF + m * 16; const float rs = row_rstd(ssp, row, inv_n, eps);
#pragma unroll
                    for (int bj = 0; bj < 2; ++bj) { const f32x4 v0 = acc[ai][bj][m][0] * rs, v1 = acc[ai][bj][m][1] * rs;
                        u32x4 w; w.x = cvt_pk_bf16(v0[0], v0[1]); w.y = cvt_pk_bf16(v0[2], v0[3]); w.z = cvt_pk_bf16(v1[0], v1[1]); w.w = cvt_pk_bf16(v1[2], v1[3]);
                        *(u32x4*)(V16 + ((size_t)head * S + row) * 256 + bj * 128 + wc * 32 + 8 * fq) = w; } }
        } else {
            bf16_t* dst = (kind == 0 ? K16 : Q16) + (size_t)(head * 2 + (wc >> 1)) * S * 128;
            const int d0 = (wc & 1) * 32 + 8 * fq;
#pragma unroll
            for (int ai = 0; ai < 2; ++ai)
#pragma unroll
                for (int m = 0; m < 4; ++m) { const int row = row0 + ai * HALF + m * 16; const float rs = row_rstd(ssp, row, inv_n, eps);
                    const f32x4* cs = (const f32x4*)(rope + ((size_t)row * 64 + d0) * 2);
                    const f32x4 c01 = cs[0], c23 = cs[1], c45 = cs[2], c67 = cs[3];
                    const f32x4 a0 = acc[ai][0][m][0] * rs, a1 = acc[ai][0][m][1] * rs, b0 = acc[ai][1][m][0] * rs, b1 = acc[ai][1][m][1] * rs;
                    float o1[8], o2[8];
                    o1[0] = a0[0] * c01[0] - b0[0] * c01[1]; o2[0] = b0[0] * c01[0] + a0[0] * c01[1];
                    o1[1] = a0[1] * c01[2] - b0[1] * c01[3]; o2[1] = b0[1] * c01[2] + a0[1] * c01[3];
                    o1[2] = a0[2] * c23[0] - b0[2] * c23[1]; o2[2] = b0[2] * c23[0] + a0[2] * c23[1];
                    o1[3] = a0[3] * c23[2] - b0[3] * c23[3]; o2[3] = b0[3] * c23[2] + a0[3] * c23[3];
                    o1[4] = a1[0] * c45[0] - b1[0] * c45[1]; o2[4] = b1[0] * c45[0] + a1[0] * c45[1];
                    o1[5] = a1[1] * c45[2] - b1[1] * c45[3]; o2[5] = b1[1] * c45[2] + a1[1] * c45[3];
                    o1[6] = a1[2] * c67[0] - b1[2] * c67[1]; o2[6] = b1[2] * c67[0] + a1[2] * c67[1];
                    o1[7] = a1[3] * c67[2] - b1[3] * c67[3]; o2[7] = b1[3] * c67[2] + a1[3] * c67[3];
                    u32x4 w1, w2; w1.x = cvt_pk_bf16(o1[0], o1[1]); w1.y = cvt_pk_bf16(o1[2], o1[3]); w1.z = cvt_pk_bf16(o1[4], o1[5]); w1.w = cvt_pk_bf16(o1[6], o1[7]);
                    w2.x = cvt_pk_bf16(o2[0], o2[1]); w2.y = cvt_pk_bf16(o2[2], o2[3]); w2.z = cvt_pk_bf16(o2[4], o2[5]); w2.w = cvt_pk_bf16(o2[6], o2[7]);
                    bf16_t* rp = dst + (size_t)row * 128 + d0;
                    *(u32x4*)rp = w1; *(u32x4*)(rp + 64) = w2; }
        }
    }
};

template <class Epi, class Sched, bool ALIGN_EPI = false, bool SP2 = false, bool F8 = false>
__device__ __forceinline__ void gemm_phase(PG8_LAS unsigned char* lds, const int rowbytes  , const Sched& S, const Epi& E, const int wave_id, const int kbytes = 0  ) {
    const int lane = fresh_lane(), wid = wave_id, tid = wid * 64 + lane, wr = wid >> 2, wc = wid & 3, fr = lane & 15, fq = lane >> 4;
    const int nt = (kbytes ? kbytes : rowbytes) / (BK * 2);
    unsigned voffA[2], voffB[2];
#pragma unroll
    for (int i = 0; i < 2; ++i) { int R, C; stage_rc(tid * 16 + i * 8192, R, C); const int Rb = Epi::PERM ? ((R & ~31) + perm32(R & 31)) : R;
        voffA[i] = (unsigned)(R * rowbytes + C * 2); voffB[i] = (unsigned)(Rb * rowbytes + C * 2); }
    const size_t kstep = (size_t)(BK * 2);
    const size_t hstep = (size_t)HALF * rowbytes;
    const unsigned ldsw = (unsigned)wid * 1024u;
    const int aoff = lds_byte(wr * 64 + fr, fq * 8), boff = lds_byte(wc * 32 + fr, fq * 8);
#define PG8_SA(b, h) (((b) * 2 + (h)) * HTB)
#define PG8_SB(b, h) ((4 + (b) * 2 + (h)) * HTB)
#define PG8_STAGE(bufoff, gbase, voff) do { _Pragma("unroll") for (int _i = 0; _i < 2; ++_i) \
        __builtin_amdgcn_global_load_lds((const unsigned*)((const char*)(gbase) + (voff)[_i]), (PG8_LAS unsigned*)(lds + (bufoff) + ldsw + _i * 8192), 16, 0, 0); } while (0)
#define PG8_LDA(dst, b, h) do { _Pragma("unroll") for (int m = 0; m < 4; ++m) { if constexpr (F8) { dst##8[m] = __builtin_shufflevector(*(const PG8_LAS i32x4*)(lds + PG8_SA(b, h) + aoff + m * 2048), *(const PG8_LAS i32x4*)(lds + PG8_SA(b, h) + aoff + m * 2048 + 1024), 0, 1, 2, 3, 4, 5, 6, 7); } \
        else { _Pragma("unroll") for (int k = 0; k < 2; ++k) dst[m][k] = *(const PG8_LAS bf16x8*)(lds + PG8_SA(b, h) + aoff + m * 2048 + k * 1024); } } } while (0)
#define PG8_LDB(dst, b, h) do { _Pragma("unroll") for (int n = 0; n < 2; ++n) { if constexpr (F8) { dst##8[n] = __builtin_shufflevector(*(const PG8_LAS i32x4*)(lds + PG8_SB(b, h) + boff + n * 2048), *(const PG8_LAS i32x4*)(lds + PG8_SB(b, h) + boff + n * 2048 + 1024), 0, 1, 2, 3, 4, 5, 6, 7); } \
        else { _Pragma("unroll") for (int k = 0; k < 2; ++k) dst[n][k] = *(const PG8_LAS bf16x8*)(lds + PG8_SB(b, h) + boff + n * 2048 + k * 1024); } } } while (0)
#define PG8_MMA(ai, bj, At, Bt) do { __builtin_amdgcn_s_setprio(1); _Pragma("unroll") for (int m = 0; m < 4; ++m) _Pragma("unroll") for (int n = 0; n < 2; ++n) { \
        if constexpr (F8) { asm volatile("v_mfma_scale_f32_16x16x128_f8f6f4 %0, %1, %2, %0, %3, %3 op_sel_hi:[0,0,0]" : "+v"(acc[ai][bj][m][n]) : "v"(Bt##8[n]), "v"(At##8[m]), "v"(sc1)); }     \
        else { _Pragma("unroll") for (int k = 0; k < 2; ++k) acc[ai][bj][m][n] = __builtin_amdgcn_mfma_f32_16x16x32_bf16(Bt[n][k], At[m][k], acc[ai][bj][m][n], 0, 0, 0); } } \
        __builtin_amdgcn_s_setprio(0); } while (0)
#define PG8_WAIT_V(n) asm volatile("s_waitcnt vmcnt(" #n ")" ::: "memory")
#define PG8_WAIT_L(n) asm volatile("s_waitcnt lgkmcnt(" #n ")" ::: "memory")
#define PG8_BAR __builtin_amdgcn_s_barrier()
#define PG8_SCHED __builtin_amdgcn_sched_barrier(0)
    Unit cur, nxt; int ui = 0;
    if (!S.next(0, cur)) return;
    f32x4 acc[2][2][4][2];
#pragma unroll
    for (int a = 0; a < 2; ++a)
#pragma unroll
        for (int b = 0; b < 2; ++b)
#pragma unroll
            for (int m = 0; m < 4; ++m)
#pragma unroll
                for (int n = 0; n < 2; ++n) acc[a][b][m][n] = (f32x4){0.f, 0.f, 0.f, 0.f};
    const int sc1 = 0x7f7f7f7f;
    bf16x8 At[4][2], B0[2][2], B1[2][2]; i32x8 At8[4], B08[2], B18[2];
    const char* cA = cur.A; const char* cB = cur.B;
    S.a_ready(cur);
    if constexpr (SP2) {
        PG8_STAGE(PG8_SB(0, 0), cB, voffB); PG8_STAGE(PG8_SB(0, 1), cB + hstep, voffB); PG8_STAGE(PG8_SA(0, 0), cA, voffA); PG8_STAGE(PG8_SA(0, 1), cA + hstep, voffA);
        if (wr == 1) PG8_BAR;
        PG8_WAIT_V(2); PG8_BAR;
        PG8_STAGE(PG8_SB(1, 0), cB + kstep, voffB); PG8_STAGE(PG8_SA(1, 0), cA + kstep, voffA); PG8_STAGE(PG8_SB(1, 1), cB + hstep + kstep, voffB);
        PG8_WAIT_V(6); PG8_BAR;
    } else {
        PG8_STAGE(PG8_SB(0, 0), cB, voffB); PG8_STAGE(PG8_SA(0, 0), cA, voffA); PG8_STAGE(PG8_SB(0, 1), cB + hstep, voffB); PG8_STAGE(PG8_SA(0, 1), cA + hstep, voffA);
        if (wr == 1) PG8_BAR;
        PG8_WAIT_V(4); PG8_BAR;
        PG8_STAGE(PG8_SB(1, 0), cB + kstep, voffB); PG8_STAGE(PG8_SA(1, 0), cA + kstep, voffA); PG8_STAGE(PG8_SB(1, 1), cB + hstep + kstep, voffB);
        PG8_WAIT_V(6); PG8_BAR;
    }
    for (;;) {
        const bool has_next = S.next(ui + 1, nxt);
        const char* nA = has_next ? nxt.A : cA; const char* nB = has_next ? nxt.B : cB;
        for (int t = 0; t < nt; t += 2) {
            const bool last = (t == nt - 2);
            const char* a1 = cA + (size_t)(t + 1) * kstep;
            const char* a2 = last ? nA : cA + (size_t)(t + 2) * kstep; const char* b2 = last ? nB : cB + (size_t)(t + 2) * kstep;
            const char* a3 = a2 + kstep; const char* b3 = b2 + kstep;
            if (last && has_next) S.a_ready(nxt);
            if constexpr (SP2) {
            PG8_LDB(B0, 0, 0); PG8_LDB(B1, 0, 1); PG8_SCHED; PG8_LDA(At, 0, 0); PG8_STAGE(PG8_SA(1, 1), a1 + hstep, voffA);
            PG8_WAIT_V(8); PG8_WAIT_L(0); PG8_BAR; PG8_MMA(0, 0, At, B0); PG8_MMA(0, 1, At, B1); PG8_BAR; PG8_SCHED;
            PG8_LDA(At, 0, 1); PG8_STAGE(PG8_SB(0, 0), b2, voffB); PG8_STAGE(PG8_SB(0, 1), b2 + hstep, voffB); PG8_STAGE(PG8_SA(0, 0), a2, voffA);
            PG8_WAIT_V(8); PG8_WAIT_L(0); PG8_BAR; PG8_MMA(1, 0, At, B0); PG8_MMA(1, 1, At, B1); PG8_BAR; PG8_SCHED;
            PG8_LDB(B0, 1, 0); PG8_LDB(B1, 1, 1); PG8_SCHED; PG8_LDA(At, 1, 0); PG8_STAGE(PG8_SA(0, 1), a2 + hstep, voffA);
            PG8_WAIT_V(8); PG8_WAIT_L(0); PG8_BAR; PG8_MMA(0, 0, At, B0); PG8_MMA(0, 1, At, B1); PG8_BAR; PG8_SCHED;
            PG8_LDA(At, 1, 1); PG8_STAGE(PG8_SB(1, 0), b3, voffB); PG8_STAGE(PG8_SB(1, 1), b3 + hstep, voffB); PG8_STAGE(PG8_SA(1, 0), a3, voffA);
            PG8_WAIT_V(8); PG8_WAIT_L(0); PG8_BAR; PG8_MMA(1, 0, At, B0); PG8_MMA(1, 1, At, B1); PG8_BAR; PG8_SCHED;
            } else {
            PG8_LDB(B0, 0, 0); PG8_SCHED; PG8_LDA(At, 0, 0); PG8_STAGE(PG8_SA(1, 1), a1 + hstep, voffA);
            PG8_WAIT_L(8); PG8_BAR; PG8_WAIT_L(0); PG8_MMA(0, 0, At, B0); PG8_BAR; PG8_SCHED;
            PG8_LDB(B1, 0, 1); PG8_STAGE(PG8_SB(0, 0), b2, voffB);
            PG8_BAR; PG8_WAIT_L(0); PG8_MMA(0, 1, At, B1); PG8_BAR;
            PG8_LDA(At, 0, 1); PG8_STAGE(PG8_SA(0, 0), a2, voffA);
            PG8_BAR; PG8_WAIT_L(0); PG8_MMA(1, 0, At, B0); PG8_BAR; PG8_SCHED;
            PG8_STAGE(PG8_SB(0, 1), b2 + hstep, voffB);
            PG8_WAIT_V(6); PG8_BAR; PG8_MMA(1, 1, At, B1); PG8_BAR;
            PG8_LDB(B0, 1, 0); PG8_SCHED; PG8_LDA(At, 1, 0); PG8_STAGE(PG8_SA(0, 1), a2 + hstep, voffA);
            PG8_WAIT_L(8); PG8_BAR; PG8_WAIT_L(0); PG8_MMA(0, 0, At, B0); PG8_BAR; PG8_SCHED;
            PG8_LDB(B1, 1, 1); PG8_STAGE(PG8_SB(1, 0), b3, voffB);
            PG8_BAR; PG8_WAIT_L(0); PG8_MMA(0, 1, At, B1); PG8_BAR;
            PG8_LDA(At, 1, 1); PG8_STAGE(PG8_SA(1, 0), a3, voffA);
            PG8_BAR; PG8_WAIT_L(0); PG8_MMA(1, 0, At, B0); PG8_BAR; PG8_SCHED;
            PG8_STAGE(PG8_SB(1, 1), b3 + hstep, voffB);
            PG8_WAIT_V(6); PG8_BAR; PG8_MMA(1, 1, At, B1); PG8_BAR;
            }
        }
        if constexpr (ALIGN_EPI) { if (wr == 0) PG8_BAR; }
        if constexpr (F8) { asm volatile("s_nop 15\n\ts_nop 15" ::: "memory"); }
        if constexpr (!Epi::AFTER_DRAIN) { const int le_ = fresh_lane(); E(acc, cur, wr, wc, le_ & 15, le_ >> 4); S.done(cur); }
        if (!has_next) break;
#pragma unroll
        for (int a = 0; a < 2; ++a)
#pragma unroll
            for (int b = 0; b < 2; ++b)
#pragma unroll
                for (int m = 0; m < 4; ++m)
#pragma unroll
                    for (int n = 0; n < 2; ++n) acc[a][b][m][n] = (f32x4){0.f, 0.f, 0.f, 0.f};
        if constexpr (F8) { asm volatile("s_nop 7" ::: "memory"); }
        cur = nxt; cA = nA; cB = nB; ++ui;
        if constexpr (ALIGN_EPI) { if (wr == 1) PG8_BAR; }
    }
    PG8_WAIT_V(0);
    if constexpr (!ALIGN_EPI) { if (wr == 0) PG8_BAR; }
    PG8_BAR;
    if constexpr (Epi::AFTER_DRAIN) { E.fused(acc, cur, wr, wc, fr, fq, lds, wid, lane); S.done(cur); }
#undef PG8_SA
#undef PG8_SB
#undef PG8_STAGE
#undef PG8_LDA
#undef PG8_LDB
#undef PG8_MMA
#undef PG8_WAIT_V
#undef PG8_WAIT_L
#undef PG8_BAR
#undef PG8_SCHED
}

}

namespace attn {
constexpr int D = 128; constexpr float THR = 8.f; constexpr bool WSKIP = false;
constexpr float SCALE = 0.08838834764831845f;
constexpr int NW = 8, QBLK = 32, KVBLK = 64, QB = NW * QBLK;
constexpr int DV = 256;
constexpr int SHM_V = KVBLK * DV * 2, SHM_K = KVBLK * D * 2;
constexpr int LDS_BYTES = 2 * SHM_V + 2 * SHM_K + NW * 64 * 4;

using bf16 = __hip_bfloat16;
typedef short bf16x8 __attribute__((ext_vector_type(8)));
typedef short s16x4 __attribute__((ext_vector_type(4)));
typedef float f32x16 __attribute__((ext_vector_type(16)));
typedef float f32x4 __attribute__((ext_vector_type(4)));
typedef unsigned u32x4 __attribute__((ext_vector_type(4)));
template <class A, class Bt> struct same_t { static constexpr bool v = false; };
template <class A> struct same_t<A, A> { static constexpr bool v = true; };

#define KSWZ(row, colB) ((row) * 256 + ((colB) ^ (((row) & 7) << 4)))
#define SBAR() __builtin_amdgcn_sched_barrier(0)
__device__ __forceinline__ int v_st(int k, int c) { const int kk = (k & ~0xC) | ((k & 4) << 1) | ((k & 8) >> 1); return ((kk >> 3) * 4 + (c >> 5)) * 512 + ((kk & 7) * 32 + (c & 31)) * 2; }
__device__ __forceinline__ int v_rd_base(int lane) { return ((lane & 3) << 3) | (((lane >> 2) & 3) << 6) | (((lane >> 4) & 1) << 5) | (((lane >> 5) & 1) << 8); }
constexpr int v_rd_off(int d0, int ks, int half) { return d0 * 512 + ks * 4096 + half * 2048; }
__device__ __forceinline__ int crow(int r, int hi) { return (r & 3) + 8 * (r >> 2) + 4 * hi; }
__device__ __forceinline__ unsigned cvtpk(float lo, float hi) {
    unsigned r; asm volatile("v_cvt_pk_bf16_f32 %0, %1, %2" : "=v"(r) : "v"(lo), "v"(hi)); return r;
}
__device__ __forceinline__ bf16x8 pack8(f32x4 a, f32x4 b) {
    u32x4 w = {cvtpk(a[0], a[1]), cvtpk(a[2], a[3]), cvtpk(b[0], b[1]), cvtpk(b[2], b[3])};
    return *reinterpret_cast<bf16x8*>(&w);
}
template <class T> __device__ __forceinline__ bf16x8 load8(const T* p) {
    if constexpr (same_t<T, float>::v) { return pack8(*(const f32x4*)p, *(const f32x4*)(p + 4)); }
    else { return *reinterpret_cast<const bf16x8*>(p); }
}
__device__ __forceinline__ void mask_tile(f32x16& p0, f32x16& p1, int dq, unsigned W) {
    const float NEG = -__builtin_inff();
#pragma unroll
    for (int r = 0; r < 16; ++r) {
        const int c = (r & 3) + 8 * (r >> 2);
        if ((unsigned)(dq - c) >= W) p0[r] = NEG;
        if ((unsigned)(dq - c - 32) >= W) p1[r] = NEG;
    }
}
__device__ __forceinline__ void partialSM(f32x16& p0, f32x16& p1, float& m_reg, float& mn, float& alpha) {
    float pmax = p0[0]; for (int r = 1; r < 16; ++r) pmax = fmaxf(pmax, p0[r]); for (int r = 0; r < 16; ++r) pmax = fmaxf(pmax, p1[r]);
    { auto rr = __builtin_amdgcn_permlane32_swap(__float_as_uint(pmax), __float_as_uint(pmax), false, false);
      pmax = fmaxf(__uint_as_float(rr[0]), __uint_as_float(rr[1])); }
    constexpr float C2 = 1.4426950408889634f * SCALE;
    if (__builtin_expect(__all((pmax - m_reg) * SCALE <= THR), 1)) { mn = m_reg; alpha = 1.f; }
    else { mn = fmaxf(m_reg, pmax); alpha = __builtin_amdgcn_exp2f((m_reg - mn) * C2); m_reg = mn; }
    const float mnL = -mn * C2;
    for (int r = 0; r < 16; ++r) p0[r] = fmaf(p0[r], C2, mnL); for (int r = 0; r < 16; ++r) p1[r] = fmaf(p1[r], C2, mnL);
    for (int r = 0; r < 16; ++r) p0[r] = __builtin_amdgcn_exp2f(p0[r]);
}
__device__ __forceinline__ void finishSM(f32x16& p0, f32x16& p1, float alpha, float& l_reg, bf16x8& pa0, bf16x8& pa1, bf16x8& pa2, bf16x8& pa3) {
    for (int r = 0; r < 16; ++r) p1[r] = __builtin_amdgcn_exp2f(p1[r]);
    float ps = 0; for (int r = 0; r < 16; ++r) ps += p0[r]; for (int r = 0; r < 16; ++r) ps += p1[r];
    { auto rr = __builtin_amdgcn_permlane32_swap(__float_as_uint(ps), __float_as_uint(ps), false, false);
      ps = __uint_as_float(rr[0]) + __uint_as_float(rr[1]); }
    l_reg = l_reg * alpha + ps;
#define PK4(P, B_, OUT) do { unsigned a0 = cvtpk(P[B_+0], P[B_+1]), a1 = cvtpk(P[B_+2], P[B_+3]);                          \
        unsigned b0 = cvtpk(P[B_+4], P[B_+5]), b1 = cvtpk(P[B_+6], P[B_+7]);                                             \
        auto r0 = __builtin_amdgcn_permlane32_swap(a0, b0, false, false); auto r1 = __builtin_amdgcn_permlane32_swap(a1, b1, false, false); \
        u32x4 w = {r0[0], r1[0], r0[1], r1[1]}; OUT = *reinterpret_cast<bf16x8*>(&w); } while (0)
    PK4(p0, 0, pa0); PK4(p0, 8, pa1); PK4(p1, 0, pa2); PK4(p1, 8, pa3);
#undef PK4
}
template <int KB, bool SK>
__device__ __forceinline__ void qkt(f32x16& p0, f32x16& p1, const char* K_lds, int r32, int hi, const bf16x8* qr, bool act) {
    if (SK && !act) { const float NEG = -__builtin_inff();
#pragma unroll
        for (int r = 0; r < 16; ++r) { p0[r] = NEG; p1[r] = NEG; } return; }
    p0 = f32x16{}; p1 = f32x16{};
    const char* kb[4];
#pragma unroll
    for (int dd = 0; dd < 4; ++dd) kb[dd] = K_lds + KB * SHM_K + KSWZ(r32, (dd * 16 + hi * 8) * 2);
#pragma unroll
    for (int d0 = 0; d0 < 8; ++d0) { const char* a = kb[d0 & 3] + (d0 >> 2) * 128;
        bf16x8 b0 = *reinterpret_cast<const bf16x8*>(a);
        bf16x8 b1 = *reinterpret_cast<const bf16x8*>(a + 32 * 256);
        p0 = __builtin_amdgcn_mfma_f32_32x32x16_bf16(b0, qr[d0], p0, 0, 0, 0);
        p1 = __builtin_amdgcn_mfma_f32_32x32x16_bf16(b1, qr[d0], p1, 0, 0, 0); }
}


#define AT2_LAS __attribute__((address_space(3)))
template <int VB>
__device__ __forceinline__ void pv_tile8(f32x16* o, const AT2_LAS char* vb, bf16x8 pa0, bf16x8 pa1, bf16x8 pa2, bf16x8 pa3) {
#define TRR(off) __builtin_amdgcn_ds_read_tr16_b64_v4i16((AT2_LAS s16x4*)(vb + (off)))
#pragma unroll
    for (int d0 = 0; d0 < 8; ++d0) { const int b_ = VB * SHM_V + d0 * 512;
        const s16x4 l0 = TRR(b_), h0 = TRR(b_ + 4096), l1 = TRR(b_ + 8192), h1 = TRR(b_ + 12288), l2 = TRR(b_ + 16384), h2 = TRR(b_ + 20480), l3 = TRR(b_ + 24576), h3 = TRR(b_ + 28672);
        o[d0] = __builtin_amdgcn_mfma_f32_32x32x16_bf16(pa0, (bf16x8){l0[0], l0[1], l0[2], l0[3], h0[0], h0[1], h0[2], h0[3]}, o[d0], 0, 0, 0);
        o[d0] = __builtin_amdgcn_mfma_f32_32x32x16_bf16(pa1, (bf16x8){l1[0], l1[1], l1[2], l1[3], h1[0], h1[1], h1[2], h1[3]}, o[d0], 0, 0, 0);
        o[d0] = __builtin_amdgcn_mfma_f32_32x32x16_bf16(pa2, (bf16x8){l2[0], l2[1], l2[2], l2[3], h2[0], h2[1], h2[2], h2[3]}, o[d0], 0, 0, 0);
        o[d0] = __builtin_amdgcn_mfma_f32_32x32x16_bf16(pa3, (bf16x8){l3[0], l3[1], l3[2], l3[3], h3[0], h3[1], h3[2], h3[3]}, o[d0], 0, 0, 0); }
#undef TRR
}
__device__ __forceinline__ void softmax_main(f32x16& p0, f32x16& p1, float& m_reg, float& alpha, float& ps) {
    float pmax = p0[0];
#pragma unroll
    for (int r = 1; r < 16; ++r) pmax = fmaxf(pmax, p0[r]);
#pragma unroll
    for (int r = 0; r < 16; ++r) pmax = fmaxf(pmax, p1[r]);
    { auto rr = __builtin_amdgcn_permlane32_swap(__float_as_uint(pmax), __float_as_uint(pmax), false, false);
      pmax = fmaxf(__uint_as_float(rr[0]), __uint_as_float(rr[1])); }
    constexpr float C2 = 1.4426950408889634f * SCALE;
    const bool keep = __all((pmax - m_reg) * SCALE <= THR);
    const float mn = keep ? m_reg : fmaxf(m_reg, pmax);
    alpha = __builtin_amdgcn_exp2f((m_reg - mn) * C2);
    m_reg = mn;
    const float mnL = -mn * C2;
#pragma unroll
    for (int r = 0; r < 16; ++r) { p0[r] = __builtin_amdgcn_exp2f(fmaf(p0[r], C2, mnL)); p1[r] = __builtin_amdgcn_exp2f(fmaf(p1[r], C2, mnL)); }
    float s = 0.f;
#pragma unroll
    for (int r = 0; r < 16; ++r) s += p0[r];
#pragma unroll
    for (int r = 0; r < 16; ++r) s += p1[r];
    { auto rr = __builtin_amdgcn_permlane32_swap(__float_as_uint(s), __float_as_uint(s), false, false);
      ps = __uint_as_float(rr[0]) + __uint_as_float(rr[1]); }
}
__device__ __forceinline__ void pack_p(const f32x16& p0, const f32x16& p1, bf16x8& pa0, bf16x8& pa1, bf16x8& pa2, bf16x8& pa3) {
#define PK4(P, B_, OUT) do { unsigned a0 = cvtpk(P[B_+0], P[B_+1]), a1 = cvtpk(P[B_+2], P[B_+3]);                          \
        unsigned b0 = cvtpk(P[B_+4], P[B_+5]), b1 = cvtpk(P[B_+6], P[B_+7]);                                             \
        auto r0 = __builtin_amdgcn_permlane32_swap(a0, b0, false, false); auto r1 = __builtin_amdgcn_permlane32_swap(a1, b1, false, false); \
        u32x4 w = {r0[0], r1[0], r0[1], r1[1]}; OUT = *reinterpret_cast<bf16x8*>(&w); } while (0)
    PK4(p0, 0, pa0); PK4(p0, 8, pa1); PK4(p1, 0, pa2); PK4(p1, 8, pa3);
#undef PK4
}
struct Block2 { const bf16* Q; const bf16* K; const bf16* V; unsigned short* O; int P0; };
__device__ __forceinline__ void attn_block2(const Block2& cur, char* lds, AT2_LAS unsigned char* L, const int wave_id) {
    const int lane = fresh_lane(), wid = wave_id, r32 = lane & 31, hi = lane >> 5;
    const int NT = (cur.P0 + QB - 1) / KVBLK + 1;
    const int qlo = cur.P0 + wid * QBLK;
    char* K_lds = lds + 2 * SHM_V;
    float* ws = (float*)(lds + 2 * SHM_V + 2 * SHM_K) + wid * 64; float* li_l = ws, * al_l = ws + 32;
#define AT2_GLDS(g, l) __builtin_amdgcn_global_load_lds((const unsigned*)(g), (AT2_LAS unsigned*)(l), 16, 0, 0)
#define AT2_DMA_K(t, b) do { const char* kg_ = (const char*)cur.K + (size_t)(t) * (KVBLK * D * 2); const unsigned ln_ = (unsigned)fresh_lane(), kr0 = 8u * wid + (ln_ >> 4), kr1 = kr0 + 4u; \
        const unsigned koff0 = kr0 * 256u + (((ln_ & 15u) ^ (kr0 & 7u)) << 4), koff1 = kr1 * 256u + (((ln_ & 15u) ^ (kr1 & 7u)) << 4); \
        AT2_GLDS(kg_ + koff0, L + 2 * SHM_V + (b) * SHM_K + (2 * wid) * 1024); AT2_GLDS(kg_ + koff1, L + 2 * SHM_V + (b) * SHM_K + (2 * wid + 1) * 1024); } while (0)
#define AT2_DMA_V(t, b) do { const char* vg_ = (const char*)cur.V + (size_t)(t) * (KVBLK * DV * 2); const unsigned ln_ = (unsigned)fresh_lane(), kkv = 8u * wid + ((ln_ & 31u) >> 2); \
        const unsigned keyv = (kkv & ~0xCu) | ((kkv & 4u) << 1) | ((kkv & 8u) >> 1), voff = keyv * 512u + (ln_ >> 5) * 64u + (ln_ & 3u) * 16u; \
        _Pragma("unroll") for (int i_ = 0; i_ < 4; ++i_) AT2_GLDS(vg_ + i_ * 128 + voff, L + (b) * SHM_V + (4 * wid + i_) * 1024); } while (0)
    bf16x8 qr[8];
#pragma unroll
    for (int d0 = 0; d0 < 8; ++d0) qr[d0] = load8<bf16>(cur.Q + (size_t)(wid * QBLK + r32) * D + d0 * 16 + hi * 8);
    AT2_DMA_K(0, 0);
    float m_reg = -1e30f, l_reg = 0; f32x16 o[8] = {};
    f32x16 p0, p1; float al, ps; bf16x8 pa0, pa1, pa2, pa3;
#define RESC(a) do { if (__any((a) < 1.f)) { const int lr_ = fresh_lane(), hr_ = lr_ >> 5; if (hr_ == 0) al_l[lr_ & 31] = (a); asm volatile("s_waitcnt lgkmcnt(0)" ::: "memory");              \
                     for (int d_ = 0; d_ < 8; ++d_) for (int r = 0; r < 16; ++r) o[d_][r] *= al_l[crow(r, hr_)]; } } while (0)
#define AT2_TRR(off) __builtin_amdgcn_ds_read_tr16_b64_v4i16((AT2_LAS s16x4*)(vb + (off)))
#define MX3(a_, b_, c_) fmaxf(fmaxf((a_), (b_)), (c_))
#define AT2_PV_SM(VB) do { const AT2_LAS char* vb = (const AT2_LAS char*)L + v_rd_base(fresh_lane()); constexpr float C2_ = 1.4426950408889634f * SCALE; float mxa, mxb, mnL_; ps = 0.f; s16x4 fl0, fh0, fl1, fh1, fl2, fh2, fl3, fh3; \
        constexpr int vbo_ = (VB) * SHM_V; \
        fl0 = AT2_TRR(vbo_ + 0); fh0 = AT2_TRR(vbo_ + 4096); \
        fl1 = AT2_TRR(vbo_ + 8192); fh1 = AT2_TRR(vbo_ + 12288); \
        fl2 = AT2_TRR(vbo_ + 16384); fh2 = AT2_TRR(vbo_ + 20480); \
        fl3 = AT2_TRR(vbo_ + 24576); fh3 = AT2_TRR(vbo_ + 28672); \
        SBAR(); \
        o[0] = __builtin_amdgcn_mfma_f32_32x32x16_bf16(pa0, (bf16x8){fl0[0], fl0[1], fl0[2], fl0[3], fh0[0], fh0[1], fh0[2], fh0[3]}, o[0], 0, 0, 0); fl0 = AT2_TRR(vbo_ + 512); fh0 = AT2_TRR(vbo_ + 4608); mxa = MX3(p0[0], p0[1], p0[2]); mxb = MX3(p1[0], p1[1], p1[2]); mxa = MX3(mxa, p0[3], p0[4]); mxb = MX3(mxb, p1[3], p1[4]); SBAR(); \
        o[0] = __builtin_amdgcn_mfma_f32_32x32x16_bf16(pa1, (bf16x8){fl1[0], fl1[1], fl1[2], fl1[3], fh1[0], fh1[1], fh1[2], fh1[3]}, o[0], 0, 0, 0); fl1 = AT2_TRR(vbo_ + 8704); fh1 = AT2_TRR(vbo_ + 12800); mxa = MX3(mxa, p0[5], p0[6]); mxb = MX3(mxb, p1[5], p1[6]); mxa = MX3(mxa, p0[7], p0[8]); mxb = MX3(mxb, p1[7], p1[8]); SBAR(); \
        o[0] = __builtin_amdgcn_mfma_f32_32x32x16_bf16(pa2, (bf16x8){fl2[0], fl2[1], fl2[2], fl2[3], fh2[0], fh2[1], fh2[2], fh2[3]}, o[0], 0, 0, 0); fl2 = AT2_TRR(vbo_ + 16896); fh2 = AT2_TRR(vbo_ + 20992); mxa = MX3(mxa, p0[9], p0[10]); mxb = MX3(mxb, p1[9], p1[10]); mxa = MX3(mxa, p0[11], p0[12]); mxb = MX3(mxb, p1[11], p1[12]); SBAR(); \
        o[0] = __builtin_amdgcn_mfma_f32_32x32x16_bf16(pa3, (bf16x8){fl3[0], fl3[1], fl3[2], fl3[3], fh3[0], fh3[1], fh3[2], fh3[3]}, o[0], 0, 0, 0); fl3 = AT2_TRR(vbo_ + 25088); fh3 = AT2_TRR(vbo_ + 29184); mxa = MX3(mxa, p0[13], p0[14]); mxb = MX3(mxb, p1[13], p1[14]); mxa = fmaxf(mxa, p0[15]); mxb = fmaxf(mxb, p1[15]); SBAR(); \
        o[1] = __builtin_amdgcn_mfma_f32_32x32x16_bf16(pa0, (bf16x8){fl0[0], fl0[1], fl0[2], fl0[3], fh0[0], fh0[1], fh0[2], fh0[3]}, o[1], 0, 0, 0); fl0 = AT2_TRR(vbo_ + 1024); fh0 = AT2_TRR(vbo_ + 5120); mxa = fmaxf(mxa, mxb); { auto rr_ = __builtin_amdgcn_permlane32_swap(__float_as_uint(mxa), __float_as_uint(mxa), false, false); mxa = fmaxf(__uint_as_float(rr_[0]), __uint_as_float(rr_[1])); } SBAR(); \
        o[1] = __builtin_amdgcn_mfma_f32_32x32x16_bf16(pa1, (bf16x8){fl1[0], fl1[1], fl1[2], fl1[3], fh1[0], fh1[1], fh1[2], fh1[3]}, o[1], 0, 0, 0); fl1 = AT2_TRR(vbo_ + 9216); fh1 = AT2_TRR(vbo_ + 13312); { const bool keep_ = __all((mxa - m_reg) * SCALE <= THR); const float mn_ = keep_ ? m_reg : fmaxf(m_reg, mxa); al = __builtin_amdgcn_exp2f((m_reg - mn_) * C2_); m_reg = mn_; mnL_ = -mn_ * C2_; } SBAR(); \
        o[1] = __builtin_amdgcn_mfma_f32_32x32x16_bf16(pa2, (bf16x8){fl2[0], fl2[1], fl2[2], fl2[3], fh2[0], fh2[1], fh2[2], fh2[3]}, o[1], 0, 0, 0); fl2 = AT2_TRR(vbo_ + 17408); fh2 = AT2_TRR(vbo_ + 21504); p0[0] = __builtin_amdgcn_exp2f(fmaf(p0[0], C2_, mnL_)); p0[1] = __builtin_amdgcn_exp2f(fmaf(p0[1], C2_, mnL_)); SBAR(); \
        o[1] = __builtin_amdgcn_mfma_f32_32x32x16_bf16(pa3, (bf16x8){fl3[0], fl3[1], fl3[2], fl3[3], fh3[0], fh3[1], fh3[2], fh3[3]}, o[1], 0, 0, 0); fl3 = AT2_TRR(vbo_ + 25600); fh3 = AT2_TRR(vbo_ + 29696); ps += p0[0]; ps += p0[1]; p0[2] = __builtin_amdgcn_exp2f(fmaf(p0[2], C2_, mnL_)); SBAR(); \
        o[2] = __builtin_amdgcn_mfma_f32_32x32x16_bf16(pa0, (bf16x8){fl0[0], fl0[1], fl0[2], fl0[3], fh0[0], fh0[1], fh0[2], fh0[3]}, o[2], 0, 0, 0); fl0 = AT2_TRR(vbo_ + 1536); fh0 = AT2_TRR(vbo_ + 5632); ps += p0[2]; p0[3] = __builtin_amdgcn_exp2f(fmaf(p0[3], C2_, mnL_)); p0[4] = __builtin_amdgcn_exp2f(fmaf(p0[4], C2_, mnL_)); SBAR(); \
        o[2] = __builtin_amdgcn_mfma_f32_32x32x16_bf16(pa1, (bf16x8){fl1[0], fl1[1], fl1[2], fl1[3], fh1[0], fh1[1], fh1[2], fh1[3]}, o[2], 0, 0, 0); fl1 = AT2_TRR(vbo_ + 9728); fh1 = AT2_TRR(vbo_ + 13824); ps += p0[3]; ps += p0[4]; p0[5] = __builtin_amdgcn_exp2f(fmaf(p0[5], C2_, mnL_)); SBAR(); \
        o[2] = __builtin_amdgcn_mfma_f32_32x32x16_bf16(pa2, (bf16x8){fl2[0], fl2[1], fl2[2], fl2[3], fh2[0], fh2[1], fh2[2], fh2[3]}, o[2], 0, 0, 0); fl2 = AT2_TRR(vbo_ + 17920); fh2 = AT2_TRR(vbo_ + 22016); ps += p0[5]; p0[6] = __builtin_amdgcn_exp2f(fmaf(p0[6], C2_, mnL_)); p0[7] = __builtin_amdgcn_exp2f(fmaf(p0[7], C2_, mnL_)); SBAR(); \
        o[2] = __builtin_amdgcn_mfma_f32_32x32x16_bf16(pa3, (bf16x8){fl3[0], fl3[1], fl3[2], fl3[3], fh3[0], fh3[1], fh3[2], fh3[3]}, o[2], 0, 0, 0); fl3 = AT2_TRR(vbo_ + 26112); fh3 = AT2_TRR(vbo_ + 30208); ps += p0[6]; ps += p0[7]; p0[8] = __builtin_amdgcn_exp2f(fmaf(p0[8], C2_, mnL_)); SBAR(); \
        o[3] = __builtin_amdgcn_mfma_f32_32x32x16_bf16(pa0, (bf16x8){fl0[0], fl0[1], fl0[2], fl0[3], fh0[0], fh0[1], fh0[2], fh0[3]}, o[3], 0, 0, 0); fl0 = AT2_TRR(vbo_ + 2048); fh0 = AT2_TRR(vbo_ + 6144); ps += p0[8]; p0[9] = __builtin_amdgcn_exp2f(fmaf(p0[9], C2_, mnL_)); p0[10] = __builtin_amdgcn_exp2f(fmaf(p0[10], C2_, mnL_)); SBAR(); \
        o[3] = __builtin_amdgcn_mfma_f32_32x32x16_bf16(pa1, (bf16x8){fl1[0], fl1[1], fl1[2], fl1[3], fh1[0], fh1[1], fh1[2], fh1[3]}, o[3], 0, 0, 0); fl1 = AT2_TRR(vbo_ + 10240); fh1 = AT2_TRR(vbo_ + 14336); ps += p0[9]; ps += p0[10]; p0[11] = __builtin_amdgcn_exp2f(fmaf(p0[11], C2_, mnL_)); SBAR(); \
        o[3] = __builtin_amdgcn_mfma_f32_32x32x16_bf16(pa2, (bf16x8){fl2[0], fl2[1], fl2[2], fl2[3], fh2[0], fh2[1], fh2[2], fh2[3]}, o[3], 0, 0, 0); fl2 = AT2_TRR(vbo_ + 18432); fh2 = AT2_TRR(vbo_ + 22528); ps += p0[11]; p0[12] = __builtin_amdgcn_exp2f(fmaf(p0[12], C2_, mnL_)); p0[13] = __builtin_amdgcn_exp2f(fmaf(p0[13], C2_, mnL_)); SBAR(); \
        o[3] = __builtin_amdgcn_mfma_f32_32x32x16_bf16(pa3, (bf16x8){fl3[0], fl3[1], fl3[2], fl3[3], fh3[0], fh3[1], fh3[2], fh3[3]}, o[3], 0, 0, 0); fl3 = AT2_TRR(vbo_ + 26624); fh3 = AT2_TRR(vbo_ + 30720); ps += p0[12]; ps += p0[13]; p0[14] = __builtin_amdgcn_exp2f(fmaf(p0[14], C2_, mnL_)); SBAR(); \
        o[4] = __builtin_amdgcn_mfma_f32_32x32x16_bf16(pa0, (bf16x8){fl0[0], fl0[1], fl0[2], fl0[3], fh0[0], fh0[1], fh0[2], fh0[3]}, o[4], 0, 0, 0); fl0 = AT2_TRR(vbo_ + 2560); fh0 = AT2_TRR(vbo_ + 6656); ps += p0[14]; p0[15] = __builtin_amdgcn_exp2f(fmaf(p0[15], C2_, mnL_)); p1[0] = __builtin_amdgcn_exp2f(fmaf(p1[0], C2_, mnL_)); SBAR(); \
        o[4] = __builtin_amdgcn_mfma_f32_32x32x16_bf16(pa1, (bf16x8){fl1[0], fl1[1], fl1[2], fl1[3], fh1[0], fh1[1], fh1[2], fh1[3]}, o[4], 0, 0, 0); fl1 = AT2_TRR(vbo_ + 10752); fh1 = AT2_TRR(vbo_ + 14848); ps += p0[15]; ps += p1[0]; p1[1] = __builtin_amdgcn_exp2f(fmaf(p1[1], C2_, mnL_)); SBAR(); \
        o[4] = __builtin_amdgcn_mfma_f32_32x32x16_bf16(pa2, (bf16x8){fl2[0], fl2[1], fl2[2], fl2[3], fh2[0], fh2[1], fh2[2], fh2[3]}, o[4], 0, 0, 0); fl2 = AT2_TRR(vbo_ + 18944); fh2 = AT2_TRR(vbo_ + 23040); ps += p1[1]; p1[2] = __builtin_amdgcn_exp2f(fmaf(p1[2], C2_, mnL_)); p1[3] = __builtin_amdgcn_exp2f(fmaf(p1[3], C2_, mnL_)); SBAR(); \
        o[4] = __builtin_amdgcn_mfma_f32_32x32x16_bf16(pa3, (bf16x8){fl3[0], fl3[1], fl3[2], fl3[3], fh3[0], fh3[1], fh3[2], fh3[3]}, o[4], 0, 0, 0); fl3 = AT2_TRR(vbo_ + 27136); fh3 = AT2_TRR(vbo_ + 31232); ps += p1[2]; ps += p1[3]; p1[4] = __builtin_amdgcn_exp2f(fmaf(p1[4], C2_, mnL_)); SBAR(); \
        o[5] = __builtin_amdgcn_mfma_f32_32x32x16_bf16(pa0, (bf16x8){fl0[0], fl0[1], fl0[2], fl0[3], fh0[0], fh0[1], fh0[2], fh0[3]}, o[5], 0, 0, 0); fl0 = AT2_TRR(vbo_ + 3072); fh0 = AT2_TRR(vbo_ + 7168); ps += p1[4]; p1[5] = __builtin_amdgcn_exp2f(fmaf(p1[5], C2_, mnL_)); p1[6] = __builtin_amdgcn_exp2f(fmaf(p1[6], C2_, mnL_)); SBAR(); \
        o[5] = __builtin_amdgcn_mfma_f32_32x32x16_bf16(pa1, (bf16x8){fl1[0], fl1[1], fl1[2], fl1[3], fh1[0], fh1[1], fh1[2], fh1[3]}, o[5], 0, 0, 0); fl1 = AT2_TRR(vbo_ + 11264); fh1 = AT2_TRR(vbo_ + 15360); ps += p1[5]; ps += p1[6]; p1[7] = __builtin_amdgcn_exp2f(fmaf(p1[7], C2_, mnL_)); SBAR(); \
        o[5] = __builtin_amdgcn_mfma_f32_32x32x16_bf16(pa2, (bf16x8){fl2[0], fl2[1], fl2[2], fl2[3], fh2[0], fh2[1], fh2[2], fh2[3]}, o[5], 0, 0, 0); fl2 = AT2_TRR(vbo_ + 19456); fh2 = AT2_TRR(vbo_ + 23552); ps += p1[7]; p1[8] = __builtin_amdgcn_exp2f(fmaf(p1[8], C2_, mnL_)); p1[9] = __builtin_amdgcn_exp2f(fmaf(p1[9], C2_, mnL_)); SBAR(); \
        o[5] = __builtin_amdgcn_mfma_f32_32x32x16_bf16(pa3, (bf16x8){fl3[0], fl3[1], fl3[2], fl3[3], fh3[0], fh3[1], fh3[2], fh3[3]}, o[5], 0, 0, 0); fl3 = AT2_TRR(vbo_ + 27648); fh3 = AT2_TRR(vbo_ + 31744); ps += p1[8]; ps += p1[9]; p1[10] = __builtin_amdgcn_exp2f(fmaf(p1[10], C2_, mnL_)); SBAR(); \
        o[6] = __builtin_amdgcn_mfma_f32_32x32x16_bf16(pa0, (bf16x8){fl0[0], fl0[1], fl0[2], fl0[3], fh0[0], fh0[1], fh0[2], fh0[3]}, o[6], 0, 0, 0); fl0 = AT2_TRR(vbo_ + 3584); fh0 = AT2_TRR(vbo_ + 7680); ps += p1[10]; p1[11] = __builtin_amdgcn_exp2f(fmaf(p1[11], C2_, mnL_)); p1[12] = __builtin_amdgcn_exp2f(fmaf(p1[12], C2_, mnL_)); SBAR(); \
        o[6] = __builtin_amdgcn_mfma_f32_32x32x16_bf16(pa1, (bf16x8){fl1[0], fl1[1], fl1[2], fl1[3], fh1[0], fh1[1], fh1[2], fh1[3]}, o[6], 0, 0, 0); fl1 = AT2_TRR(vbo_ + 11776); fh1 = AT2_TRR(vbo_ + 15872); ps += p1[11]; ps += p1[12]; p1[13] = __builtin_amdgcn_exp2f(fmaf(p1[13], C2_, mnL_)); SBAR(); \
        o[6] = __builtin_amdgcn_mfma_f32_32x32x16_bf16(pa2, (bf16x8){fl2[0], fl2[1], fl2[2], fl2[3], fh2[0], fh2[1], fh2[2], fh2[3]}, o[6], 0, 0, 0); fl2 = AT2_TRR(vbo_ + 19968); fh2 = AT2_TRR(vbo_ + 24064); ps += p1[13]; p1[14] = __builtin_amdgcn_exp2f(fmaf(p1[14], C2_, mnL_)); p1[15] = __builtin_amdgcn_exp2f(fmaf(p1[15], C2_, mnL_)); SBAR(); \
        o[6] = __builtin_amdgcn_mfma_f32_32x32x16_bf16(pa3, (bf16x8){fl3[0], fl3[1], fl3[2], fl3[3], fh3[0], fh3[1], fh3[2], fh3[3]}, o[6], 0, 0, 0); fl3 = AT2_TRR(vbo_ + 28160); fh3 = AT2_TRR(vbo_ + 32256); ps += p1[14]; ps += p1[15]; { auto rr_ = __builtin_amdgcn_permlane32_swap(__float_as_uint(ps), __float_as_uint(ps), false, false); ps = __uint_as_float(rr_[0]) + __uint_as_float(rr_[1]); } SBAR(); \
        o[7] = __builtin_amdgcn_mfma_f32_32x32x16_bf16(pa0, (bf16x8){fl0[0], fl0[1], fl0[2], fl0[3], fh0[0], fh0[1], fh0[2], fh0[3]}, o[7], 0, 0, 0);  SBAR(); \
        o[7] = __builtin_amdgcn_mfma_f32_32x32x16_bf16(pa1, (bf16x8){fl1[0], fl1[1], fl1[2], fl1[3], fh1[0], fh1[1], fh1[2], fh1[3]}, o[7], 0, 0, 0);  SBAR(); \
        o[7] = __builtin_amdgcn_mfma_f32_32x32x16_bf16(pa2, (bf16x8){fl2[0], fl2[1], fl2[2], fl2[3], fh2[0], fh2[1], fh2[2], fh2[3]}, o[7], 0, 0, 0);  SBAR(); \
        o[7] = __builtin_amdgcn_mfma_f32_32x32x16_bf16(pa3, (bf16x8){fl3[0], fl3[1], fl3[2], fl3[3], fh3[0], fh3[1], fh3[2], fh3[3]}, o[7], 0, 0, 0);  SBAR(); \
        } while (0)
#define AT2_STEP(t, b, HASPV) do { \
        asm volatile("s_waitcnt vmcnt(0)" ::: "memory"); __builtin_amdgcn_s_barrier(); asm volatile("" ::: "memory");     \
        if ((t) + 1 < NT) AT2_DMA_K((t) + 1, 1 - (b)); \
        AT2_DMA_V((t), (b)); \
        SBAR(); { const int lq_ = fresh_lane(); qkt<b, false>(p0, p1, K_lds, lq_ & 31, lq_ >> 5, qr, true); } \
        { const int kb_ = (t) * KVBLK; if (kb_ + KVBLK - 1 > qlo) { const int lm_ = fresh_lane(); mask_tile(p0, p1, qlo + (lm_ & 31) - 4 * (lm_ >> 5) - kb_, 0x7fffffffu); } } \
        SBAR(); \
        if (HASPV) { AT2_PV_SM(1 - (b)); } else { softmax_main(p0, p1, m_reg, al, ps); } \
        SBAR(); \
        RESC(al); l_reg = l_reg * al + ps; pack_p(p0, p1, pa0, pa1, pa2, pa3); } while (0)
    AT2_STEP(0, 0, false);
    for (int t = 1; t + 1 < NT; t += 2) { AT2_STEP(t, 1, true); AT2_STEP(t + 1, 0, true); }
    AT2_STEP(NT - 1, 1, true);
    asm volatile("s_waitcnt vmcnt(0)" ::: "memory"); __builtin_amdgcn_s_barrier(); asm volatile("" ::: "memory");
    pv_tile8<1>(o, (const AT2_LAS char*)L + v_rd_base(fresh_lane()), pa0, pa1, pa2, pa3);
    const int l2_ = fresh_lane(), he_ = l2_ >> 5;
    if (he_ == 0) li_l[l2_ & 31] = l_reg; asm volatile("s_waitcnt lgkmcnt(0)" ::: "memory");
    float rli[16];
#pragma unroll
    for (int r = 0; r < 16; ++r) rli[r] = __builtin_amdgcn_rcpf(li_l[crow(r, he_)]);
    const int loff = 4 * (l2_ >> 5) * DV + (l2_ & 31);
    unsigned short* Ow = cur.O + (size_t)(wid * QBLK) * DV + loff;
    const bool even_ = (l2_ & 1) == 0;
#pragma unroll
    for (int r = 0; r < 16; ++r) { const int orow = (r & 3) + 8 * (r >> 2);
#pragma unroll
        for (int d0 = 0; d0 < 8; ++d0) { const float v = o[d0][r] * rli[r]; const float vn = __shfl_xor(v, 1);
            if (even_) *(unsigned*)(Ow + orow * DV + d0 * 32) = cvtpk(v, vn); } }
    __syncthreads();
#undef RESC
#undef AT2_PV_SM
#undef MX3
#undef AT2_TRR
#undef AT2_STEP
#undef AT2_DMA_K
#undef AT2_DMA_V
#undef AT2_GLDS
}
}

#ifndef MK_N_LAUNCHES
#define MK_N_LAUNCHES 1
#endif
constexpr int N_LAUNCHES = MK_N_LAUNCHES, N_PHASES = 16;
constexpr int NWAVES = 8;

constexpr int S_ = 16384, DM = 2048, FF = 5632, DE = 7168, NE = 8, NHEAD = 8;
constexpr float NORM_EPS = 1e-6f, SUBLN_EPS = 1e-5f;
constexpr float LAMBDA_INIT = 0.35550906759096934f;
constexpr float SA_X = 16.f, SW_GU = 1024.f, SA_H = 16.f, SW_D = 2048.f;
constexpr int CAP_ROWS = 2 * S_ + NE * 256;

constexpr size_t MiB = 1u << 20;
constexpr size_t WS_CTL = 0, CTL_ZERO_BYTES = 1 * MiB;
constexpr size_t WS_SS1 = 1 * MiB, WS_SS2 = WS_SS1 + 524288;
constexpr size_t WS_RS0 = 1 * MiB;
constexpr size_t WS_RS1 = 2 * MiB;
constexpr size_t WS_TOKI = WS_RS1 + 65536;
constexpr size_t WS_TOKG = WS_TOKI + 262144;
constexpr size_t WS_ROPE = 3 * MiB;
constexpr size_t WS_WPOOL = 11 * MiB;
constexpr size_t WS_WKVQ = 13 * MiB;
constexpr size_t WS_WO = 37 * MiB;
constexpr size_t WS_WGU = 45 * MiB;
constexpr size_t WS_WD = 89 * MiB;
constexpr size_t WS_WEGU = 111 * MiB;
constexpr size_t WS_WED = 559 * MiB;
constexpr size_t WS_X1 = 783 * MiB;
constexpr size_t WS_H = 911 * MiB;
constexpr size_t WS_SCR = 975 * MiB;
constexpr size_t WS_HID = WS_SCR, WS_MG = WS_SCR + 176 * MiB;
constexpr size_t WS_H2 = WS_SCR, WS_K16 = WS_SCR + 64 * MiB, WS_V16 = WS_SCR + 128 * MiB, WS_Q16 = WS_SCR + 192 * MiB, WS_O32 = WS_SCR + 256 * MiB, WS_ON = WS_SCR + 512 * MiB;
constexpr size_t WS_HIDE = WS_SCR, WS_XG = WS_SCR + 476 * MiB, WS_Y = WS_SCR + 476 * MiB;
constexpr size_t WS_YPART = WS_SCR + 300 * MiB;
constexpr size_t WS_END = WS_SCR + 748 * MiB;
static_assert((size_t)CAP_ROWS * DE * 2 == 476 * MiB && (size_t)CAP_ROWS * DM * 4 == 272 * MiB, "expert buffers");
constexpr int CW_TMO = 0, CW_BAR = 4096, CW_CNT = 8192, CW_AQ = 9216;

constexpr int RING_BYTES = 131072, LDSCTL_OFF = 151552, MISC_OFF = LDSCTL_OFF + 320, LDS_BYTES = 155648;


#define GAS __attribute__((address_space(1)))
#define LAS __attribute__((address_space(3)))
typedef unsigned short bf16;
typedef unsigned v4u __attribute__((ext_vector_type(4)));
typedef unsigned v2u __attribute__((ext_vector_type(2)));
typedef float f32x4 __attribute__((ext_vector_type(4)));
typedef float f32x2 __attribute__((ext_vector_type(2)));
typedef int i32x4 __attribute__((ext_vector_type(4)));
typedef GAS unsigned gu32;
#define RLX_AGENT __ATOMIC_RELAXED, __HIP_MEMORY_SCOPE_AGENT
#define LDS_WAIT() asm volatile("s_waitcnt lgkmcnt(0)" ::: "memory")
#define VM_WAIT() asm volatile("s_waitcnt vmcnt(0)" ::: "memory")
__device__ __forceinline__ unsigned pk2(float lo, float hi) { return pg8::cvt_pk_bf16(lo, hi); }

#define XB_TMO      128
#define XB_XCNT(j)  (256  + 64 * (j))
#define XB_XSUB(j)  (1280 + 64 * (j))
#define XB_XGEN(j)  (2304 + 64 * (j))
#define XB_TOP      3328
#define XB_TOPGEN   3392
#define XCD_BAR_WORDS 3456
#define XB_SPIN_CAP (1u << 18)

__device__ __forceinline__ unsigned xb_ld(unsigned* p)              { return __hip_atomic_load(p, __ATOMIC_RELAXED, __HIP_MEMORY_SCOPE_AGENT); }
__device__ __forceinline__ unsigned xb_add(unsigned* p, unsigned v) { return __hip_atomic_fetch_add(p, v, __ATOMIC_RELAXED, __HIP_MEMORY_SCOPE_AGENT); }
__device__ __forceinline__ unsigned xb_xcc_id() { return (unsigned)__builtin_amdgcn_s_getreg((3 << 11) | 20) & 0xFu; }
#define XB_SPIN(cond, bar) do { unsigned _sp = 0; while (cond) { __builtin_amdgcn_s_sleep(1); \
    if ((++_sp & 255u) == 0u) { if (xb_ld(&(bar)[XB_TMO])) break; if (_sp > XB_SPIN_CAP) { atomicAdd(&(bar)[XB_TMO], 1u); break; } } } } while (0)

struct XcdBarrier {
    unsigned* bar; unsigned x; int w;
    volatile LAS unsigned* st;
};

__device__ __forceinline__ XcdBarrier xcd_barrier_post(unsigned* bar, volatile LAS unsigned* st, int wave_id) {
    XcdBarrier b; b.bar = bar; b.x = xb_xcc_id(); b.st = st; b.w = wave_id;
    if (threadIdx.x == 0) (void)xb_add(&bar[XB_XCNT(b.x)], 1u);
    return b;
}
__device__ __forceinline__ void xcd_barrier_complete(unsigned* bar, unsigned x, unsigned& nloc, unsigned& nx) {
    const unsigned G = gridDim.x * gridDim.y * gridDim.z;
    unsigned sum, cnt, mine, sp = 0u;
    for (;;) {
        sum = 0u; cnt = 0u; mine = 0u;
#pragma unroll
        for (unsigned j = 0; j < 16; ++j) { const unsigned c = xb_ld(&bar[XB_XCNT(j)]); sum += c; cnt += (c > 0u) ? 1u : 0u; mine = (j == x) ? c : mine; }
        if (sum == G) break;
        __builtin_amdgcn_s_sleep(1);
        if ((++sp & 255u) == 0u) { if (xb_ld(&bar[XB_TMO])) break; if (sp > XB_SPIN_CAP) { atomicAdd(&bar[XB_TMO], 1u); break; } }
    }
    nloc = mine > 0u ? mine : 1u; nx = cnt > 0u ? cnt : 1u;
}

__device__ __forceinline__ void xcd_barrier(const XcdBarrier& b) {
    asm volatile("s_waitcnt vmcnt(0)" ::: "memory");
    __syncthreads();
    if (b.w == 0 && fresh_lane() == 0) {
        unsigned* bar = b.bar;
        __builtin_amdgcn_s_waitcnt(0);
        unsigned nloc = b.st[0], nx = b.st[1];
        if (nloc == 0u) { xcd_barrier_complete(bar, b.x, nloc, nx); b.st[0] = nloc; b.st[1] = nx; }
        const unsigned old = xb_add(&bar[XB_XSUB(b.x)], 1u);
        const unsigned gen = old / nloc;
        if (old + 1u == (gen + 1u) * nloc) {
            __builtin_amdgcn_fence(__ATOMIC_RELEASE, "agent");
            asm volatile("s_waitcnt vmcnt(0)" ::: "memory");
            const unsigned og = xb_add(&bar[XB_TOP], 1u);
            const unsigned tg = og / nx;
            if (og + 1u == (tg + 1u) * nx) xb_add(&bar[XB_TOPGEN], 1u);
            else XB_SPIN(xb_ld(&bar[XB_TOPGEN]) == tg, bar);
            __builtin_amdgcn_fence(__ATOMIC_ACQUIRE, "agent");
            xb_add(&bar[XB_XGEN(b.x)], 1u);
            asm volatile("s_waitcnt vmcnt(0)" ::: "memory");
        } else {
            XB_SPIN(xb_ld(&bar[XB_XGEN(b.x)]) == gen, bar);
            __builtin_amdgcn_fence(__ATOMIC_ACQUIRE, "agent");
            asm volatile("s_waitcnt vmcnt(0)" ::: "memory");
        }
    }
    __syncthreads();
}

__device__ __forceinline__ float wave_sum(float v) {
#pragma unroll
    for (int o = 1; o < 64; o <<= 1) v += __shfl_xor(v, o);
    return v;
}
__device__ __forceinline__ float dot4(f32x4 a, f32x4 b) { return (a.x * b.x + a.y * b.y) + (a.z * b.z + a.w * b.w); }

__device__ __forceinline__ void tr_item(const float* W, int N, int k0, int n0, bf16* dst, int ldd, LAS float* scr, int lane) {
    const float* src = W + (size_t)(k0 + (lane >> 4)) * N + n0 + 4 * (lane & 15);
    f32x4 v[16];
#pragma unroll
    for (int i = 0; i < 16; ++i) v[i] = *(const f32x4*)(src + (size_t)(4 * i) * N);
#pragma unroll
    for (int i = 0; i < 16; ++i) { LAS float* p = scr + (4 * i + (lane >> 4)) * 65 + 4 * (lane & 15); p[0] = v[i].x; p[1] = v[i].y; p[2] = v[i].z; p[3] = v[i].w; }
    LDS_WAIT(); asm volatile("" ::: "memory");
    const int c = lane & 7;
#pragma unroll
    for (int q = 0; q < 8; ++q) { const int n = (lane >> 3) + 8 * q; const LAS float* s = scr + (8 * c) * 65 + n;
        v4u o; o.x = pk2(s[0 * 65], s[1 * 65]); o.y = pk2(s[2 * 65], s[3 * 65]); o.z = pk2(s[4 * 65], s[5 * 65]); o.w = pk2(s[6 * 65], s[7 * 65]);
        *(v4u*)(dst + (size_t)n * ldd + 8 * c) = o; }
    LDS_WAIT(); asm volatile("" ::: "memory");
}
__device__ __forceinline__ void tr_item8(const float* W, int N, int k0, int n0, unsigned char* dst, int ldd, float scale, LAS float* scr, int lane) {
    const float* src = W + (size_t)(k0 + (lane >> 4)) * N + n0 + 4 * (lane & 15);
    f32x4 v[16];
#pragma unroll
    for (int i = 0; i < 16; ++i) v[i] = *(const f32x4*)(src + (size_t)(4 * i) * N);
#pragma unroll
    for (int i = 0; i < 16; ++i) { LAS float* p = scr + (4 * i + (lane >> 4)) * 65 + 4 * (lane & 15); p[0] = v[i].x * scale; p[1] = v[i].y * scale; p[2] = v[i].z * scale; p[3] = v[i].w * scale; }
    LDS_WAIT(); asm volatile("" ::: "memory");
    const int c = lane & 3;
#pragma unroll
    for (int q = 0; q < 4; ++q) { const int n = (lane >> 2) + 16 * q; const LAS float* s = scr + (16 * c) * 65 + n;
        v4u o; o.x = pg8::pk4_fp8(s[0 * 65], s[1 * 65], s[2 * 65], s[3 * 65]); o.y = pg8::pk4_fp8(s[4 * 65], s[5 * 65], s[6 * 65], s[7 * 65]);
        o.z = pg8::pk4_fp8(s[8 * 65], s[9 * 65], s[10 * 65], s[11 * 65]); o.w = pg8::pk4_fp8(s[12 * 65], s[13 * 65], s[14 * 65], s[15 * 65]);
        *(v4u*)(dst + (size_t)n * ldd + 16 * c) = o; }
    LDS_WAIT(); asm volatile("" ::: "memory");
}
template <int MODE> __device__ __forceinline__ void tr_matrix_item8(const float* W, int K, int N, unsigned char* dstbase, float scale, int r, LAS float* scr, int lane) {
    const int nblk = N / 64, kb = r / nblk, nb = r % nblk, k0 = 64 * kb, n0 = 64 * nb;
    int row;
    if (MODE == 0) row = n0;
    else if (MODE == 1) row = 256 * (n0 >> 7) + (n0 & 127);
    else row = 256 * (n0 >> 7) + 128 + (n0 & 127);
    tr_item8(W, N, k0, n0, dstbase + (size_t)row * K + k0, K, scale, scr, lane);
}
template <int MODE> __device__ __forceinline__ void tr_matrix_item(const float* W, int K, int N, bf16* dstbase, int r, LAS float* scr, int lane) {
    const int nblk = N / 64, kb = r / nblk, nb = r % nblk, k0 = 64 * kb, n0 = 64 * nb;
    int row;
    if (MODE == 0) row = n0;
    else if (MODE == 1) row = 256 * (n0 >> 7) + (n0 & 127);
    else if (MODE == 2) row = 256 * (n0 >> 7) + 128 + (n0 & 127);
    else { const int h = n0 >> 8, rr = n0 & 255, map = rr >> 7, d = rr & 127; row = 256 * h + (d < 64 ? map * 64 : 128 + map * 64); }
    tr_item(W, N, k0, n0, dstbase + (size_t)row * K + k0, K, scr, lane);
}
struct TrDesc { const float* src; unsigned char* dst; const float* gain; int N, pitch, f8; float scale; };
__device__ __forceinline__ void tr_load(const TrDesc& d, f32x4 (&v)[16], int lane) {
    const float* s = d.src + (size_t)(lane >> 4) * d.N + 4 * (lane & 15);
#pragma unroll
    for (int i = 0; i < 16; ++i) v[i] = *(const f32x4*)(s + (size_t)(4 * i) * d.N);
}
__device__ __forceinline__ void tr_store(const TrDesc& d, const f32x4 (&v)[16], LAS float* scr, int lane) {
    if (d.gain) {
#pragma unroll
        for (int i = 0; i < 16; ++i) { const float gk = d.gain[4 * i + (lane >> 4)]; LAS float* p = scr + (4 * i + (lane >> 4)) * 65 + 4 * (lane & 15); p[0] = v[i].x * gk; p[1] = v[i].y * gk; p[2] = v[i].z * gk; p[3] = v[i].w * gk; }
    } else {
#pragma unroll
        for (int i = 0; i < 16; ++i) { LAS float* p = scr + (4 * i + (lane >> 4)) * 65 + 4 * (lane & 15); p[0] = v[i].x * d.scale; p[1] = v[i].y * d.scale; p[2] = v[i].z * d.scale; p[3] = v[i].w * d.scale; }
    }
    LDS_WAIT(); asm volatile("" ::: "memory");
    if (d.f8) {
        const int c = lane & 3;
#pragma unroll
        for (int q = 0; q < 4; ++q) { const int n = (lane >> 2) + 16 * q; const LAS float* s = scr + (16 * c) * 65 + n;
            v4u o; o.x = pg8::pk4_fp8(s[0 * 65], s[1 * 65], s[2 * 65], s[3 * 65]); o.y = pg8::pk4_fp8(s[4 * 65], s[5 * 65], s[6 * 65], s[7 * 65]);
            o.z = pg8::pk4_fp8(s[8 * 65], s[9 * 65], s[10 * 65], s[11 * 65]); o.w = pg8::pk4_fp8(s[12 * 65], s[13 * 65], s[14 * 65], s[15 * 65]);
            *(v4u*)(d.dst + (size_t)n * d.pitch + 16 * c) = o; }
    } else {
        const int c = lane & 7;
#pragma unroll
        for (int q = 0; q < 8; ++q) { const int n = (lane >> 3) + 8 * q; const LAS float* s = scr + (8 * c) * 65 + n;
            v4u o; o.x = pk2(s[0 * 65], s[1 * 65]); o.y = pk2(s[2 * 65], s[3 * 65]); o.z = pk2(s[4 * 65], s[5 * 65]); o.w = pk2(s[6 * 65], s[7 * 65]);
            *(v4u*)(d.dst + (size_t)n * d.pitch + 16 * c) = o; }
    }
    LDS_WAIT(); asm volatile("" ::: "memory");
}
__device__ __forceinline__ int tr_row(int mode, int n0) {
    if (mode == 0) return n0;
    if (mode == 1) return 256 * (n0 >> 7) + (n0 & 127);
    if (mode == 2) return 256 * (n0 >> 7) + 128 + (n0 & 127);
    const int h = n0 >> 8, rr = n0 & 255, map = rr >> 7, dd = rr & 127; return 256 * h + (dd < 64 ? map * 64 : 128 + map * 64);
}
__device__ __forceinline__ void sincos_pi(double r, double& s, double& c) {
    const double x2 = r * r;
    double ps = -1.0 / 25852016738884976640000.0;
    ps = ps * x2 + 1.0 / 51090942171709440000.0;  ps = ps * x2 - 1.0 / 121645100408832000.0; ps = ps * x2 + 1.0 / 355687428096000.0; ps = ps * x2 - 1.0 / 1307674368000.0;
    ps = ps * x2 + 1.0 / 6227020800.0; ps = ps * x2 - 1.0 / 39916800.0; ps = ps * x2 + 1.0 / 362880.0; ps = ps * x2 - 1.0 / 5040.0; ps = ps * x2 + 1.0 / 120.0; ps = ps * x2 - 1.0 / 6.0; ps = ps * x2 + 1.0;
    s = ps * r;
    double pc = 1.0 / 1124000727777607680000.0;
    pc = pc * x2 - 1.0 / 2432902008176640000.0; pc = pc * x2 + 1.0 / 6402373705728000.0; pc = pc * x2 - 1.0 / 20922789888000.0; pc = pc * x2 + 1.0 / 87178291200.0;
    pc = pc * x2 - 1.0 / 479001600.0; pc = pc * x2 + 1.0 / 3628800.0; pc = pc * x2 - 1.0 / 40320.0; pc = pc * x2 + 1.0 / 720.0; pc = pc * x2 - 1.0 / 24.0; pc = pc * x2 + 0.5; pc = pc * x2 - 1.0;
    c = -pc;
}
__device__ __forceinline__ void rms_row_bf16(const float* xrow, const float* ga, bf16* oa, const float* gb, bf16* ob, int lane) {
    const f32x4* xr = (const f32x4*)xrow + lane; f32x4 v[8]; float s = 0.f;
#pragma unroll
    for (int j = 0; j < 8; ++j) { v[j] = xr[64 * j]; s += dot4(v[j], v[j]); }
    const float rstd = 1.0f / sqrtf(wave_sum(s) * (1.0f / DM) + NORM_EPS);
#pragma unroll
    for (int j = 0; j < 8; ++j) { const f32x4 g = ((const f32x4*)ga)[lane + 64 * j]; const f32x4 y = v[j] * rstd * g; v2u o; o.x = pk2(y.x, y.y); o.y = pk2(y.z, y.w); ((v2u*)oa)[lane + 64 * j] = o; }
    if (ob) {
#pragma unroll
        for (int j = 0; j < 8; ++j) { const f32x4 g = ((const f32x4*)gb)[lane + 64 * j]; const f32x4 y = v[j] * rstd * g; v2u o; o.x = pk2(y.x, y.y); o.y = pk2(y.z, y.w); ((v2u*)ob)[lane + 64 * j] = o; }
    }
}

__device__ __forceinline__ f32x4 y_chunk(const bf16* YB, const float* YPART, int pr, int R, int SK, int q) {
    const int rt = pr >> 8;
    if (rt < 128) { const v2u u = ((const v2u*)(YB + (size_t)pr * DM))[q];
        return (f32x4){__uint_as_float(u.x << 16), __uint_as_float(u.x & 0xffff0000u), __uint_as_float(u.y << 16), __uint_as_float(u.y & 0xffff0000u)}; }
    f32x4 s = {0.f, 0.f, 0.f, 0.f};
    for (int sk = 0; sk < SK; ++sk) s += ((const f32x4*)(YPART + ((size_t)(sk * R + rt - 128) * 256 + (pr & 255)) * DM))[q];
    return s;
}

struct Args { const void* in[25]; float* out; unsigned char* ws; int ph_lo, ph_hi, li, pad; };
__global__ void __launch_bounds__(NWAVES * 64, 2) yoco_fwd(Args args) {
    extern __shared__ __attribute__((aligned(16))) unsigned char lds[];
    LAS unsigned char* const L = (LAS unsigned char*)lds;
    volatile LAS unsigned* const MISC = (volatile LAS unsigned*)(L + MISC_OFF);
    const int wave = __builtin_amdgcn_readfirstlane((int)threadIdx.x >> 6);
    const int G = gridDim.x, gw = blockIdx.x * NWAVES + wave, NGW = G * NWAVES;
    unsigned char* const ws = args.ws;
    gu32* const ctl = (gu32*)(ws + WS_CTL);
    const float* x = (const float*)args.in[0]; const int* positions = (const int*)args.in[1]; const float* norm_mix_a = (const float*)args.in[2]; const float* pool_w = (const float*)args.in[3];
    const float* pool_scale = (const float*)args.in[4]; const float* norm_kv = (const float*)args.in[5]; const float* w_k = (const float*)args.in[6]; const float* w_v = (const float*)args.in[7];
    const float* norm_mix_b = (const float*)args.in[8]; const float* w_q = (const float*)args.in[9]; const float* lq1 = (const float*)args.in[10]; const float* lk1 = (const float*)args.in[11];
    const float* lq2 = (const float*)args.in[12]; const float* lk2 = (const float*)args.in[13]; const float* subln_w = (const float*)args.in[14]; const float* w_o = (const float*)args.in[15];
    const float* norm_ffn = (const float*)args.in[16]; const float* d_gate = (const float*)args.in[17]; const float* d_up = (const float*)args.in[18]; const float* d_down = (const float*)args.in[19];
    const float* router_w = (const float*)args.in[20]; const float* m_gate = (const float*)args.in[21]; const float* m_up = (const float*)args.in[22]; const float* m_down = (const float*)args.in[23];
    const float* norm_final = (const float*)args.in[24];
    float* SS1 = (float*)(ws + WS_SS1); float* SS2 = (float*)(ws + WS_SS2); float* RS1 = (float*)(ws + WS_RS1); i32x4* TOKI = (i32x4*)(ws + WS_TOKI); f32x2* TOKG = (f32x2*)(ws + WS_TOKG); float* ROPE = (float*)(ws + WS_ROPE);
    bf16* WPOOL = (bf16*)(ws + WS_WPOOL); bf16* WKVQ = (bf16*)(ws + WS_WKVQ); bf16* WO = (bf16*)(ws + WS_WO); bf16* WGU = (bf16*)(ws + WS_WGU); bf16* WD = (bf16*)(ws + WS_WD);
    unsigned char* WEGU8 = ws + WS_WEGU; unsigned char* WED8 = ws + WS_WED; float* X1 = (float*)(ws + WS_X1); bf16* HB = (bf16*)(ws + WS_H);
    bf16* HID = (bf16*)(ws + WS_HID); bf16* MG = (bf16*)(ws + WS_MG); bf16* H2 = (bf16*)(ws + WS_H2); bf16* K16 = (bf16*)(ws + WS_K16); bf16* V16 = (bf16*)(ws + WS_V16); bf16* Q16 = (bf16*)(ws + WS_Q16);
    bf16* O16 = (bf16*)(ws + WS_O32); bf16* ON = (bf16*)(ws + WS_ON); unsigned char* HIDE8 = ws + WS_HIDE; unsigned char* XG8 = ws + WS_XG; bf16* YB = (bf16*)(ws + WS_Y); float* YPART = (float*)(ws + WS_YPART);

    for (int u = threadIdx.x; u < (LDS_BYTES - LDSCTL_OFF) / 4; u += NWAVES * 64) ((LAS unsigned*)(L + LDSCTL_OFF))[u] = 0u;
    __syncthreads();
    XcdBarrier bar; bar.bar = (unsigned*)(ctl + CW_BAR); bar.x = 0; bar.st = nullptr; bar.w = wave;
    if (N_LAUNCHES == 1) bar = xcd_barrier_post((unsigned*)(ctl + CW_BAR), MISC + 8, wave);
#define GRID_BAR(seam) do { if (N_LAUNCHES != 1) { if (wave == 0 && fresh_lane() == 0) __hip_atomic_store(ctl + CW_TMO, 0xBADBA0u | (unsigned)(seam), RLX_AGENT); } else { xcd_barrier(bar); } } while (0)
    const int lo = args.ph_lo, hi = args.ph_hi;
#define FRESH_TID() const int lane = fresh_lane(), tid = wave * 64 + lane; (void)tid; (void)lane
#define IN(k) (lo <= (k) && (k) < hi)
#define BOTH(k) (IN(k) && IN((k) + 1))
#ifndef PROBE_REP_PHASE
#define PROBE_REP_PHASE -1
#endif
#define REPN(k) ((k) == PROBE_REP_PHASE ? 2 : 1)
#define SMALLREP for (int rep_ = 0; rep_ < (PROBE_REP_PHASE == 100 ? 2 : 1); ++rep_)

    if (IN(1)) { FRESH_TID();
        SMALLREP for (int rc = blockIdx.x; rc < S_ / 64; rc += G) {
            const int t0 = rc * 64;
            LAS float* rs = (LAS float*)(L + 135168);
            for (int jr = wave; jr < 79; jr += NWAVES) { const int tt = t0 - 15 + jr;
                if (tt >= 0) { const f32x4* xr = (const f32x4*)(x + (size_t)tt * DM) + lane; float s = 0.f;
#pragma unroll
                    for (int j = 0; j < 8; ++j) { const f32x4 v = xr[64 * j]; s += dot4(v, v); }
                    s = wave_sum(s); if (lane == 0) rs[jr] = 1.0f / sqrtf(s * (1.0f / DM) + NORM_EPS); } }
            __syncthreads();
            const int c = 4 * tid, g = c >> 9, w = 2 << g;
            const f32x4 gn = *(const f32x4*)(norm_mix_a + c);
            f32x4 sum = {0.f, 0.f, 0.f, 0.f};
            for (int j = w - 1; j >= 1; --j) { const int tt = t0 - j; if (tt >= 0) sum += *(const f32x4*)(x + (size_t)tt * DM + c) * rs[15 - j] * gn; }
            bf16* mg = MG + ((size_t)g * S_ + t0) * 512 + (c & 511);
            for (int t = t0; t < t0 + 64; ++t) {
                const f32x4 h = *(const f32x4*)(x + (size_t)t * DM + c) * rs[t - t0 + 15] * gn; sum += h;
                const int cnt = (t + 1 < w) ? t + 1 : w; const f32x4 m = sum * (1.0f / (float)cnt) - h;
                v2u o; o.x = pk2(m.x, m.y); o.y = pk2(m.z, m.w); *(v2u*)mg = o; mg += 512;
                const int tt = t - w + 1; if (tt >= 0) sum -= *(const f32x4*)(x + (size_t)tt * DM + c) * rs[tt - t0 + 15] * gn;
            }
            __syncthreads();
        }
        SMALLREP for (int idx = blockIdx.x * 512 + tid; idx < S_ * 64; idx += G * 512) {
            const int t = idx >> 6, i = idx & 63;
            double f = 1.0; for (int k = 0; k < i; ++k) f *= 0.8659643233600653;
            const float ang = (float)positions[t] * (float)f;
            const double a = (double)ang, kk = __builtin_rint(a * 0.15915494309189535), r = __builtin_fma(-kk, 6.283185307179586, a);
            double sn, cs; sincos_pi(r, sn, cs);
            f32x2 o; o.x = (float)cs; o.y = (float)sn; ((f32x2*)ROPE)[idx] = o;
        }
        {
            LAS float* scr = (LAS float*)(L + wave * 16640);
            constexpr int I_POOL = 64, I_SQ = 32 * 32, I_DG = 32 * 88, I_DD = 88 * 32, I_EG = 32 * 112, I_ED = 112 * 32;
            constexpr int NITEMS = 4 * I_POOL + 4 * I_SQ + 2 * I_DG + I_DD + 16 * I_EG + 8 * I_ED;
#define TR_SET(W_, K_, N_, DST_, MODE_, F8_, SC_, GAIN_, R_) do { const int nblk_ = (N_) / 64, kb_ = (R_) / nblk_, nb_ = (R_) % nblk_, k0_ = 64 * kb_, n0_ = 64 * nb_; const int es_ = (F8_) ? 1 : 2; \
        d_.src = (W_) + (size_t)k0_ * (N_) + n0_; d_.N = (N_); d_.pitch = (K_) * es_; d_.f8 = (F8_); d_.scale = (SC_); d_.gain = (GAIN_) ? (const float*)(GAIN_) + k0_ : nullptr; d_.dst = (unsigned char*)(DST_) + ((size_t)tr_row(MODE_, n0_) * (K_) + k0_) * es_; } while (0)
#define TR_DECODE(it_) do { int r = (it_) % NITEMS; \
        if (r < 4 * I_POOL) { const int g = r / I_POOL; TR_SET(pool_w + (size_t)g * 512 * 512, 512, 512, WPOOL + (size_t)g * 512 * 512, 0, 0, 1.0f, (const float*)nullptr, r % I_POOL); break; } r -= 4 * I_POOL; \
        if (r < I_SQ) { TR_SET(w_k, DM, DM, WKVQ, 3, 0, 1.0f, norm_kv, r); break; } r -= I_SQ; \
        if (r < I_SQ) { TR_SET(w_v, DM, DM, WKVQ + (size_t)2048 * DM, 0, 0, 1.0f, norm_kv, r); break; } r -= I_SQ; \
        if (r < I_SQ) { TR_SET(w_q, DM, DM, WKVQ + (size_t)4096 * DM, 3, 0, 1.0f, norm_mix_b, r); break; } r -= I_SQ; \
        if (r < I_SQ) { TR_SET(w_o, DM, DM, WO, 0, 0, 1.0f, (const float*)nullptr, r); break; } r -= I_SQ; \
        if (r < I_DG) { TR_SET(d_gate, DM, FF, WGU, 1, 0, 1.0f, norm_ffn, r); break; } r -= I_DG; \
        if (r < I_DG) { TR_SET(d_up, DM, FF, WGU, 2, 0, 1.0f, norm_ffn, r); break; } r -= I_DG; \
        if (r < I_DD) { TR_SET(d_down, FF, DM, WD, 0, 0, 1.0f, (const float*)nullptr, r); break; } r -= I_DD; \
        if (r < 8 * I_EG) { const int e = r / I_EG; TR_SET(m_gate + (size_t)e * DM * DE, DM, DE, WEGU8 + (size_t)e * 2 * DE * DM, 1, 1, SW_GU, (const float*)nullptr, r % I_EG); break; } r -= 8 * I_EG; \
        if (r < 8 * I_EG) { const int e = r / I_EG; TR_SET(m_up + (size_t)e * DM * DE, DM, DE, WEGU8 + (size_t)e * 2 * DE * DM, 2, 1, SW_GU, (const float*)nullptr, r % I_EG); break; } r -= 8 * I_EG; \
        { const int e = r / I_ED; TR_SET(m_down + (size_t)e * DE * DM, DE, DM, WED8 + (size_t)e * DM * DE, 0, 1, SW_D, (const float*)nullptr, r % I_ED); } } while (0)
            const int NIT_ = NITEMS * REPN(1);
            TrDesc dA, dB; f32x4 vA[16], vB[16];
            int it = gw;
            if (it < NIT_) {
                { TrDesc& d_ = dA; TR_DECODE(it); } tr_load(dA, vA, lane);
                for (;;) {
                    int nx = it + NGW; bool has = nx < NIT_;
                    { TrDesc& d_ = dB; TR_DECODE(has ? nx : it); } tr_load(dB, vB, lane);
                    tr_store(dA, vA, scr, lane);
                    if (!has) break;
                    it = nx; nx = it + NGW; has = nx < NIT_;
                    { TrDesc& d_ = dA; TR_DECODE(has ? nx : it); } tr_load(dA, vA, lane);
                    tr_store(dB, vB, scr, lane);
                    if (!has) break;
                    it = nx;
                }
            }
#undef TR_DECODE
#undef TR_SET
        }
        if (BOTH(1)) GRID_BAR(1);
    }
    if (IN(2)) { FRESH_TID();
        pg8::GemmOrder S; S.init(S_ / 256, 8, G, (int)blockIdx.x, MG, WPOOL, 512, 1, (size_t)S_ * 512 * 2);
        pg8::EpiResF32N E{x, X1, DM, pool_scale, HB, SS1, (LAS float*)(L + RING_BYTES)};
        pg8::gemm_phase<pg8::EpiResF32N, pg8::GemmOrder, true, true>(L, 512 * 2, S, E, wave);
        if (BOTH(2)) GRID_BAR(2);
    }
    if (IN(4)) { FRESH_TID();
        pg8::GemmOrder S; S.init(S_ / 256, 2 * FF / 256, G, (int)blockIdx.x, HB, WGU, DM, 30, 0); S.rep = REPN(4);
        pg8::EpiSwiGLU E{HID, FF, SS1, 1.0f / DM, NORM_EPS};
        pg8::gemm_phase<pg8::EpiSwiGLU, pg8::GemmOrder, true, true>(L, DM * 2, S, E, wave);
        if (BOTH(4)) GRID_BAR(4);
    }
    if (IN(5)) { FRESH_TID();
        pg8::GemmOrder S; S.init(S_ / 256, DM / 256, G, (int)blockIdx.x, HID, WD, FF, 30, 0);
        pg8::EpiResF32N E{X1, X1, DM, nullptr, HB, SS2, (LAS float*)(L + RING_BYTES)};
        pg8::gemm_phase<pg8::EpiResF32N, pg8::GemmOrder, true, true>(L, FF * 2, S, E, wave);
        if (BOTH(5)) GRID_BAR(5);
    }
    if (IN(7)) { FRESH_TID();
        pg8::GemmOrder S; S.init(S_ / 256, 24, G, (int)blockIdx.x, HB, WKVQ, DM, 30, 0); S.rep = REPN(7);
        pg8::EpiKVQ E{K16, V16, Q16, ROPE, S_, SS2, 1.0f / DM, NORM_EPS};
        pg8::gemm_phase<pg8::EpiKVQ, pg8::GemmOrder, true, true>(L, DM * 2, S, E, wave);
        if (BOTH(7)) GRID_BAR(7);
    }
    if (IN(8)) { FRESH_TID();
        constexpr int NIT = 512 * REPN(8);
        for (int Li = blockIdx.x; Li < NIT; Li += G) {
            const int vh = (Li & 7) + 8 * ((Li >> 8) & 1), xp = (Li >> 3) & 31;
            for (int pass = 0; pass < 2; ++pass) {
                const int qb = pass ? xp : 63 - xp;
                attn::Block2 cur;
                cur.Q = (const attn::bf16*)Q16 + ((size_t)vh * S_ + (size_t)qb * 256) * 128; cur.K = (const attn::bf16*)K16 + (size_t)vh * S_ * 128;
                cur.V = (const attn::bf16*)V16 + (size_t)(vh >> 1) * S_ * 256; cur.O = O16 + ((size_t)vh * S_ + (size_t)qb * 256) * 256; cur.P0 = qb * 256;
                attn::attn_block2(cur, (char*)lds, L, wave);
            }
        }
        if (BOTH(8)) GRID_BAR(8);
    }
    if (IN(9)) { FRESH_TID();
        const float s1 = wave_sum(lq1[lane] * lk1[lane] + lq1[lane + 64] * lk1[lane + 64]), s2 = wave_sum(lq2[lane] * lk2[lane] + lq2[lane + 64] * lk2[lane + 64]);
        const float lam = expf(s1) - expf(s2) + LAMBDA_INIT;
        const f32x4 sw = *(const f32x4*)(subln_w + 4 * lane) * (1.0f - LAMBDA_INIT);
        SMALLREP for (int m = gw; m < S_; m += NGW) {
#pragma unroll
            for (int h = 0; h < NHEAD; ++h) {
                const v2u u1 = *(const v2u*)(O16 + ((size_t)(h * 2) * S_ + m) * 256 + 4 * lane), u2 = *(const v2u*)(O16 + ((size_t)(h * 2 + 1) * S_ + m) * 256 + 4 * lane);
                const f32x4 o1 = {__uint_as_float(u1.x << 16), __uint_as_float(u1.x & 0xffff0000u), __uint_as_float(u1.y << 16), __uint_as_float(u1.y & 0xffff0000u)};
                const f32x4 o2 = {__uint_as_float(u2.x << 16), __uint_as_float(u2.x & 0xffff0000u), __uint_as_float(u2.y << 16), __uint_as_float(u2.y & 0xffff0000u)};
                const f32x4 o = o1 - lam * o2;
                const float r = 1.0f / sqrtf(wave_sum(dot4(o, o)) * (1.0f / 256.0f) + SUBLN_EPS);
                const f32x4 y = o * r * sw; v2u w; w.x = pk2(y.x, y.y); w.y = pk2(y.z, y.w);
                *(v2u*)(ON + (size_t)m * DM + h * 256 + 4 * lane) = w;
            }
        }
        if (BOTH(9)) GRID_BAR(9);
    }
    if (IN(10)) { FRESH_TID();
        pg8::GemmOrder S; S.init(S_ / 256, DM / 256, G, (int)blockIdx.x, ON, WO, DM, 30, 0);
        pg8::EpiResF32 E{X1, X1, DM, nullptr};
        pg8::gemm_phase<pg8::EpiResF32, pg8::GemmOrder, true, true>(L, DM * 2, S, E, wave);
        if (BOTH(10)) GRID_BAR(10);
    }
    if (IN(11)) { FRESH_TID();
        LAS float* rw = (LAS float*)L;
        LAS int* lcnt = (LAS int*)(L + 65536); LAS int* gbase = lcnt + 8; LAS int* rinfo = lcnt + 16;
        LAS float* rgate = (LAS float*)(L + 65536 + 64 + 1024);
        for (int i = tid; i < DM * NE / 4; i += NWAVES * 64) ((LAS f32x4*)rw)[i] = ((const f32x4*)router_w)[i];
        if (tid < 8) lcnt[tid] = 0;
        __syncthreads();
        const float* gn = norm_ffn + DM;
        for (int rb = blockIdx.x; rb < S_ / 64; rb += G) {
            for (int rr = 0; rr < 8; ++rr) {
                const int row = rb * 64 + wave * 8 + rr; const float* xr = X1 + (size_t)row * DM + lane;
                float xv[32]; float s = 0.f;
#pragma unroll
                for (int i = 0; i < 32; ++i) { xv[i] = xr[64 * i]; s += xv[i] * xv[i]; }
                const float rstd = 1.0f / sqrtf(wave_sum(s) * (1.0f / DM) + NORM_EPS);
                float acc[8] = {0.f, 0.f, 0.f, 0.f, 0.f, 0.f, 0.f, 0.f};
#pragma unroll
                for (int i = 0; i < 32; ++i) { const float hv = xv[i] * rstd * gn[lane + 64 * i]; const LAS f32x4* wp = (const LAS f32x4*)(rw + (lane + 64 * i) * 8); const f32x4 w0 = wp[0], w1 = wp[1];
                    acc[0] += hv * w0.x; acc[1] += hv * w0.y; acc[2] += hv * w0.z; acc[3] += hv * w0.w; acc[4] += hv * w1.x; acc[5] += hv * w1.y; acc[6] += hv * w1.z; acc[7] += hv * w1.w; }
                float lg[8];
#pragma unroll
                for (int e = 0; e < 8; ++e) lg[e] = wave_sum(acc[e]);
                int e1 = 0; float l1 = lg[0];
#pragma unroll
                for (int e = 1; e < 8; ++e) if (lg[e] > l1) { l1 = lg[e]; e1 = e; }
                int e2 = -1; float l2 = -__builtin_inff();
#pragma unroll
                for (int e = 0; e < 8; ++e) if (e != e1 && lg[e] > l2) { l2 = lg[e]; e2 = e; }
                const float ex = expf(l2 - l1), g1 = 1.0f / (1.0f + ex), g2 = ex / (1.0f + ex);
                if (lane == 0) { const int r1 = __hip_atomic_fetch_add(&lcnt[e1], 1, __ATOMIC_RELAXED, __HIP_MEMORY_SCOPE_WORKGROUP), r2 = __hip_atomic_fetch_add(&lcnt[e2], 1, __ATOMIC_RELAXED, __HIP_MEMORY_SCOPE_WORKGROUP);
                    const int q = wave * 8 + rr; rinfo[q * 4 + 0] = e1; rinfo[q * 4 + 1] = r1; rinfo[q * 4 + 2] = e2; rinfo[q * 4 + 3] = r2; rgate[q * 2] = g1; rgate[q * 2 + 1] = g2; RS1[row] = rstd; }
            }
            __syncthreads();
            if (tid < 8) gbase[tid] = (int)__hip_atomic_fetch_add(ctl + CW_CNT + 64 * tid, (unsigned)lcnt[tid], RLX_AGENT);
            __syncthreads();
            if (tid < 64) { const int row = rb * 64 + tid; const int e1 = rinfo[tid * 4], e2 = rinfo[tid * 4 + 2]; const int sl1 = gbase[e1] + rinfo[tid * 4 + 1], sl2 = gbase[e2] + rinfo[tid * 4 + 3];
                i32x4 ti; ti.x = e1; ti.y = sl1; ti.z = e2; ti.w = sl2; TOKI[row] = ti; f32x2 tg; tg.x = rgate[tid * 2]; tg.y = rgate[tid * 2 + 1]; TOKG[row] = tg; }
            __syncthreads();
            if (tid < 8) lcnt[tid] = 0;
            __syncthreads();
        }
        if (BOTH(11)) GRID_BAR(11);
    }
#define MOE_TS(ts_) do { int tot_ = 0; _Pragma("unroll") for (int e_ = 0; e_ < 8; ++e_) { const int c_ = __builtin_amdgcn_readfirstlane((int)__hip_atomic_load(ctl + CW_CNT + 64 * e_, RLX_AGENT)); (ts_)[e_] = tot_; tot_ += (c_ + 255) >> 8; } (ts_)[8] = tot_; } while (0)
#define MOE_SK(R_) ((R_) <= 2 ? 14 : ((R_) <= 4 ? 7 : 4))
    if (IN(12)) { FRESH_TID();
        int ts[9]; MOE_TS(ts);
        const float* gn = norm_ffn + DM;
        SMALLREP for (int m = gw; m < S_; m += NGW) {
            const i32x4 ti = TOKI[m]; const float rstd = RS1[m];
            int t1 = 0, t2 = 0;
#pragma unroll
            for (int e = 0; e < 8; ++e) { t1 = (ti.x == e) ? ts[e] : t1; t2 = (ti.z == e) ? ts[e] : t2; }
            unsigned* o1 = (unsigned*)(XG8 + (size_t)(256 * t1 + ti.y) * DM) + lane; unsigned* o2 = (unsigned*)(XG8 + (size_t)(256 * t2 + ti.w) * DM) + lane;
            const f32x4* xr = (const f32x4*)(X1 + (size_t)m * DM) + lane;
#pragma unroll
            for (int j = 0; j < 8; ++j) { const f32x4 y = xr[64 * j] * (rstd * SA_X) * ((const f32x4*)gn)[lane + 64 * j]; const unsigned o = pg8::pk4_fp8(y.x, y.y, y.z, y.w); o1[64 * j] = o; o2[64 * j] = o; }
        }
        if (BOTH(12)) GRID_BAR(12);
    }
    if (IN(13)) { FRESH_TID();
        pg8::MoeOrder S; MOE_TS(S.ts); S.rep = REPN(13); S.nM = S.ts[8]; S.nN = 2 * DE / 256; S.nwg = S.nM * S.nN; S.G = G; S.c = (int)blockIdx.x;
        S.A = (const char*)XG8; S.B = (const char*)WEGU8; S.tstepA = (size_t)256 * DM; S.tstepB = (size_t)256 * DM; S.estride = (size_t)2 * DE * DM;
        pg8::EpiSwiGLU8 E{HIDE8, DE, 1.0f / (SA_X * SW_GU), SA_H};
        pg8::gemm_phase<pg8::EpiSwiGLU8, pg8::MoeOrder, true, true, true>(L, DM, S, E, wave);
        if (BOTH(13)) GRID_BAR(13);
    }
    if (IN(14)) { FRESH_TID();
        pg8::MoeOrder S; MOE_TS(S.ts); S.rep = REPN(14); S.nM = S.ts[8] < 128 ? S.ts[8] : 128; S.nN = DM / 256; S.nwg = S.nM * S.nN; S.G = G; S.c = (int)blockIdx.x;
        S.A = (const char*)HIDE8; S.B = (const char*)WED8; S.tstepA = (size_t)256 * DE; S.tstepB = (size_t)256 * DE; S.estride = (size_t)DM * DE;
        pg8::EpiBf16S E{YB, DM, 1.0f / (SA_H * SW_D)};
        pg8::gemm_phase<pg8::EpiBf16S, pg8::MoeOrder, true, true, true>(L, DE, S, E, wave);
        const int R = S.ts[8] - 128;
        if (R > 0) {
            pg8::SplitOrder S2; S2.R = R; S2.SK = MOE_SK(R); S2.nsub = 8 * R * S2.SK; S2.G = G; S2.c = (int)blockIdx.x; S2.klen = DE / S2.SK;
#pragma unroll
            for (int e_ = 0; e_ < 9; ++e_) S2.ts[e_] = S.ts[e_];
            S2.A = S.A; S2.B = S.B; S2.tstepA = S.tstepA; S2.tstepB = S.tstepB; S2.estride = S.estride;
            pg8::EpiF32 E2{YPART, DM, 1.0f / (SA_H * SW_D)};
            pg8::gemm_phase<pg8::EpiF32, pg8::SplitOrder, true, true, true>(L, DE, S2, E2, wave, S2.klen);
        }
        if (BOTH(14)) GRID_BAR(14);
    }
    if (IN(15)) { FRESH_TID();
        int ts[9]; MOE_TS(ts);
        const int Rl = ts[8] - 128, SKl = MOE_SK(Rl);
        unsigned poison = __hip_atomic_load(ctl + CW_TMO, RLX_AGENT) | __hip_atomic_load(ctl + CW_BAR + XB_TMO, RLX_AGENT);
        SMALLREP for (int m = gw; m < S_; m += NGW) {
            const i32x4 ti = TOKI[m]; const f32x2 tg = TOKG[m];
            int t1 = 0, t2 = 0;
#pragma unroll
            for (int e = 0; e < 8; ++e) { t1 = (ti.x == e) ? ts[e] : t1; t2 = (ti.z == e) ? ts[e] : t2; }
            const int pr1 = 256 * t1 + ti.y, pr2 = 256 * t2 + ti.w;
            const f32x4* xr = (const f32x4*)(X1 + (size_t)m * DM) + lane;
            const bool first_lo = ti.x < ti.z;
            f32x4 v[8]; float s = 0.f;
            if (((pr1 | pr2) >> 8) < 128) {
                const v2u* y1 = (const v2u*)(YB + (size_t)pr1 * DM) + lane; const v2u* y2 = (const v2u*)(YB + (size_t)pr2 * DM) + lane;
#pragma unroll
                for (int j = 0; j < 8; ++j) { const v2u ua = y1[64 * j], ub = y2[64 * j];
                    const f32x4 a = (f32x4){__uint_as_float(ua.x << 16), __uint_as_float(ua.x & 0xffff0000u), __uint_as_float(ua.y << 16), __uint_as_float(ua.y & 0xffff0000u)} * tg.x;
                    const f32x4 b = (f32x4){__uint_as_float(ub.x << 16), __uint_as_float(ub.x & 0xffff0000u), __uint_as_float(ub.y << 16), __uint_as_float(ub.y & 0xffff0000u)} * tg.y;
                    v[j] = xr[64 * j] + (first_lo ? (a + b) : (b + a)); s += dot4(v[j], v[j]); }
            } else {
#pragma unroll
                for (int j = 0; j < 8; ++j) { const f32x4 a = y_chunk(YB, YPART, pr1, Rl, SKl, lane + 64 * j) * tg.x, b = y_chunk(YB, YPART, pr2, Rl, SKl, lane + 64 * j) * tg.y;
                    v[j] = xr[64 * j] + (first_lo ? (a + b) : (b + a)); s += dot4(v[j], v[j]); }
            }
            float rstd = 1.0f / sqrtf(wave_sum(s) * (1.0f / DM) + NORM_EPS);
            if (poison) rstd = __builtin_nanf("");
            f32x4* o = (f32x4*)(args.out + (size_t)m * DM) + lane;
#pragma unroll
            for (int j = 0; j < 8; ++j) o[64 * j] = v[j] * rstd * ((const f32x4*)norm_final)[lane + 64 * j];
        }
    }
#undef IN
#undef BOTH
#undef GRID_BAR
#undef MOE_TS
}

extern "C" void kernel_launch(void* const* d_in, const int* in_sizes, int n_in, void* d_out, int out_size, void* d_ws, size_t ws_size, hipStream_t stream) {
    static int grid = 0;
    if (grid == 0) {
        if (n_in != 25 || in_sizes[0] != S_ * DM || out_size != S_ * DM || ws_size < WS_END) { fprintf(stderr, "kernel_launch: shape / workspace mismatch (n_in %d, in0 %d, out %d, ws %zu, need %zu); nothing launched\n", n_in, n_in > 0 ? in_sizes[0] : -1, out_size, ws_size, (size_t)WS_END); grid = -1; return; }
        int dev = 0, cus = 0;
        if (hipGetDevice(&dev) != hipSuccess || hipDeviceGetAttribute(&cus, hipDeviceAttributeMultiprocessorCount, dev) != hipSuccess) { fprintf(stderr, "kernel_launch: device query failed\n"); grid = -1; return; }
        if (hipFuncSetAttribute((const void*)yoco_fwd, hipFuncAttributeMaxDynamicSharedMemorySize, LDS_BYTES) != hipSuccess) { fprintf(stderr, "kernel_launch: hipFuncSetAttribute failed\n"); grid = -1; return; }
        int per_cu = 0;
        if (hipOccupancyMaxActiveBlocksPerMultiprocessor(&per_cu, (const void*)yoco_fwd, NWAVES * 64, LDS_BYTES) != hipSuccess || per_cu < 1) { fprintf(stderr, "kernel_launch: occupancy query reports %d workgroups per CU\n", per_cu); }
        (void)hipGetLastError();
        grid = cus;
    }
    if (grid < 0) return;
    if (hipMemsetAsync((char*)d_ws + WS_CTL, 0, CTL_ZERO_BYTES, stream) != hipSuccess) { fprintf(stderr, "kernel_launch: memset failed\n"); return; }
    Args a{};
    for (int i = 0; i < 25; ++i) a.in[i] = d_in[i];
    a.out = (float*)d_out; a.ws = (unsigned char*)d_ws; a.pad = 0;
    if (N_LAUNCHES == 1) { a.ph_lo = 0; a.ph_hi = N_PHASES; a.li = 0; hipLaunchKernelGGL(yoco_fwd, dim3(grid), dim3(NWAVES * 64), LDS_BYTES, stream, a); }
    else { for (int li = 0; li < N_PHASES; ++li) { a.ph_lo = li; a.ph_hi = li + 1; a.li = li; hipLaunchKernelGGL(yoco_fwd, dim3(grid), dim3(NWAVES * 64), LDS_BYTES, stream, a); } }
    const hipError_t le = hipPeekAtLastError();
    if (le != hipSuccess) fprintf(stderr, "kernel_launch: launch failed: %s\n", hipGetErrorName(le));
}
```

```cpp
#include <hip/hip_runtime.h>
#include <hip/hip_bf16.h>
#include <cstdio>
#include <cstdint>

__device__ __forceinline__ int fresh_lane() { int l; asm volatile("v_mbcnt_lo_u32_b32 %0, -1, 0\n\tv_mbcnt_hi_u32_b32 %0, -1, %0" : "=v"(l)); return l; }

namespace pg8 {
#define PG8_LAS __attribute__((address_space(3)))
typedef unsigned short bf16_t;
typedef short bf16x8 __attribute__((ext_vector_type(8)));
typedef float f32x4 __attribute__((ext_vector_type(4)));
typedef unsigned u32x4 __attribute__((ext_vector_type(4)));
typedef int i32x4 __attribute__((ext_vector_type(4)));
typedef int i32x8 __attribute__((ext_vector_type(8)));
typedef unsigned u32x2 __attribute__((ext_vector_type(2)));
constexpr int BM = 256, BK = 64, HALF = 128, HTB = HALF * BK * 2  , STAGE_BYTES = 8 * HTB, NXCD = 8, WGM = 8;

__host__ __device__ __forceinline__ int lds_byte(int r, int c) { const int st = (r >> 4) * 2 + (c >> 5), rr = r & 15, cc = c & 31, ob = rr * 64 + cc * 2; return st * 1024 + (ob ^ (((ob >> 9) & 1) << 5)); }
__host__ __device__ __forceinline__ void stage_rc(int b, int& R, int& C) { const int st = b / 1024, sb = b % 1024, swz = sb ^ (((sb >> 9) & 1) << 5); R = (st >> 1) * 16 + swz / 64; C = (st & 1) * 32 + (swz % 64) / 2; }
__host__ __device__ __forceinline__ int perm32(int rho) { const int n = rho >> 4, i = rho & 15; return 8 * (i >> 2) + 4 * n + (i & 3); }

struct Unit { int pm, pn, aux; const char* A; const char* B; };

struct GemmOrder {
    int nM, nN, nwg, G, c, ashift, rep; const char* A; const char* B; size_t tstepA, tstepB, astride;
    __device__ __forceinline__ void init(int nM_, int nN_, int G_, int c_, const void* A_, const void* B_, int K, int ashift_, size_t astride_) {
        nM = nM_; nN = nN_; nwg = nM * nN; G = G_; c = c_; A = (const char*)A_; B = (const char*)B_; tstepA = (size_t)BM * K * 2;     tstepB = tstepA; ashift = ashift_; astride = astride_; rep = 1; }
    __device__ __forceinline__ bool next(int i, Unit& u) const {
        const long L = (long)i * G + c; if (L >= (long)nwg * rep) return false;
        int wgid = (int)(L % nwg); { const int q = nwg / NXCD, r = nwg % NXCD, xcd = wgid % NXCD, off = wgid / NXCD; wgid = (xcd < r ? xcd * (q + 1) : r * (q + 1) + (xcd - r) * q) + off; }
        const int nig = WGM * nN, gid = wgid / nig, fm = gid * WGM, gsz = (nM - fm) < WGM ? (nM - fm) : WGM;
        u.pm = fm + ((wgid % nig) % gsz); u.pn = (wgid % nig) / gsz; u.aux = 0;
        u.A = A + (size_t)(u.pn >> ashift) * astride + (size_t)u.pm * tstepA; u.B = B + (size_t)u.pn * tstepB; return true;
    }
    __device__ __forceinline__ void a_ready(const Unit&) const {}
    __device__ __forceinline__ void done(const Unit&) const {}
};
struct MoeOrder {
    int nM, nN, nwg, G, c, rep; int ts[9]; const char* A; const char* B; size_t tstepA, tstepB, estride, ecapA;
    __device__ __forceinline__ bool next(int i, Unit& u) const {
        const long L = (long)i * G + c; if (L >= (long)nwg * rep) return false;
        int wgid = (int)(L % nwg); { const int q = nwg / NXCD, r = nwg % NXCD, xcd = wgid % NXCD, off = wgid / NXCD; wgid = (xcd < r ? xcd * (q + 1) : r * (q + 1) + (xcd - r) * q) + off; }
        const int nig = WGM * nN, gid = wgid / nig, fm = gid * WGM, gsz = (nM - fm) < WGM ? (nM - fm) : WGM;
        u.pm = fm + ((wgid % nig) % gsz); u.pn = (wgid % nig) / gsz;
        int e = 0, t0 = 0;
#pragma unroll
        for (int j = 1; j < 8; ++j) { const bool ge = u.pm >= ts[j]; e += ge ? 1 : 0; t0 = ge ? ts[j] : t0; }
        u.aux = e;
        u.A = ecapA ? A + (size_t)e * ecapA + (size_t)(u.pm - t0) * tstepA : A + (size_t)u.pm * tstepA; u.B = B + (size_t)e * estride + (size_t)u.pn * tstepB; return true;
    }
    __device__ __forceinline__ void a_ready(const Unit&) const {}
    __device__ __forceinline__ void done(const Unit&) const {}
};

struct SplitOrder {
    int R, SK, nsub, G, c, klen, base; int ts[9]; const char* A; const char* B; size_t tstepA, tstepB, estride;
    __device__ __forceinline__ bool next(int i, Unit& u) const {
        const long L = (long)i * G + c; if (L >= nsub) return false;
        const int sk = (int)(L % SK), unit = (int)(L / SK), rtl = unit >> 3, pm = base + rtl;
        int e = 0;
#pragma unroll
        for (int j = 1; j < 8; ++j) e += (pm >= ts[j]) ? 1 : 0;
        u.pm = sk * R + rtl; u.pn = unit & 7; u.aux = e;
        u.A = A + (size_t)pm * tstepA + (size_t)sk * klen; u.B = B + (size_t)e * estride + (size_t)u.pn * tstepB + (size_t)sk * klen; return true;
    }
    __device__ __forceinline__ void a_ready(const Unit&) const {}
    __device__ __forceinline__ void done(const Unit&) const {}
};

__device__ __forceinline__ unsigned cvt_pk_bf16(float lo, float hi) { unsigned r; asm volatile("v_cvt_pk_bf16_f32 %0, %1, %2" : "=v"(r) : "v"(lo), "v"(hi)); return r; }

struct EpiResF32 {
    static constexpr bool PERM = false, AFTER_DRAIN = false;
    const float* base; float* out; int ldc; const float* scale;
    __device__ __forceinline__ void operator()(const f32x4 (&acc)[2][2][4][2], const Unit& u, int wr, int wc, int fr, int fq) const {
        const int row0 = u.pm * BM + wr * 64 + fr, col0 = u.pn * BM + wc * 32 + 4 * fq;
        f32x4 sv[2][2];
#pragma unroll
        for (int bj = 0; bj < 2; ++bj)
#pragma unroll
            for (int n = 0; n < 2; ++n) sv[bj][n] = scale ? *(const f32x4*)(scale + col0 + bj * HALF + n * 16) : (f32x4){1.f, 1.f, 1.f, 1.f};
#pragma unroll
        for (int ai = 0; ai < 2; ++ai) { f32x4 bs[4][2][2];
#pragma unroll
            for (int m = 0; m < 4; ++m) { const size_t off = (size_t)(row0 + ai * HALF + m * 16) * ldc + col0;
#pragma unroll
                for (int bj = 0; bj < 2; ++bj)
#pragma unroll
                    for (int n = 0; n < 2; ++n) bs[m][bj][n] = *(const f32x4*)(base + off + bj * HALF + n * 16); }
            asm volatile("" ::: "memory");
#pragma unroll
            for (int m = 0; m < 4; ++m) { const size_t off = (size_t)(row0 + ai * HALF + m * 16) * ldc + col0;
#pragma unroll
                for (int bj = 0; bj < 2; ++bj)
#pragma unroll
                    for (int n = 0; n < 2; ++n) *(f32x4*)(out + off + bj * HALF + n * 16) = bs[m][bj][n] + acc[ai][bj][m][n] * sv[bj][n]; }
            asm volatile("" ::: "memory"); }
    }
};
__device__ __forceinline__ unsigned pk4_fp8(float a, float b, float c, float d) {
    a = __builtin_amdgcn_fmed3f(a, -448.f, 448.f); b = __builtin_amdgcn_fmed3f(b, -448.f, 448.f); c = __builtin_amdgcn_fmed3f(c, -448.f, 448.f); d = __builtin_amdgcn_fmed3f(d, -448.f, 448.f);
    int r = __builtin_amdgcn_cvt_pk_fp8_f32(a, b, 0, false); r = __builtin_amdgcn_cvt_pk_fp8_f32(c, d, r, true); return (unsigned)r; }
struct EpiResF32N {
    static constexpr bool PERM = false, AFTER_DRAIN = false;
    const float* base; float* out; int ldc; const float* scale; bf16_t* xb; float* ssp; PG8_LAS float* tab; float osc; unsigned char* x8; float s8;
    __device__ __forceinline__ void operator()(const f32x4 (&acc)[2][2][4][2], const Unit& u, int wr, int wc, int fr, int fq) const {
        const int row0 = u.pm * BM + wr * 64 + fr, col0 = u.pn * BM + wc * 32 + 4 * fq;
        f32x4 sv[2][2];
#pragma unroll
        for (int bj = 0; bj < 2; ++bj)
#pragma unroll
            for (int n = 0; n < 2; ++n) sv[bj][n] = scale ? *(const f32x4*)(scale + col0 + bj * HALF + n * 16) : (f32x4){1.f, 1.f, 1.f, 1.f};
#pragma unroll
        for (int ai = 0; ai < 2; ++ai) { f32x4 bsv[4][2][2];
#pragma unroll
            for (int m = 0; m < 4; ++m) { const size_t off = (size_t)(row0 + ai * HALF + m * 16) * ldc + col0;
#pragma unroll
                for (int bj = 0; bj < 2; ++bj)
#pragma unroll
                    for (int n = 0; n < 2; ++n) bsv[m][bj][n] = *(const f32x4*)(base + off + bj * HALF + n * 16); }
            asm volatile("" ::: "memory");
#pragma unroll
            for (int m = 0; m < 4; ++m) { const int row = row0 + ai * HALF + m * 16; const size_t off = (size_t)row * ldc + col0; float q = 0.f;
#pragma unroll
                for (int bj = 0; bj < 2; ++bj)
#pragma unroll
                    for (int n = 0; n < 2; ++n) { const f32x4 bs = bsv[m][bj][n]; const f32x4 v = bs + acc[ai][bj][m][n] * (sv[bj][n] * osc);
                        *(f32x4*)(out + off + bj * HALF + n * 16) = v; q += (v[0] * v[0] + v[1] * v[1]) + (v[2] * v[2] + v[3] * v[3]);
                        if (xb) { u32x2 w; w.x = cvt_pk_bf16(v[0], v[1]); w.y = cvt_pk_bf16(v[2], v[3]); *(u32x2*)(xb + off + bj * HALF + n * 16) = w; }
                        if (x8) *(unsigned*)(x8 + off + bj * HALF + n * 16) = pk4_fp8(v[0] * s8, v[1] * s8, v[2] * s8, v[3] * s8); }
                q += __shfl_xor(q, 16); q += __shfl_xor(q, 32);
                if (fq == 0) tab[(ai * HALF + wr * 64 + m * 16 + fr) * 4 + wc] = q;
                asm volatile("" ::: "memory"); } }
        asm volatile("s_waitcnt lgkmcnt(0)" ::: "memory"); __builtin_amdgcn_s_barrier(); asm volatile("" ::: "memory");
        const int t = (wr * 4 + wc) * 64 + fq * 16 + fr;
        if (t < BM) { const PG8_LAS f32x4* p = (const PG8_LAS f32x4*)(tab + t * 4); const f32x4 s = *p; ssp[(size_t)(u.pm * BM + t) * 8 + u.pn] = ((s[0] + s[1]) + s[2]) + s[3]; }
    }
};
struct EpiBf16S {
    static constexpr bool PERM = true, AFTER_DRAIN = false;
    bf16_t* O; int ldc; float sc;
    __device__ __forceinline__ void operator()(const f32x4 (&acc)[2][2][4][2], const Unit& u, int wr, int wc, int fr, int fq) const {
        const int row0 = u.pm * BM + wr * 64 + fr, col0 = u.pn * BM + wc * 32 + 8 * fq;
#pragma unroll
        for (int ai = 0; ai < 2; ++ai)
#pragma unroll
            for (int m = 0; m < 4; ++m) { bf16_t* rowp = O + (size_t)(row0 + ai * HALF + m * 16) * ldc + col0;
#pragma unroll
                for (int bj = 0; bj < 2; ++bj) { const f32x4 v0 = acc[ai][bj][m][0] * sc, v1 = acc[ai][bj][m][1] * sc;
                    u32x4 w; w.x = cvt_pk_bf16(v0[0], v0[1]); w.y = cvt_pk_bf16(v0[2], v0[3]); w.z = cvt_pk_bf16(v1[0], v1[1]); w.w = cvt_pk_bf16(v1[2], v1[3]);
                    *(u32x4*)(rowp + bj * HALF) = w; } }
    }
};
struct EpiF32 {
    static constexpr bool PERM = false, AFTER_DRAIN = false;
    float* out; int ldc; float sc;
    __device__ __forceinline__ void operator()(const f32x4 (&acc)[2][2][4][2], const Unit& u, int wr, int wc, int fr, int fq) const {
        const int row0 = u.pm * BM + wr * 64 + fr, col0 = u.pn * BM + wc * 32 + 4 * fq;
#pragma unroll
        for (int ai = 0; ai < 2; ++ai)
#pragma unroll
            for (int m = 0; m < 4; ++m) { float* rowp = out + (size_t)(row0 + ai * HALF + m * 16) * ldc + col0;
#pragma unroll
                for (int bj = 0; bj < 2; ++bj)
#pragma unroll
                    for (int n = 0; n < 2; ++n) *(f32x4*)(rowp + bj * HALF + n * 16) = acc[ai][bj][m][n] * sc; }
    }
};
__device__ __forceinline__ float row_rstd(const float* ssp, int row, float inv_n, float eps) { const f32x4 a = *(const f32x4*)(ssp + (size_t)row * 8), b = *(const f32x4*)(ssp + (size_t)row * 8 + 4);
    return 1.0f / sqrtf((((a[0] + a[1]) + (a[2] + a[3])) + ((b[0] + b[1]) + (b[2] + b[3]))) * inv_n + eps); }
__device__ __forceinline__ float silu_mul(float g, float u) { return g * u * __builtin_amdgcn_rcpf(1.0f + __builtin_amdgcn_exp2f(-1.4426950408889634f * g)); }
struct EpiSwiGLU {
    static constexpr bool PERM = true, AFTER_DRAIN = false;
    bf16_t* O; int ldc; const float* ssp; float inv_n, eps, sin;
    __device__ __forceinline__ void operator()(const f32x4 (&acc)[2][2][4][2], const Unit& u, int wr, int wc, int fr, int fq) const {
        const int row0 = u.pm * BM + wr * 64 + fr, col0 = u.pn * HALF + wc * 32 + 8 * fq;
        float rs8[2][4];
#pragma unroll
        for (int ai = 0; ai < 2; ++ai)
#pragma unroll
            for (int m = 0; m < 4; ++m) rs8[ai][m] = sin * row_rstd(ssp, row0 + ai * HALF + m * 16, inv_n, eps);
        asm volatile("" ::: "memory");
#pragma unroll
        for (int ai = 0; ai < 2; ++ai)
#pragma unroll
            for (int m = 0; m < 4; ++m) { const int row = row0 + ai * HALF + m * 16; bf16_t* rowp = O + (size_t)row * ldc + col0; const float rs = rs8[ai][m];
                const f32x4 g0 = acc[ai][0][m][0] * rs, g1 = acc[ai][0][m][1] * rs, u0 = acc[ai][1][m][0] * rs, u1 = acc[ai][1][m][1] * rs;
                u32x4 w; w.x = cvt_pk_bf16(silu_mul(g0[0], u0[0]), silu_mul(g0[1], u0[1])); w.y = cvt_pk_bf16(silu_mul(g0[2], u0[2]), silu_mul(g0[3], u0[3]));
                w.z = cvt_pk_bf16(silu_mul(g1[0], u1[0]), silu_mul(g1[1], u1[1])); w.w = cvt_pk_bf16(silu_mul(g1[2], u1[2]), silu_mul(g1[3], u1[3]));
                *(u32x4*)rowp = w; }
    }
};
struct EpiSwiGLU8 {
    static constexpr bool PERM = true, AFTER_DRAIN = false;
    unsigned char* O; int ldc; float sin, sout; const float* ssp; float inv_n, eps;
    __device__ __forceinline__ void operator()(const f32x4 (&acc)[2][2][4][2], const Unit& u, int wr, int wc, int fr, int fq) const {
        const int row0 = u.pm * BM + wr * 64 + fr, col0 = u.pn * HALF + wc * 32 + 8 * fq;
        float kg8[2][4];
#pragma unroll
        for (int ai = 0; ai < 2; ++ai)
#pragma unroll
            for (int m = 0; m < 4; ++m) kg8[ai][m] = ssp ? sin * row_rstd(ssp, row0 + ai * HALF + m * 16, inv_n, eps) : sin;
        asm volatile("" ::: "memory");
#pragma unroll
        for (int ai = 0; ai < 2; ++ai)
#pragma unroll
            for (int m = 0; m < 4; ++m) { const int row = row0 + ai * HALF + m * 16; unsigned char* rowp = O + (size_t)row * ldc + col0; const float kg = kg8[ai][m];
                const f32x4 g0 = acc[ai][0][m][0] * kg, g1 = acc[ai][0][m][1] * kg, u0 = acc[ai][1][m][0] * (kg * sout), u1 = acc[ai][1][m][1] * (kg * sout);
                u32x2 w; w.x = pk4_fp8(silu_mul(g0[0], u0[0]), silu_mul(g0[1], u0[1]), silu_mul(g0[2], u0[2]), silu_mul(g0[3], u0[3]));
                w.y = pk4_fp8(silu_mul(g1[0], u1[0]), silu_mul(g1[1], u1[1]), silu_mul(g1[2], u1[2]), silu_mul(g1[3], u1[3]));
                *(u32x2*)rowp = w; }
    }
};
struct EpiKVQ {
    static constexpr bool PERM = true, AFTER_DRAIN = false;
    bf16_t* K16; bf16_t* V16; bf16_t* Q16; const float* rope; int S; const float* ssp; float inv_n, eps;
    __device__ __forceinline__ void operator()(const f32x4 (&acc)[2][2][4][2], const Unit& u, int wr, int wc, int fr, int fq) const {
        const int row0 = u.pm * BM + wr * 64 + fr;
        const int kind = u.pn >> 3, head = u.pn & 7;
        float rs8[2][4];
#pragma unroll
        for (int ai = 0; ai < 2; ++ai)
#pragma unroll
            for (int m = 0; m < 4; ++m) rs8[ai][m] = row_rstd(ssp, row0 + ai * HALF + m * 16, inv_n, eps);
        asm volatile("" ::: "memory");
        if (kind == 1) {
#pragma unroll
            for (int ai = 0; ai < 2; ++ai)
#pragma unroll
                for (int m = 0; m < 4; ++m) { const int row = row0 + ai * HALF + m * 16; const float rs = rs8[ai][m];
#pragma unroll
                    for (int bj = 0; bj < 2; ++bj) { const f32x4 v0 = acc[ai][bj][m][0] * rs, v1 = acc[ai][bj][m][1] * rs;
                        u32x4 w; w.x = cvt_pk_bf16(v0[0], v0[1]); w.y = cvt_pk_bf16(v0[2], v0[3]); w.z = cvt_pk_bf16(v1[0], v1[1]); w.w = cvt_pk_bf16(v1[2], v1[3]);
                        *(u32x4*)(V16 + ((size_t)head * S + row) * 256 + bj * 128 + wc * 32 + 8 * fq) = w; } }
        } else {
            bf16_t* dst = (kind == 0 ? K16 : Q16) + (size_t)(head * 2 + (wc >> 1)) * S * 128;
            const int d0 = (wc & 1) * 32 + 8 * fq;
            f32x4 cn[4];
            { const f32x4* cs0 = (const f32x4*)(rope + ((size_t)row0 * 64 + d0) * 2); cn[0] = cs0[0]; cn[1] = cs0[1]; cn[2] = cs0[2]; cn[3] = cs0[3]; }
#pragma unroll
            for (int ai = 0; ai < 2; ++ai)
#pragma unroll
                for (int m = 0; m < 4; ++m) { const int row = row0 + ai * HALF + m * 16; const float rs = rs8[ai][m];
                    const f32x4 c01 = cn[0], c23 = cn[1], c45 = cn[2], c67 = cn[3];
                    { const int ix = ai * 4 + m + 1, rown = row0 + ((ix >> 2) & 1) * HALF + (ix & 3) * 16; const f32x4* cs = (const f32x4*)(rope + ((size_t)(ix < 8 ? rown : row) * 64 + d0) * 2);
                      cn[0] = cs[0]; cn[1] = cs[1]; cn[2] = cs[2]; cn[3] = cs[3]; }
                    asm volatile("" ::: "memory");
                    const f32x4 a0 = acc[ai][0][m][0] * rs, a1 = acc[ai][0][m][1] * rs, b0 = acc[ai][1][m][0] * rs, b1 = acc[ai][1][m][1] * rs;
                    float o1[8], o2[8];
                    o1[0] = a0[0] * c01[0] - b0[0] * c01[1]; o2[0] = b0[0] * c01[0] + a0[0] * c01[1];
                    o1[1] = a0[1] * c01[2] - b0[1] * c01[3]; o2[1] = b0[1] * c01[2] + a0[1] * c01[3];
                    o1[2] = a0[2] * c23[0] - b0[2] * c23[1]; o2[2] = b0[2] * c23[0] + a0[2] * c23[1];
                    o1[3] = a0[3] * c23[2] - b0[3] * c23[3]; o2[3] = b0[3] * c23[2] + a0[3] * c23[3];
                    o1[4] = a1[0] * c45[0] - b1[0] * c45[1]; o2[4] = b1[0] * c45[0] + a1[0] * c45[1];
                    o1[5] = a1[1] * c45[2] - b1[1] * c45[3]; o2[5] = b1[1] * c45[2] + a1[1] * c45[3];
                    o1[6] = a1[2] * c67[0] - b1[2] * c67[1]; o2[6] = b1[2] * c67[0] + a1[2] * c67[1];
                    o1[7] = a1[3] * c67[2] - b1[3] * c67[3]; o2[7] = b1[3] * c67[2] + a1[3] * c67[3];
                    u32x4 w1, w2; w1.x = cvt_pk_bf16(o1[0], o1[1]); w1.y = cvt_pk_bf16(o1[2], o1[3]); w1.z = cvt_pk_bf16(o1[4], o1[5]); w1.w = cvt_pk_bf16(o1[6], o1[7]);
                    w2.x = cvt_pk_bf16(o2[0], o2[1]); w2.y = cvt_pk_bf16(o2[2], o2[3]); w2.z = cvt_pk_bf16(o2[4], o2[5]); w2.w = cvt_pk_bf16(o2[6], o2[7]);
                    bf16_t* rp = dst + (size_t)row * 128 + d0;
                    *(u32x4*)rp = w1; *(u32x4*)(rp + 64) = w2; }
        }
    }
};

template <class Epi, class Sched, bool ALIGN_EPI = false, bool SP2 = false, bool F8 = false>
__device__ __forceinline__ void gemm_phase(PG8_LAS unsigned char* lds, const int rowbytes  , const Sched& S, const Epi& E, const int wave_id, const int kbytes = 0  ) {
    const int lane = fresh_lane(), wid = wave_id, tid = wid * 64 + lane, wr = wid >> 2, wc = wid & 3, fr = lane & 15, fq = lane >> 4;
    const int nt = (kbytes ? kbytes : rowbytes) / (BK * 2);
    unsigned voffA[2], voffB[2];
#pragma unroll
    for (int i = 0; i < 2; ++i) { int R, C; stage_rc(tid * 16 + i * 8192, R, C); const int Rb = Epi::PERM ? ((R & ~31) + perm32(R & 31)) : R;
        voffA[i] = (unsigned)(R * rowbytes + C * 2); voffB[i] = (unsigned)(Rb * rowbytes + C * 2); }
    const size_t kstep = (size_t)(BK * 2);
    const size_t hstep = (size_t)HALF * rowbytes;
    const unsigned ldsw = (unsigned)wid * 1024u;
    const int aoff = lds_byte(wr * 64 + fr, fq * 8), boff = lds_byte(wc * 32 + fr, fq * 8);
#define PG8_SA(b, h) (((b) * 2 + (h)) * HTB)
#define PG8_SB(b, h) ((4 + (b) * 2 + (h)) * HTB)
#define PG8_STAGE(bufoff, gbase, voff) do { _Pragma("unroll") for (int _i = 0; _i < 2; ++_i) \
        __builtin_amdgcn_global_load_lds((const unsigned*)((const char*)(gbase) + (voff)[_i]), (PG8_LAS unsigned*)(lds + (bufoff) + ldsw + _i * 8192), 16, 0, 0); } while (0)
#define PG8_LDA(dst, b, h) do { _Pragma("unroll") for (int m = 0; m < 4; ++m) { if constexpr (F8) { dst##8[m] = __builtin_shufflevector(*(const PG8_LAS i32x4*)(lds + PG8_SA(b, h) + aoff + m * 2048), *(const PG8_LAS i32x4*)(lds + PG8_SA(b, h) + aoff + m * 2048 + 1024), 0, 1, 2, 3, 4, 5, 6, 7); } \
        else { _Pragma("unroll") for (int k = 0; k < 2; ++k) dst[m][k] = *(const PG8_LAS bf16x8*)(lds + PG8_SA(b, h) + aoff + m * 2048 + k * 1024); } } } while (0)
#define PG8_LDB(dst, b, h) do { _Pragma("unroll") for (int n = 0; n < 2; ++n) { if constexpr (F8) { dst##8[n] = __builtin_shufflevector(*(const PG8_LAS i32x4*)(lds + PG8_SB(b, h) + boff + n * 2048), *(const PG8_LAS i32x4*)(lds + PG8_SB(b, h) + boff + n * 2048 + 1024), 0, 1, 2, 3, 4, 5, 6, 7); } \
        else { _Pragma("unroll") for (int k = 0; k < 2; ++k) dst[n][k] = *(const PG8_LAS bf16x8*)(lds + PG8_SB(b, h) + boff + n * 2048 + k * 1024); } } } while (0)
#define PG8_MMA(ai, bj, At, Bt) do { __builtin_amdgcn_s_setprio(1); _Pragma("unroll") for (int m = 0; m < 4; ++m) _Pragma("unroll") for (int n = 0; n < 2; ++n) { \
        if constexpr (F8) { asm volatile("v_mfma_scale_f32_16x16x128_f8f6f4 %0, %1, %2, %0, %3, %3 op_sel_hi:[0,0,0]" : "+v"(acc[ai][bj][m][n]) : "v"(Bt##8[n]), "v"(At##8[m]), "v"(sc1)); }     \
        else { _Pragma("unroll") for (int k = 0; k < 2; ++k) acc[ai][bj][m][n] = __builtin_amdgcn_mfma_f32_16x16x32_bf16(Bt[n][k], At[m][k], acc[ai][bj][m][n], 0, 0, 0); } } \
        __builtin_amdgcn_s_setprio(0); } while (0)
#define PG8_WAIT_V(n) asm volatile("s_waitcnt vmcnt(" #n ")" ::: "memory")
#define PG8_WAIT_L(n) asm volatile("s_waitcnt lgkmcnt(" #n ")" ::: "memory")
#define PG8_BAR __builtin_amdgcn_s_barrier()
#define PG8_SCHED __builtin_amdgcn_sched_barrier(0)
    Unit cur, nxt; int ui = 0;
    if (!S.next(0, cur)) return;
    f32x4 acc[2][2][4][2];
#pragma unroll
    for (int a = 0; a < 2; ++a)
#pragma unroll
        for (int b = 0; b < 2; ++b)
#pragma unroll
            for (int m = 0; m < 4; ++m)
#pragma unroll
                for (int n = 0; n < 2; ++n) acc[a][b][m][n] = (f32x4){0.f, 0.f, 0.f, 0.f};
    const int sc1 = 0x7f7f7f7f;
    bf16x8 At[4][2], B0[2][2], B1[2][2]; i32x8 At8[4], B08[2], B18[2];
    const char* cA = cur.A; const char* cB = cur.B;
    S.a_ready(cur);
    if constexpr (SP2) {
        PG8_STAGE(PG8_SB(0, 0), cB, voffB); PG8_STAGE(PG8_SB(0, 1), cB + hstep, voffB); PG8_STAGE(PG8_SA(0, 0), cA, voffA); PG8_STAGE(PG8_SA(0, 1), cA + hstep, voffA);
        if (wr == 1) PG8_BAR;
        PG8_WAIT_V(2); PG8_BAR;
        PG8_STAGE(PG8_SB(1, 0), cB + kstep, voffB); PG8_STAGE(PG8_SA(1, 0), cA + kstep, voffA); PG8_STAGE(PG8_SB(1, 1), cB + hstep + kstep, voffB);
        PG8_WAIT_V(6); PG8_BAR;
    } else {
        PG8_STAGE(PG8_SB(0, 0), cB, voffB); PG8_STAGE(PG8_SA(0, 0), cA, voffA); PG8_STAGE(PG8_SB(0, 1), cB + hstep, voffB); PG8_STAGE(PG8_SA(0, 1), cA + hstep, voffA);
        if (wr == 1) PG8_BAR;
        PG8_WAIT_V(4); PG8_BAR;
        PG8_STAGE(PG8_SB(1, 0), cB + kstep, voffB); PG8_STAGE(PG8_SA(1, 0), cA + kstep, voffA); PG8_STAGE(PG8_SB(1, 1), cB + hstep + kstep, voffB);
        PG8_WAIT_V(6); PG8_BAR;
    }
    for (;;) {
        const bool has_next = S.next(ui + 1, nxt);
        const char* nA = has_next ? nxt.A : cA; const char* nB = has_next ? nxt.B : cB;
        for (int t = 0; t < nt; t += 2) {
            const bool last = (t == nt - 2);
            const char* a1 = cA + (size_t)(t + 1) * kstep;
            const char* a2 = last ? nA : cA + (size_t)(t + 2) * kstep; const char* b2 = last ? nB : cB + (size_t)(t + 2) * kstep;
            const char* a3 = a2 + kstep; const char* b3 = b2 + kstep;
            if (last && has_next) S.a_ready(nxt);
            if constexpr (SP2) {
            PG8_LDB(B0, 0, 0); PG8_LDB(B1, 0, 1); PG8_SCHED; PG8_LDA(At, 0, 0); PG8_STAGE(PG8_SA(1, 1), a1 + hstep, voffA);
            PG8_WAIT_V(8); PG8_WAIT_L(0); PG8_BAR; PG8_MMA(0, 0, At, B0); PG8_MMA(0, 1, At, B1); PG8_BAR; PG8_SCHED;
            PG8_LDA(At, 0, 1); PG8_STAGE(PG8_SB(0, 0), b2, voffB); PG8_STAGE(PG8_SB(0, 1), b2 + hstep, voffB); PG8_STAGE(PG8_SA(0, 0), a2, voffA);
            PG8_WAIT_V(8); PG8_WAIT_L(0); PG8_BAR; PG8_MMA(1, 0, At, B0); PG8_MMA(1, 1, At, B1); PG8_BAR; PG8_SCHED;
            PG8_LDB(B0, 1, 0); PG8_LDB(B1, 1, 1); PG8_SCHED; PG8_LDA(At, 1, 0); PG8_STAGE(PG8_SA(0, 1), a2 + hstep, voffA);
            PG8_WAIT_V(8); PG8_WAIT_L(0); PG8_BAR; PG8_MMA(0, 0, At, B0); PG8_MMA(0, 1, At, B1); PG8_BAR; PG8_SCHED;
            PG8_LDA(At, 1, 1); PG8_STAGE(PG8_SB(1, 0), b3, voffB); PG8_STAGE(PG8_SB(1, 1), b3 + hstep, voffB); PG8_STAGE(PG8_SA(1, 0), a3, voffA);
            PG8_WAIT_V(8); PG8_WAIT_L(0); PG8_BAR; PG8_MMA(1, 0, At, B0); PG8_MMA(1, 1, At, B1); PG8_BAR; PG8_SCHED;
            } else {
            PG8_LDB(B0, 0, 0); PG8_SCHED; PG8_LDA(At, 0, 0); PG8_STAGE(PG8_SA(1, 1), a1 + hstep, voffA);
            PG8_WAIT_L(8); PG8_BAR; PG8_WAIT_L(0); PG8_MMA(0, 0, At, B0); PG8_BAR; PG8_SCHED;
            PG8_LDB(B1, 0, 1); PG8_STAGE(PG8_SB(0, 0), b2, voffB);
            PG8_BAR; PG8_WAIT_L(0); PG8_MMA(0, 1, At, B1); PG8_BAR;
            PG8_LDA(At, 0, 1); PG8_STAGE(PG8_SA(0, 0), a2, voffA);
            PG8_BAR; PG8_WAIT_L(0); PG8_MMA(1, 0, At, B0); PG8_BAR; PG8_SCHED;
            PG8_STAGE(PG8_SB(0, 1), b2 + hstep, voffB);
            PG8_WAIT_V(6); PG8_BAR; PG8_MMA(1, 1, At, B1); PG8_BAR;
            PG8_LDB(B0, 1, 0); PG8_SCHED; PG8_LDA(At, 1, 0); PG8_STAGE(PG8_SA(0, 1), a2 + hstep, voffA);
            PG8_WAIT_L(8); PG8_BAR; PG8_WAIT_L(0); PG8_MMA(0, 0, At, B0); PG8_BAR; PG8_SCHED;
            PG8_LDB(B1, 1, 1); PG8_STAGE(PG8_SB(1, 0), b3, voffB);
            PG8_BAR; PG8_WAIT_L(0); PG8_MMA(0, 1, At, B1); PG8_BAR;
            PG8_LDA(At, 1, 1); PG8_STAGE(PG8_SA(1, 0), a3, voffA);
            PG8_BAR; PG8_WAIT_L(0); PG8_MMA(1, 0, At, B0); PG8_BAR; PG8_SCHED;
            PG8_STAGE(PG8_SB(1, 1), b3 + hstep, voffB);
            PG8_WAIT_V(6); PG8_BAR; PG8_MMA(1, 1, At, B1); PG8_BAR;
            }
        }
        if constexpr (ALIGN_EPI) { if (wr == 0) PG8_BAR; }
        if constexpr (F8) { asm volatile("s_nop 15\n\ts_nop 15" ::: "memory"); }
        if constexpr (!Epi::AFTER_DRAIN) { const int le_ = fresh_lane(); E(acc, cur, wr, wc, le_ & 15, le_ >> 4); S.done(cur); }
        if (!has_next) break;
#pragma unroll
        for (int a = 0; a < 2; ++a)
#pragma unroll
            for (int b = 0; b < 2; ++b)
#pragma unroll
                for (int m = 0; m < 4; ++m)
#pragma unroll
                    for (int n = 0; n < 2; ++n) acc[a][b][m][n] = (f32x4){0.f, 0.f, 0.f, 0.f};
        if constexpr (F8) { asm volatile("s_nop 7" ::: "memory"); }
        cur = nxt; cA = nA; cB = nB; ++ui;
        if constexpr (ALIGN_EPI) { if (wr == 1) PG8_BAR; }
    }
    PG8_WAIT_V(0);
    if constexpr (!ALIGN_EPI) { if (wr == 0) PG8_BAR; }
    PG8_BAR;
    if constexpr (Epi::AFTER_DRAIN) { E.fused(acc, cur, wr, wc, fr, fq, lds, wid, lane); S.done(cur); }
#undef PG8_SA
#undef PG8_SB
#undef PG8_STAGE
#undef PG8_LDA
#undef PG8_LDB
#undef PG8_MMA
#undef PG8_WAIT_V
#undef PG8_WAIT_L
#undef PG8_BAR
#undef PG8_SCHED
}

}

namespace attn {
constexpr int D = 128; constexpr float THR = 8.f; constexpr bool WSKIP = false;
constexpr float SCALE = 0.08838834764831845f;
constexpr int NW = 8, QBLK = 32, KVBLK = 64, QB = NW * QBLK;
constexpr int DV = 256;
constexpr int SHM_V = KVBLK * DV * 2, SHM_K = KVBLK * D * 2;
constexpr int LDS_BYTES = 2 * SHM_V + 2 * SHM_K + NW * 64 * 4;

using bf16 = __hip_bfloat16;
typedef short bf16x8 __attribute__((ext_vector_type(8)));
typedef short s16x4 __attribute__((ext_vector_type(4)));
typedef float f32x16 __attribute__((ext_vector_type(16)));
typedef float f32x4 __attribute__((ext_vector_type(4)));
typedef unsigned u32x4 __attribute__((ext_vector_type(4)));
template <class A, class Bt> struct same_t { static constexpr bool v = false; };
template <class A> struct same_t<A, A> { static constexpr bool v = true; };

#define KSWZ(row, colB) ((row) * 256 + ((colB) ^ (((row) & 7) << 4)))
#define SBAR() __builtin_amdgcn_sched_barrier(0)
__device__ __forceinline__ int v_st(int k, int c) { const int kk = (k & ~0xC) | ((k & 4) << 1) | ((k & 8) >> 1); return ((kk >> 3) * 4 + (c >> 5)) * 512 + ((kk & 7) * 32 + (c & 31)) * 2; }
__device__ __forceinline__ int v_rd_base(int lane) { return ((lane & 3) << 3) | (((lane >> 2) & 3) << 6) | (((lane >> 4) & 1) << 5) | (((lane >> 5) & 1) << 8); }
constexpr int v_rd_off(int d0, int ks, int half) { return d0 * 512 + ks * 4096 + half * 2048; }
__device__ __forceinline__ int crow(int r, int hi) { return (r & 3) + 8 * (r >> 2) + 4 * hi; }
__device__ __forceinline__ unsigned cvtpk(float lo, float hi) {
    unsigned r; asm volatile("v_cvt_pk_bf16_f32 %0, %1, %2" : "=v"(r) : "v"(lo), "v"(hi)); return r;
}
__device__ __forceinline__ bf16x8 pack8(f32x4 a, f32x4 b) {
    u32x4 w = {cvtpk(a[0], a[1]), cvtpk(a[2], a[3]), cvtpk(b[0], b[1]), cvtpk(b[2], b[3])};
    return *reinterpret_cast<bf16x8*>(&w);
}
template <class T> __device__ __forceinline__ bf16x8 load8(const T* p) {
    if constexpr (same_t<T, float>::v) { return pack8(*(const f32x4*)p, *(const f32x4*)(p + 4)); }
    else { return *reinterpret_cast<const bf16x8*>(p); }
}
__device__ __forceinline__ void mask_tile(f32x16& p0, f32x16& p1, int dq, unsigned W) {
    const float NEG = -__builtin_inff();
#pragma unroll
    for (int r = 0; r < 16; ++r) {
        const int c = (r & 3) + 8 * (r >> 2);
        if ((unsigned)(dq - c) >= W) p0[r] = NEG;
        if ((unsigned)(dq - c - 32) >= W) p1[r] = NEG;
    }
}
__device__ __forceinline__ void partialSM(f32x16& p0, f32x16& p1, float& m_reg, float& mn, float& alpha) {
    float pmax = p0[0]; for (int r = 1; r < 16; ++r) pmax = fmaxf(pmax, p0[r]); for (int r = 0; r < 16; ++r) pmax = fmaxf(pmax, p1[r]);
    { auto rr = __builtin_amdgcn_permlane32_swap(__float_as_uint(pmax), __float_as_uint(pmax), false, false);
      pmax = fmaxf(__uint_as_float(rr[0]), __uint_as_float(rr[1])); }
    constexpr float C2 = 1.4426950408889634f * SCALE;
    if (__builtin_expect(__all((pmax - m_reg) * SCALE <= THR), 1)) { mn = m_reg; alpha = 1.f; }
    else { mn = fmaxf(m_reg, pmax); alpha = __builtin_amdgcn_exp2f((m_reg - mn) * C2); m_reg = mn; }
    const float mnL = -mn * C2;
    for (int r = 0; r < 16; ++r) p0[r] = fmaf(p0[r], C2, mnL); for (int r = 0; r < 16; ++r) p1[r] = fmaf(p1[r], C2, mnL);
    for (int r = 0; r < 16; ++r) p0[r] = __builtin_amdgcn_exp2f(p0[r]);
}
__device__ __forceinline__ void finishSM(f32x16& p0, f32x16& p1, float alpha, float& l_reg, bf16x8& pa0, bf16x8& pa1, bf16x8& pa2, bf16x8& pa3) {
    for (int r = 0; r < 16; ++r) p1[r] = __builtin_amdgcn_exp2f(p1[r]);
    float ps = 0; for (int r = 0; r < 16; ++r) ps += p0[r]; for (int r = 0; r < 16; ++r) ps += p1[r];
    { auto rr = __builtin_amdgcn_permlane32_swap(__float_as_uint(ps), __float_as_uint(ps), false, false);
      ps = __uint_as_float(rr[0]) + __uint_as_float(rr[1]); }
    l_reg = l_reg * alpha + ps;
#define PK4(P, B_, OUT) do { unsigned a0 = cvtpk(P[B_+0], P[B_+1]), a1 = cvtpk(P[B_+2], P[B_+3]);                          \
        unsigned b0 = cvtpk(P[B_+4], P[B_+5]), b1 = cvtpk(P[B_+6], P[B_+7]);                                             \
        auto r0 = __builtin_amdgcn_permlane32_swap(a0, b0, false, false); auto r1 = __builtin_amdgcn_permlane32_swap(a1, b1, false, false); \
        u32x4 w = {r0[0], r1[0], r0[1], r1[1]}; OUT = *reinterpret_cast<bf16x8*>(&w); } while (0)
    PK4(p0, 0, pa0); PK4(p0, 8, pa1); PK4(p1, 0, pa2); PK4(p1, 8, pa3);
#undef PK4
}
template <int KB, bool SK>
__device__ __forceinline__ void qkt(f32x16& p0, f32x16& p1, const char* K_lds, int r32, int hi, const bf16x8* qr, bool act) {
    if (SK && !act) { const float NEG = -__builtin_inff();
#pragma unroll
        for (int r = 0; r < 16; ++r) { p0[r] = NEG; p1[r] = NEG; } return; }
    p0 = f32x16{}; p1 = f32x16{};
    const char* kb[4];
#pragma unroll
    for (int dd = 0; dd < 4; ++dd) kb[dd] = K_lds + KB * SHM_K + KSWZ(r32, (dd * 16 + hi * 8) * 2);
#pragma unroll
    for (int d0 = 0; d0 < 8; ++d0) { const char* a = kb[d0 & 3] + (d0 >> 2) * 128;
        bf16x8 b0 = *reinterpret_cast<const bf16x8*>(a);
        bf16x8 b1 = *reinterpret_cast<const bf16x8*>(a + 32 * 256);
        p0 = __builtin_amdgcn_mfma_f32_32x32x16_bf16(b0, qr[d0], p0, 0, 0, 0);
        p1 = __builtin_amdgcn_mfma_f32_32x32x16_bf16(b1, qr[d0], p1, 0, 0, 0); }
}


#define AT2_LAS __attribute__((address_space(3)))
template <int VB>
__device__ __forceinline__ void pv_tile8(f32x16* o, const AT2_LAS char* vb, bf16x8 pa0, bf16x8 pa1, bf16x8 pa2, bf16x8 pa3) {
#define TRR(off) __builtin_amdgcn_ds_read_tr16_b64_v4i16((AT2_LAS s16x4*)(vb + (off)))
#pragma unroll
    for (int d0 = 0; d0 < 8; ++d0) { const int b_ = VB * SHM_V + d0 * 512;
        const s16x4 l0 = TRR(b_), h0 = TRR(b_ + 4096), l1 = TRR(b_ + 8192), h1 = TRR(b_ + 12288), l2 = TRR(b_ + 16384), h2 = TRR(b_ + 20480), l3 = TRR(b_ + 24576), h3 = TRR(b_ + 28672);
        o[d0] = __builtin_amdgcn_mfma_f32_32x32x16_bf16(pa0, (bf16x8){l0[0], l0[1], l0[2], l0[3], h0[0], h0[1], h0[2], h0[3]}, o[d0], 0, 0, 0);
        o[d0] = __builtin_amdgcn_mfma_f32_32x32x16_bf16(pa1, (bf16x8){l1[0], l1[1], l1[2], l1[3], h1[0], h1[1], h1[2], h1[3]}, o[d0], 0, 0, 0);
        o[d0] = __builtin_amdgcn_mfma_f32_32x32x16_bf16(pa2, (bf16x8){l2[0], l2[1], l2[2], l2[3], h2[0], h2[1], h2[2], h2[3]}, o[d0], 0, 0, 0);
        o[d0] = __builtin_amdgcn_mfma_f32_32x32x16_bf16(pa3, (bf16x8){l3[0], l3[1], l3[2], l3[3], h3[0], h3[1], h3[2], h3[3]}, o[d0], 0, 0, 0); }
#undef TRR
}
__device__ __forceinline__ void softmax_main(f32x16& p0, f32x16& p1, float& m_reg, float& alpha, float& ps) {
    float pmax = p0[0];
#pragma unroll
    for (int r = 1; r < 16; ++r) pmax = fmaxf(pmax, p0[r]);
#pragma unroll
    for (int r = 0; r < 16; ++r) pmax = fmaxf(pmax, p1[r]);
    { auto rr = __builtin_amdgcn_permlane32_swap(__float_as_uint(pmax), __float_as_uint(pmax), false, false);
      pmax = fmaxf(__uint_as_float(rr[0]), __uint_as_float(rr[1])); }
    constexpr float C2 = 1.4426950408889634f * SCALE;
    const bool keep = __all((pmax - m_reg) * SCALE <= THR);
    const float mn = keep ? m_reg : fmaxf(m_reg, pmax);
    alpha = __builtin_amdgcn_exp2f((m_reg - mn) * C2);
    m_reg = mn;
    const float mnL = -mn * C2;
#pragma unroll
    for (int r = 0; r < 16; ++r) { p0[r] = __builtin_amdgcn_exp2f(fmaf(p0[r], C2, mnL)); p1[r] = __builtin_amdgcn_exp2f(fmaf(p1[r], C2, mnL)); }
    float s = 0.f;
#pragma unroll
    for (int r = 0; r < 16; ++r) s += p0[r];
#pragma unroll
    for (int r = 0; r < 16; ++r) s += p1[r];
    { auto rr = __builtin_amdgcn_permlane32_swap(__float_as_uint(s), __float_as_uint(s), false, false);
      ps = __uint_as_float(rr[0]) + __uint_as_float(rr[1]); }
}
__device__ __forceinline__ void pack_p(const f32x16& p0, const f32x16& p1, bf16x8& pa0, bf16x8& pa1, bf16x8& pa2, bf16x8& pa3) {
#define PK4(P, B_, OUT) do { unsigned a0 = cvtpk(P[B_+0], P[B_+1]), a1 = cvtpk(P[B_+2], P[B_+3]);                          \
        unsigned b0 = cvtpk(P[B_+4], P[B_+5]), b1 = cvtpk(P[B_+6], P[B_+7]);                                             \
        auto r0 = __builtin_amdgcn_permlane32_swap(a0, b0, false, false); auto r1 = __builtin_amdgcn_permlane32_swap(a1, b1, false, false); \
        u32x4 w = {r0[0], r1[0], r0[1], r1[1]}; OUT = *reinterpret_cast<bf16x8*>(&w); } while (0)
    PK4(p0, 0, pa0); PK4(p0, 8, pa1); PK4(p1, 0, pa2); PK4(p1, 8, pa3);
#undef PK4
}
struct Block2 { const bf16* Q; const bf16* K; const bf16* V; unsigned short* O; int P0; };
__device__ __forceinline__ void attn_block2(const Block2& cur, char* lds, AT2_LAS unsigned char* L, const int wave_id) {
    const int lane = fresh_lane(), wid = wave_id, r32 = lane & 31, hi = lane >> 5;
    const int NT = (cur.P0 + QB - 1) / KVBLK + 1;
    const int qlo = cur.P0 + wid * QBLK;
    char* K_lds = lds + 2 * SHM_V;
    float* ws = (float*)(lds + 2 * SHM_V + 2 * SHM_K) + wid * 64; float* li_l = ws, * al_l = ws + 32;
#define AT2_GLDS(g, l) __builtin_amdgcn_global_load_lds((const unsigned*)(g), (AT2_LAS unsigned*)(l), 16, 0, 0)
#define AT2_DMA_K(t, b) do { const char* kg_ = (const char*)cur.K + (size_t)(t) * (KVBLK * D * 2); const unsigned ln_ = (unsigned)fresh_lane(), kr0 = 8u * wid + (ln_ >> 4), kr1 = kr0 + 4u; \
        const unsigned koff0 = kr0 * 256u + (((ln_ & 15u) ^ (kr0 & 7u)) << 4), koff1 = kr1 * 256u + (((ln_ & 15u) ^ (kr1 & 7u)) << 4); \
        AT2_GLDS(kg_ + koff0, L + 2 * SHM_V + (b) * SHM_K + (2 * wid) * 1024); AT2_GLDS(kg_ + koff1, L + 2 * SHM_V + (b) * SHM_K + (2 * wid + 1) * 1024); } while (0)
#define AT2_DMA_V(t, b) do { const char* vg_ = (const char*)cur.V + (size_t)(t) * (KVBLK * DV * 2); const unsigned ln_ = (unsigned)fresh_lane(), kkv = 8u * wid + ((ln_ & 31u) >> 2); \
        const unsigned keyv = (kkv & ~0xCu) | ((kkv & 4u) << 1) | ((kkv & 8u) >> 1), voff = keyv * 512u + (ln_ >> 5) * 64u + (ln_ & 3u) * 16u; \
        _Pragma("unroll") for (int i_ = 0; i_ < 4; ++i_) AT2_GLDS(vg_ + i_ * 128 + voff, L + (b) * SHM_V + (4 * wid + i_) * 1024); } while (0)
    bf16x8 qr[8];
#pragma unroll
    for (int d0 = 0; d0 < 8; ++d0) qr[d0] = load8<bf16>(cur.Q + (size_t)(wid * QBLK + r32) * D + d0 * 16 + hi * 8);
    AT2_DMA_K(0, 0);
    float m_reg = -1e30f, l_reg = 0; f32x16 o[8] = {};
    f32x16 p0, p1; float al, ps; bf16x8 pa0, pa1, pa2, pa3;
#define RESC(a) do { if (__any((a) < 1.f)) { const int lr_ = fresh_lane(), hr_ = lr_ >> 5; if (hr_ == 0) al_l[lr_ & 31] = (a); asm volatile("s_waitcnt lgkmcnt(0)" ::: "memory");              \
                     for (int d_ = 0; d_ < 8; ++d_) for (int r = 0; r < 16; ++r) o[d_][r] *= al_l[crow(r, hr_)]; } } while (0)
#define AT2_TRR(off) __builtin_amdgcn_ds_read_tr16_b64_v4i16((AT2_LAS s16x4*)(vb + (off)))
#define MX3(a_, b_, c_) fmaxf(fmaxf((a_), (b_)), (c_))
#define AT2_PK4(P, B_, OUT) do { unsigned a0_ = cvtpk(P[B_+0], P[B_+1]), a1_ = cvtpk(P[B_+2], P[B_+3]), b0_ = cvtpk(P[B_+4], P[B_+5]), b1_ = cvtpk(P[B_+6], P[B_+7]); \
        auto r0_ = __builtin_amdgcn_permlane32_swap(a0_, b0_, false, false); auto r1_ = __builtin_amdgcn_permlane32_swap(a1_, b1_, false, false); \
        u32x4 w_ = {r0_[0], r1_[0], r0_[1], r1_[1]}; OUT = *reinterpret_cast<bf16x8*>(&w_); } while (0)
#define AT2_PV_SM(VB) do { const AT2_LAS char* vb = (const AT2_LAS char*)L + v_rd_base(fresh_lane()); constexpr float C2_ = 1.4426950408889634f * SCALE; float mxa, mxb, mnL_; ps = 0.f; s16x4 fl0, fh0, fl1, fh1, fl2, fh2, fl3, fh3; \
        constexpr int vbo_ = (VB) * SHM_V; \
        fl0 = AT2_TRR(vbo_ + 0); fh0 = AT2_TRR(vbo_ + 4096); \
        fl1 = AT2_TRR(vbo_ + 8192); fh1 = AT2_TRR(vbo_ + 12288); \
        fl2 = AT2_TRR(vbo_ + 16384); fh2 = AT2_TRR(vbo_ + 20480); \
        fl3 = AT2_TRR(vbo_ + 24576); fh3 = AT2_TRR(vbo_ + 28672); \
        SBAR(); \
        o[0] = __builtin_amdgcn_mfma_f32_32x32x16_bf16(pa0, (bf16x8){fl0[0], fl0[1], fl0[2], fl0[3], fh0[0], fh0[1], fh0[2], fh0[3]}, o[0], 0, 0, 0); fl0 = AT2_TRR(vbo_ + 512); fh0 = AT2_TRR(vbo_ + 4608); mxa = MX3(p0[0], p0[1], p0[2]); mxb = MX3(p1[0], p1[1], p1[2]); mxa = MX3(mxa, p0[3], p0[4]); mxb = MX3(mxb, p1[3], p1[4]); SBAR(); \
        o[0] = __builtin_amdgcn_mfma_f32_32x32x16_bf16(pa1, (bf16x8){fl1[0], fl1[1], fl1[2], fl1[3], fh1[0], fh1[1], fh1[2], fh1[3]}, o[0], 0, 0, 0); fl1 = AT2_TRR(vbo_ + 8704); fh1 = AT2_TRR(vbo_ + 12800); mxa = MX3(mxa, p0[5], p0[6]); mxb = MX3(mxb, p1[5], p1[6]); mxa = MX3(mxa, p0[7], p0[8]); mxb = MX3(mxb, p1[7], p1[8]); SBAR(); \
        o[0] = __builtin_amdgcn_mfma_f32_32x32x16_bf16(pa2, (bf16x8){fl2[0], fl2[1], fl2[2], fl2[3], fh2[0], fh2[1], fh2[2], fh2[3]}, o[0], 0, 0, 0); fl2 = AT2_TRR(vbo_ + 16896); fh2 = AT2_TRR(vbo_ + 20992); mxa = MX3(mxa, p0[9], p0[10]); mxb = MX3(mxb, p1[9], p1[10]); mxa = MX3(mxa, p0[11], p0[12]); mxb = MX3(mxb, p1[11], p1[12]); SBAR(); \
        o[0] = __builtin_amdgcn_mfma_f32_32x32x16_bf16(pa3, (bf16x8){fl3[0], fl3[1], fl3[2], fl3[3], fh3[0], fh3[1], fh3[2], fh3[3]}, o[0], 0, 0, 0); fl3 = AT2_TRR(vbo_ + 25088); fh3 = AT2_TRR(vbo_ + 29184); mxa = MX3(mxa, p0[13], p0[14]); mxb = MX3(mxb, p1[13], p1[14]); mxa = fmaxf(mxa, p0[15]); mxb = fmaxf(mxb, p1[15]); SBAR(); \
        o[1] = __builtin_amdgcn_mfma_f32_32x32x16_bf16(pa0, (bf16x8){fl0[0], fl0[1], fl0[2], fl0[3], fh0[0], fh0[1], fh0[2], fh0[3]}, o[1], 0, 0, 0); fl0 = AT2_TRR(vbo_ + 1024); fh0 = AT2_TRR(vbo_ + 5120); mxa = fmaxf(mxa, mxb); { auto rr_ = __builtin_amdgcn_permlane32_swap(__float_as_uint(mxa), __float_as_uint(mxa), false, false); mxa = fmaxf(__uint_as_float(rr_[0]), __uint_as_float(rr_[1])); } SBAR(); \
        o[1] = __builtin_amdgcn_mfma_f32_32x32x16_bf16(pa1, (bf16x8){fl1[0], fl1[1], fl1[2], fl1[3], fh1[0], fh1[1], fh1[2], fh1[3]}, o[1], 0, 0, 0); fl1 = AT2_TRR(vbo_ + 9216); fh1 = AT2_TRR(vbo_ + 13312); { const bool keep_ = __all((mxa - m_reg) * SCALE <= THR); const float mn_ = keep_ ? m_reg : fmaxf(m_reg, mxa); al = __builtin_amdgcn_exp2f((m_reg - mn_) * C2_); m_reg = mn_; mnL_ = -mn_ * C2_; } SBAR(); \
        o[1] = __builtin_amdgcn_mfma_f32_32x32x16_bf16(pa2, (bf16x8){fl2[0], fl2[1], fl2[2], fl2[3], fh2[0], fh2[1], fh2[2], fh2[3]}, o[1], 0, 0, 0); fl2 = AT2_TRR(vbo_ + 17408); fh2 = AT2_TRR(vbo_ + 21504); p0[0] = __builtin_amdgcn_exp2f(fmaf(p0[0], C2_, mnL_)); p0[1] = __builtin_amdgcn_exp2f(fmaf(p0[1], C2_, mnL_)); SBAR(); \
        o[1] = __builtin_amdgcn_mfma_f32_32x32x16_bf16(pa3, (bf16x8){fl3[0], fl3[1], fl3[2], fl3[3], fh3[0], fh3[1], fh3[2], fh3[3]}, o[1], 0, 0, 0); fl3 = AT2_TRR(vbo_ + 25600); fh3 = AT2_TRR(vbo_ + 29696); ps += p0[0]; ps += p0[1]; p0[2] = __builtin_amdgcn_exp2f(fmaf(p0[2], C2_, mnL_)); SBAR(); \
        o[2] = __builtin_amdgcn_mfma_f32_32x32x16_bf16(pa0, (bf16x8){fl0[0], fl0[1], fl0[2], fl0[3], fh0[0], fh0[1], fh0[2], fh0[3]}, o[2], 0, 0, 0); fl0 = AT2_TRR(vbo_ + 1536); fh0 = AT2_TRR(vbo_ + 5632); ps += p0[2]; p0[3] = __builtin_amdgcn_exp2f(fmaf(p0[3], C2_, mnL_)); p0[4] = __builtin_amdgcn_exp2f(fmaf(p0[4], C2_, mnL_)); SBAR(); \
        o[2] = __builtin_amdgcn_mfma_f32_32x32x16_bf16(pa1, (bf16x8){fl1[0], fl1[1], fl1[2], fl1[3], fh1[0], fh1[1], fh1[2], fh1[3]}, o[2], 0, 0, 0); fl1 = AT2_TRR(vbo_ + 9728); fh1 = AT2_TRR(vbo_ + 13824); ps += p0[3]; ps += p0[4]; p0[5] = __builtin_amdgcn_exp2f(fmaf(p0[5], C2_, mnL_)); SBAR(); \
        o[2] = __builtin_amdgcn_mfma_f32_32x32x16_bf16(pa2, (bf16x8){fl2[0], fl2[1], fl2[2], fl2[3], fh2[0], fh2[1], fh2[2], fh2[3]}, o[2], 0, 0, 0); fl2 = AT2_TRR(vbo_ + 17920); fh2 = AT2_TRR(vbo_ + 22016); ps += p0[5]; p0[6] = __builtin_amdgcn_exp2f(fmaf(p0[6], C2_, mnL_)); p0[7] = __builtin_amdgcn_exp2f(fmaf(p0[7], C2_, mnL_)); SBAR(); \
        o[2] = __builtin_amdgcn_mfma_f32_32x32x16_bf16(pa3, (bf16x8){fl3[0], fl3[1], fl3[2], fl3[3], fh3[0], fh3[1], fh3[2], fh3[3]}, o[2], 0, 0, 0); fl3 = AT2_TRR(vbo_ + 26112); fh3 = AT2_TRR(vbo_ + 30208); ps += p0[6]; ps += p0[7]; p0[8] = __builtin_amdgcn_exp2f(fmaf(p0[8], C2_, mnL_)); SBAR(); \
        o[3] = __builtin_amdgcn_mfma_f32_32x32x16_bf16(pa0, (bf16x8){fl0[0], fl0[1], fl0[2], fl0[3], fh0[0], fh0[1], fh0[2], fh0[3]}, o[3], 0, 0, 0); fl0 = AT2_TRR(vbo_ + 2048); fh0 = AT2_TRR(vbo_ + 6144); ps += p0[8]; p0[9] = __builtin_amdgcn_exp2f(fmaf(p0[9], C2_, mnL_)); p0[10] = __builtin_amdgcn_exp2f(fmaf(p0[10], C2_, mnL_)); SBAR(); \
        o[3] = __builtin_amdgcn_mfma_f32_32x32x16_bf16(pa1, (bf16x8){fl1[0], fl1[1], fl1[2], fl1[3], fh1[0], fh1[1], fh1[2], fh1[3]}, o[3], 0, 0, 0); fl1 = AT2_TRR(vbo_ + 10240); fh1 = AT2_TRR(vbo_ + 14336); ps += p0[9]; ps += p0[10]; p0[11] = __builtin_amdgcn_exp2f(fmaf(p0[11], C2_, mnL_)); SBAR(); \
        o[3] = __builtin_amdgcn_mfma_f32_32x32x16_bf16(pa2, (bf16x8){fl2[0], fl2[1], fl2[2], fl2[3], fh2[0], fh2[1], fh2[2], fh2[3]}, o[3], 0, 0, 0); fl2 = AT2_TRR(vbo_ + 18432); fh2 = AT2_TRR(vbo_ + 22528); ps += p0[11]; p0[12] = __builtin_amdgcn_exp2f(fmaf(p0[12], C2_, mnL_)); p0[13] = __builtin_amdgcn_exp2f(fmaf(p0[13], C2_, mnL_)); SBAR(); \
        o[3] = __builtin_amdgcn_mfma_f32_32x32x16_bf16(pa3, (bf16x8){fl3[0], fl3[1], fl3[2], fl3[3], fh3[0], fh3[1], fh3[2], fh3[3]}, o[3], 0, 0, 0); fl3 = AT2_TRR(vbo_ + 26624); fh3 = AT2_TRR(vbo_ + 30720); ps += p0[12]; ps += p0[13]; p0[14] = __builtin_amdgcn_exp2f(fmaf(p0[14], C2_, mnL_)); SBAR(); \
        o[4] = __builtin_amdgcn_mfma_f32_32x32x16_bf16(pa0, (bf16x8){fl0[0], fl0[1], fl0[2], fl0[3], fh0[0], fh0[1], fh0[2], fh0[3]}, o[4], 0, 0, 0); fl0 = AT2_TRR(vbo_ + 2560); fh0 = AT2_TRR(vbo_ + 6656); ps += p0[14]; p0[15] = __builtin_amdgcn_exp2f(fmaf(p0[15], C2_, mnL_)); p1[0] = __builtin_amdgcn_exp2f(fmaf(p1[0], C2_, mnL_)); SBAR(); \
        o[4] = __builtin_amdgcn_mfma_f32_32x32x16_bf16(pa1, (bf16x8){fl1[0], fl1[1], fl1[2], fl1[3], fh1[0], fh1[1], fh1[2], fh1[3]}, o[4], 0, 0, 0); fl1 = AT2_TRR(vbo_ + 10752); fh1 = AT2_TRR(vbo_ + 14848); ps += p0[15]; ps += p1[0]; p1[1] = __builtin_amdgcn_exp2f(fmaf(p1[1], C2_, mnL_)); SBAR(); \
        o[4] = __builtin_amdgcn_mfma_f32_32x32x16_bf16(pa2, (bf16x8){fl2[0], fl2[1], fl2[2], fl2[3], fh2[0], fh2[1], fh2[2], fh2[3]}, o[4], 0, 0, 0); fl2 = AT2_TRR(vbo_ + 18944); fh2 = AT2_TRR(vbo_ + 23040); ps += p1[1]; p1[2] = __builtin_amdgcn_exp2f(fmaf(p1[2], C2_, mnL_)); p1[3] = __builtin_amdgcn_exp2f(fmaf(p1[3], C2_, mnL_)); SBAR(); \
        o[4] = __builtin_amdgcn_mfma_f32_32x32x16_bf16(pa3, (bf16x8){fl3[0], fl3[1], fl3[2], fl3[3], fh3[0], fh3[1], fh3[2], fh3[3]}, o[4], 0, 0, 0); fl3 = AT2_TRR(vbo_ + 27136); fh3 = AT2_TRR(vbo_ + 31232); ps += p1[2]; ps += p1[3]; p1[4] = __builtin_amdgcn_exp2f(fmaf(p1[4], C2_, mnL_)); SBAR(); \
        o[5] = __builtin_amdgcn_mfma_f32_32x32x16_bf16(pa0, (bf16x8){fl0[0], fl0[1], fl0[2], fl0[3], fh0[0], fh0[1], fh0[2], fh0[3]}, o[5], 0, 0, 0); fl0 = AT2_TRR(vbo_ + 3072); fh0 = AT2_TRR(vbo_ + 7168); ps += p1[4]; p1[5] = __builtin_amdgcn_exp2f(fmaf(p1[5], C2_, mnL_)); p1[6] = __builtin_amdgcn_exp2f(fmaf(p1[6], C2_, mnL_)); SBAR(); \
        o[5] = __builtin_amdgcn_mfma_f32_32x32x16_bf16(pa1, (bf16x8){fl1[0], fl1[1], fl1[2], fl1[3], fh1[0], fh1[1], fh1[2], fh1[3]}, o[5], 0, 0, 0); fl1 = AT2_TRR(vbo_ + 11264); fh1 = AT2_TRR(vbo_ + 15360); ps += p1[5]; ps += p1[6]; p1[7] = __builtin_amdgcn_exp2f(fmaf(p1[7], C2_, mnL_)); SBAR(); \
        o[5] = __builtin_amdgcn_mfma_f32_32x32x16_bf16(pa2, (bf16x8){fl2[0], fl2[1], fl2[2], fl2[3], fh2[0], fh2[1], fh2[2], fh2[3]}, o[5], 0, 0, 0); fl2 = AT2_TRR(vbo_ + 19456); fh2 = AT2_TRR(vbo_ + 23552); ps += p1[7]; p1[8] = __builtin_amdgcn_exp2f(fmaf(p1[8], C2_, mnL_)); p1[9] = __builtin_amdgcn_exp2f(fmaf(p1[9], C2_, mnL_)); SBAR(); \
        o[5] = __builtin_amdgcn_mfma_f32_32x32x16_bf16(pa3, (bf16x8){fl3[0], fl3[1], fl3[2], fl3[3], fh3[0], fh3[1], fh3[2], fh3[3]}, o[5], 0, 0, 0); fl3 = AT2_TRR(vbo_ + 27648); fh3 = AT2_TRR(vbo_ + 31744); ps += p1[8]; ps += p1[9]; p1[10] = __builtin_amdgcn_exp2f(fmaf(p1[10], C2_, mnL_)); SBAR(); \
        o[6] = __builtin_amdgcn_mfma_f32_32x32x16_bf16(pa0, (bf16x8){fl0[0], fl0[1], fl0[2], fl0[3], fh0[0], fh0[1], fh0[2], fh0[3]}, o[6], 0, 0, 0); fl0 = AT2_TRR(vbo_ + 3584); fh0 = AT2_TRR(vbo_ + 7680); ps += p1[10]; p1[11] = __builtin_amdgcn_exp2f(fmaf(p1[11], C2_, mnL_)); p1[12] = __builtin_amdgcn_exp2f(fmaf(p1[12], C2_, mnL_)); SBAR(); \
        o[6] = __builtin_amdgcn_mfma_f32_32x32x16_bf16(pa1, (bf16x8){fl1[0], fl1[1], fl1[2], fl1[3], fh1[0], fh1[1], fh1[2], fh1[3]}, o[6], 0, 0, 0); fl1 = AT2_TRR(vbo_ + 11776); fh1 = AT2_TRR(vbo_ + 15872); ps += p1[11]; ps += p1[12]; p1[13] = __builtin_amdgcn_exp2f(fmaf(p1[13], C2_, mnL_)); SBAR(); \
        o[6] = __builtin_amdgcn_mfma_f32_32x32x16_bf16(pa2, (bf16x8){fl2[0], fl2[1], fl2[2], fl2[3], fh2[0], fh2[1], fh2[2], fh2[3]}, o[6], 0, 0, 0); fl2 = AT2_TRR(vbo_ + 19968); fh2 = AT2_TRR(vbo_ + 24064); ps += p1[13]; p1[14] = __builtin_amdgcn_exp2f(fmaf(p1[14], C2_, mnL_)); p1[15] = __builtin_amdgcn_exp2f(fmaf(p1[15], C2_, mnL_)); SBAR(); \
        o[6] = __builtin_amdgcn_mfma_f32_32x32x16_bf16(pa3, (bf16x8){fl3[0], fl3[1], fl3[2], fl3[3], fh3[0], fh3[1], fh3[2], fh3[3]}, o[6], 0, 0, 0); fl3 = AT2_TRR(vbo_ + 28160); fh3 = AT2_TRR(vbo_ + 32256); ps += p1[14]; ps += p1[15]; { auto rr_ = __builtin_amdgcn_permlane32_swap(__float_as_uint(ps), __float_as_uint(ps), false, false); ps = __uint_as_float(rr_[0]) + __uint_as_float(rr_[1]); } SBAR(); \
        o[7] = __builtin_amdgcn_mfma_f32_32x32x16_bf16(pa0, (bf16x8){fl0[0], fl0[1], fl0[2], fl0[3], fh0[0], fh0[1], fh0[2], fh0[3]}, o[7], 0, 0, 0); AT2_PK4(p0, 0, pa0); SBAR(); \
        o[7] = __builtin_amdgcn_mfma_f32_32x32x16_bf16(pa1, (bf16x8){fl1[0], fl1[1], fl1[2], fl1[3], fh1[0], fh1[1], fh1[2], fh1[3]}, o[7], 0, 0, 0); AT2_PK4(p0, 8, pa1); SBAR(); \
        o[7] = __builtin_amdgcn_mfma_f32_32x32x16_bf16(pa2, (bf16x8){fl2[0], fl2[1], fl2[2], fl2[3], fh2[0], fh2[1], fh2[2], fh2[3]}, o[7], 0, 0, 0); AT2_PK4(p1, 0, pa2); SBAR(); \
        o[7] = __builtin_amdgcn_mfma_f32_32x32x16_bf16(pa3, (bf16x8){fl3[0], fl3[1], fl3[2], fl3[3], fh3[0], fh3[1], fh3[2], fh3[3]}, o[7], 0, 0, 0); AT2_PK4(p1, 8, pa3); SBAR(); \
        } while (0)
#define AT2_LDK(p_) (*reinterpret_cast<const bf16x8*>(p_))
#define AT2_QKT_DMA(t, b) do { \
        const unsigned lq_ = (unsigned)fresh_lane(); const int r32_ = (int)(lq_ & 31u), hi_ = (int)(lq_ >> 5); \
        const char* vg_ = (const char*)cur.V + (size_t)(t) * (KVBLK * DV * 2); \
        const unsigned kkv_ = 8u * wid + ((lq_ & 31u) >> 2), keyv_ = (kkv_ & ~0xCu) | ((kkv_ & 4u) << 1) | ((kkv_ & 8u) >> 1), voff_ = keyv_ * 512u + (lq_ >> 5) * 64u + (lq_ & 3u) * 16u; \
        const bool hk_ = (t) + 1 < NT; const char* kg_ = (const char*)cur.K + (size_t)((t) + 1) * (KVBLK * D * 2); \
        const unsigned kr0_ = 8u * wid + (lq_ >> 4), koff0_ = kr0_ * 256u + (((lq_ & 15u) ^ (kr0_ & 7u)) << 4), koff1_ = (koff0_ + 1024u) ^ 64u; \
        const char* kq0_ = K_lds + (b) * SHM_K + KSWZ(r32_, (0 * 16 + hi_ * 8) * 2); const char* kq1_ = K_lds + (b) * SHM_K + KSWZ(r32_, (1 * 16 + hi_ * 8) * 2); \
        const char* kq2_ = K_lds + (b) * SHM_K + KSWZ(r32_, (2 * 16 + hi_ * 8) * 2); const char* kq3_ = K_lds + (b) * SHM_K + KSWZ(r32_, (3 * 16 + hi_ * 8) * 2); \
        p0 = f32x16{}; p1 = f32x16{}; bf16x8 ka0_, ka1_, kc0_, kc1_; \
        ka0_ = AT2_LDK(kq0_); ka1_ = AT2_LDK(kq0_ + 8192); \
        kc0_ = AT2_LDK(kq1_); kc1_ = AT2_LDK(kq1_ + 8192); p0 = __builtin_amdgcn_mfma_f32_32x32x16_bf16(ka0_, qr[0], p0, 0, 0, 0); p1 = __builtin_amdgcn_mfma_f32_32x32x16_bf16(ka1_, qr[0], p1, 0, 0, 0); SBAR(); AT2_GLDS(vg_ + 0 * 128 + voff_, L + (b) * SHM_V + (4 * wid + 0) * 1024); SBAR(); \
        ka0_ = AT2_LDK(kq2_); ka1_ = AT2_LDK(kq2_ + 8192); p0 = __builtin_amdgcn_mfma_f32_32x32x16_bf16(kc0_, qr[1], p0, 0, 0, 0); p1 = __builtin_amdgcn_mfma_f32_32x32x16_bf16(kc1_, qr[1], p1, 0, 0, 0); SBAR(); AT2_GLDS(vg_ + 1 * 128 + voff_, L + (b) * SHM_V + (4 * wid + 1) * 1024); SBAR(); \
        kc0_ = AT2_LDK(kq3_); kc1_ = AT2_LDK(kq3_ + 8192); p0 = __builtin_amdgcn_mfma_f32_32x32x16_bf16(ka0_, qr[2], p0, 0, 0, 0); p1 = __builtin_amdgcn_mfma_f32_32x32x16_bf16(ka1_, qr[2], p1, 0, 0, 0); SBAR(); AT2_GLDS(vg_ + 2 * 128 + voff_, L + (b) * SHM_V + (4 * wid + 2) * 1024); SBAR(); \
        ka0_ = AT2_LDK(kq0_ + 128); ka1_ = AT2_LDK(kq0_ + 128 + 8192); p0 = __builtin_amdgcn_mfma_f32_32x32x16_bf16(kc0_, qr[3], p0, 0, 0, 0); p1 = __builtin_amdgcn_mfma_f32_32x32x16_bf16(kc1_, qr[3], p1, 0, 0, 0); SBAR(); AT2_GLDS(vg_ + 3 * 128 + voff_, L + (b) * SHM_V + (4 * wid + 3) * 1024); SBAR(); \
        kc0_ = AT2_LDK(kq1_ + 128); kc1_ = AT2_LDK(kq1_ + 128 + 8192); p0 = __builtin_amdgcn_mfma_f32_32x32x16_bf16(ka0_, qr[4], p0, 0, 0, 0); p1 = __builtin_amdgcn_mfma_f32_32x32x16_bf16(ka1_, qr[4], p1, 0, 0, 0); SBAR(); if (hk_) AT2_GLDS(kg_ + koff0_, L + 2 * SHM_V + (1 - (b)) * SHM_K + (2 * wid) * 1024); SBAR(); \
        ka0_ = AT2_LDK(kq2_ + 128); ka1_ = AT2_LDK(kq2_ + 128 + 8192); p0 = __builtin_amdgcn_mfma_f32_32x32x16_bf16(kc0_, qr[5], p0, 0, 0, 0); p1 = __builtin_amdgcn_mfma_f32_32x32x16_bf16(kc1_, qr[5], p1, 0, 0, 0); SBAR(); if (hk_) AT2_GLDS(kg_ + koff1_, L + 2 * SHM_V + (1 - (b)) * SHM_K + (2 * wid + 1) * 1024); SBAR(); \
        kc0_ = AT2_LDK(kq3_ + 128); kc1_ = AT2_LDK(kq3_ + 128 + 8192); p0 = __builtin_amdgcn_mfma_f32_32x32x16_bf16(ka0_, qr[6], p0, 0, 0, 0); p1 = __builtin_amdgcn_mfma_f32_32x32x16_bf16(ka1_, qr[6], p1, 0, 0, 0); SBAR(); \
        p0 = __builtin_amdgcn_mfma_f32_32x32x16_bf16(kc0_, qr[7], p0, 0, 0, 0); p1 = __builtin_amdgcn_mfma_f32_32x32x16_bf16(kc1_, qr[7], p1, 0, 0, 0); SBAR(); \
        } while (0)
#define AT2_STEP(t, b, HASPV) do { \
        asm volatile("s_waitcnt vmcnt(0)" ::: "memory"); __builtin_amdgcn_s_barrier(); asm volatile("" ::: "memory");     \
        SBAR(); AT2_QKT_DMA((t), (b)); \
        { const int kb_ = (t) * KVBLK; if (kb_ + KVBLK - 1 > qlo) { const int lm_ = fresh_lane(); mask_tile(p0, p1, qlo + (lm_ & 31) - 4 * (lm_ >> 5) - kb_, 0x7fffffffu); } } \
        SBAR(); \
        if (HASPV) { AT2_PV_SM(1 - (b)); } else { softmax_main(p0, p1, m_reg, al, ps); } \
        SBAR(); \
        RESC(al); l_reg = l_reg * al + ps; if (!(HASPV)) pack_p(p0, p1, pa0, pa1, pa2, pa3); } while (0)
    AT2_STEP(0, 0, false);
    for (int t = 1; t + 1 < NT; t += 2) { AT2_STEP(t, 1, true); AT2_STEP(t + 1, 0, true); }
    AT2_STEP(NT - 1, 1, true);
    asm volatile("s_waitcnt vmcnt(0)" ::: "memory"); __builtin_amdgcn_s_barrier(); asm volatile("" ::: "memory");
    pv_tile8<1>(o, (const AT2_LAS char*)L + v_rd_base(fresh_lane()), pa0, pa1, pa2, pa3);
    const int l2_ = fresh_lane(), he_ = l2_ >> 5;
    if (he_ == 0) li_l[l2_ & 31] = l_reg; asm volatile("s_waitcnt lgkmcnt(0)" ::: "memory");
    float rli[16];
#pragma unroll
    for (int r = 0; r < 16; ++r) rli[r] = __builtin_amdgcn_rcpf(li_l[crow(r, he_)]);
    const int loff = 4 * (l2_ >> 5) * DV + (l2_ & 31);
    unsigned short* Ow = cur.O + (size_t)(wid * QBLK) * DV + loff;
    const bool even_ = (l2_ & 1) == 0;
#pragma unroll
    for (int r = 0; r < 16; ++r) { const int orow = (r & 3) + 8 * (r >> 2);
#pragma unroll
        for (int d0 = 0; d0 < 8; ++d0) { const float v = o[d0][r] * rli[r]; const float vn = __shfl_xor(v, 1);
            if (even_) *(unsigned*)(Ow + orow * DV + d0 * 32) = cvtpk(v, vn); } }
    __syncthreads();
#undef RESC
#undef AT2_PV_SM
#undef AT2_PK4
#undef MX3
#undef AT2_TRR
#undef AT2_STEP
#undef AT2_QKT_DMA
#undef AT2_LDK
#undef AT2_DMA_K
#undef AT2_DMA_V
#undef AT2_GLDS
}
}

#ifndef MK_N_LAUNCHES
#define MK_N_LAUNCHES 1
#endif
constexpr int N_LAUNCHES = MK_N_LAUNCHES, N_PHASES = 16;
constexpr int NWAVES = 8;

constexpr int S_ = 16384, DM = 2048, FF = 5632, DE = 7168, NE = 8, NHEAD = 8;
constexpr float NORM_EPS = 1e-6f, SUBLN_EPS = 1e-5f;
constexpr float LAMBDA_INIT = 0.35550906759096934f;
constexpr float SA_X = 16.f, SW_GU = 1024.f, SA_H = 16.f, SW_D = 2048.f, SA_HD = 16.f, SW_DD = 2048.f, SA_XD = 16.f, SW_GUD = 1024.f;
constexpr int XP = 2304;
constexpr int CAP_ROWS = 2 * S_ + NE * 256;

constexpr size_t MiB = 1u << 20;
constexpr size_t WS_CTL = 0, CTL_ZERO_BYTES = 1 * MiB;
constexpr size_t WS_SS1 = 1 * MiB, WS_SS2 = WS_SS1 + 524288;
constexpr size_t WS_RS0 = 1 * MiB;
constexpr size_t WS_RS1 = 2 * MiB;
constexpr size_t WS_TOKI = WS_RS1 + 65536;
constexpr size_t WS_TOKG = WS_TOKI + 262144;
constexpr size_t WS_ROPE = 3 * MiB;
constexpr size_t WS_WPOOL = 11 * MiB;
constexpr size_t WS_WKVQ = 13 * MiB;
constexpr size_t WS_WO = 37 * MiB;
constexpr size_t WS_WGU = 45 * MiB;
constexpr size_t WS_WD = 89 * MiB;
constexpr size_t WS_WEGU = 111 * MiB;
constexpr size_t WS_WED = 559 * MiB;
constexpr size_t WS_X1 = 783 * MiB;
constexpr size_t WS_H = 911 * MiB;
constexpr size_t WS_SCR = 975 * MiB;
constexpr size_t WS_HID = WS_SCR, WS_MG = WS_SCR + 176 * MiB;
constexpr size_t WS_H2 = WS_SCR, WS_K16 = WS_SCR + 64 * MiB, WS_V16 = WS_SCR + 128 * MiB, WS_Q16 = WS_SCR + 192 * MiB, WS_O32 = WS_SCR + 256 * MiB, WS_ON = WS_SCR + 512 * MiB;
constexpr size_t WS_HIDE = WS_SCR, WS_XG = WS_SCR + 440 * MiB, WS_Y = WS_SCR + 440 * MiB;
constexpr size_t WS_YPART = WS_SCR + 300 * MiB;
constexpr size_t WS_END = WS_SCR + 748 * MiB;
static_assert((size_t)CAP_ROWS * DE * 2 == 476 * MiB && (size_t)CAP_ROWS * DM * 4 == 272 * MiB, "expert buffers");
constexpr int CW_TMO = 0, CW_BAR = 4096, CW_CNT = 8192, CW_AQ = 9216, CW_KS = 12288, CW_BC = 16384;

constexpr int RING_BYTES = 131072, LDSCTL_OFF = 151552, MISC_OFF = LDSCTL_OFF + 320, LDS_BYTES = 155648;


#define GAS __attribute__((address_space(1)))
#define LAS __attribute__((address_space(3)))
typedef unsigned short bf16;
typedef unsigned v4u __attribute__((ext_vector_type(4)));
typedef unsigned v2u __attribute__((ext_vector_type(2)));
typedef float f32x4 __attribute__((ext_vector_type(4)));
typedef float f32x2 __attribute__((ext_vector_type(2)));
typedef int i32x4 __attribute__((ext_vector_type(4)));
typedef GAS unsigned gu32;
#define RLX_AGENT __ATOMIC_RELAXED, __HIP_MEMORY_SCOPE_AGENT
#define LDS_WAIT() asm volatile("s_waitcnt lgkmcnt(0)" ::: "memory")
#define VM_WAIT() asm volatile("s_waitcnt vmcnt(0)" ::: "memory")
__device__ __forceinline__ unsigned pk2(float lo, float hi) { return pg8::cvt_pk_bf16(lo, hi); }

#define XB_TMO      128
#define XB_XCNT(j)  (256  + 64 * (j))
#define XB_XSUB(j)  (1280 + 64 * (j))
#define XB_XGEN(j)  (2304 + 64 * (j))
#define XB_TOP      3328
#define XB_TOPGEN   3392
#define XCD_BAR_WORDS 3456
#define XB_SPIN_CAP (1u << 18)

__device__ __forceinline__ unsigned xb_ld(unsigned* p)              { return __hip_atomic_load(p, __ATOMIC_RELAXED, __HIP_MEMORY_SCOPE_AGENT); }
__device__ __forceinline__ unsigned xb_add(unsigned* p, unsigned v) { return __hip_atomic_fetch_add(p, v, __ATOMIC_RELAXED, __HIP_MEMORY_SCOPE_AGENT); }
__device__ __forceinline__ unsigned xb_xcc_id() { return (unsigned)__builtin_amdgcn_s_getreg((3 << 11) | 20) & 0xFu; }
#define XB_SPIN(cond, bar) do { unsigned _sp = 0; while (cond) { __builtin_amdgcn_s_sleep(1); \
    if ((++_sp & 255u) == 0u) { if (xb_ld(&(bar)[XB_TMO])) break; if (_sp > XB_SPIN_CAP) { atomicAdd(&(bar)[XB_TMO], 1u); break; } } } } while (0)

struct XcdBarrier {
    unsigned* bar; unsigned x; int w;
    volatile LAS unsigned* st;
};

__device__ __forceinline__ XcdBarrier xcd_barrier_post(unsigned* bar, volatile LAS unsigned* st, int wave_id) {
    XcdBarrier b; b.bar = bar; b.x = xb_xcc_id(); b.st = st; b.w = wave_id;
    if (threadIdx.x == 0) (void)xb_add(&bar[XB_XCNT(b.x)], 1u);
    return b;
}
__device__ __forceinline__ void xcd_barrier_complete(unsigned* bar, unsigned x, unsigned& nloc, unsigned& nx) {
    const unsigned G = gridDim.x * gridDim.y * gridDim.z;
    unsigned sum, cnt, mine, sp = 0u;
    for (;;) {
        sum = 0u; cnt = 0u; mine = 0u;
#pragma unroll
        for (unsigned j = 0; j < 16; ++j) { const unsigned c = xb_ld(&bar[XB_XCNT(j)]); sum += c; cnt += (c > 0u) ? 1u : 0u; mine = (j == x) ? c : mine; }
        if (sum == G) break;
        __builtin_amdgcn_s_sleep(1);
        if ((++sp & 255u) == 0u) { if (xb_ld(&bar[XB_TMO])) break; if (sp > XB_SPIN_CAP) { atomicAdd(&bar[XB_TMO], 1u); break; } }
    }
    nloc = mine > 0u ? mine : 1u; nx = cnt > 0u ? cnt : 1u;
}

__device__ __forceinline__ void xcd_barrier(const XcdBarrier& b) {
    asm volatile("s_waitcnt vmcnt(0)" ::: "memory");
    __syncthreads();
    if (b.w == 0 && fresh_lane() == 0) {
        unsigned* bar = b.bar;
        __builtin_amdgcn_s_waitcnt(0);
        unsigned nloc = b.st[0], nx = b.st[1];
        if (nloc == 0u) { xcd_barrier_complete(bar, b.x, nloc, nx); b.st[0] = nloc; b.st[1] = nx; }
        const unsigned old = xb_add(&bar[XB_XSUB(b.x)], 1u);
        const unsigned gen = old / nloc;
        if (old + 1u == (gen + 1u) * nloc) {
            __builtin_amdgcn_fence(__ATOMIC_RELEASE, "agent");
            asm volatile("s_waitcnt vmcnt(0)" ::: "memory");
            const unsigned og = xb_add(&bar[XB_TOP], 1u);
            const unsigned tg = og / nx;
            if (og + 1u == (tg + 1u) * nx) xb_add(&bar[XB_TOPGEN], 1u);
            else XB_SPIN(xb_ld(&bar[XB_TOPGEN]) == tg, bar);
            __builtin_amdgcn_fence(__ATOMIC_ACQUIRE, "agent");
            xb_add(&bar[XB_XGEN(b.x)], 1u);
            asm volatile("s_waitcnt vmcnt(0)" ::: "memory");
        } else {
            XB_SPIN(xb_ld(&bar[XB_XGEN(b.x)]) == gen, bar);
            __builtin_amdgcn_fence(__ATOMIC_ACQUIRE, "agent");
            asm volatile("s_waitcnt vmcnt(0)" ::: "memory");
        }
    }
    __syncthreads();
}

__device__ __forceinline__ float wave_sum(float v) {
#pragma unroll
    for (int o = 1; o < 64; o <<= 1) v += __shfl_xor(v, o);
    return v;
}
__device__ __forceinline__ float dot4(f32x4 a, f32x4 b) { return (a.x * b.x + a.y * b.y) + (a.z * b.z + a.w * b.w); }

__device__ __forceinline__ void tr_item(const float* W, int N, int k0, int n0, bf16* dst, int ldd, LAS float* scr, int lane) {
    const float* src = W + (size_t)(k0 + (lane >> 4)) * N + n0 + 4 * (lane & 15);
    f32x4 v[16];
#pragma unroll
    for (int i = 0; i < 16; ++i) v[i] = *(const f32x4*)(src + (size_t)(4 * i) * N);
#pragma unroll
    for (int i = 0; i < 16; ++i) { LAS float* p = scr + (4 * i + (lane >> 4)) * 65 + 4 * (lane & 15); p[0] = v[i].x; p[1] = v[i].y; p[2] = v[i].z; p[3] = v[i].w; }
    LDS_WAIT(); asm volatile("" ::: "memory");
    const int c = lane & 7;
#pragma unroll
    for (int q = 0; q < 8; ++q) { const int n = (lane >> 3) + 8 * q; const LAS float* s = scr + (8 * c) * 65 + n;
        v4u o; o.x = pk2(s[0 * 65], s[1 * 65]); o.y = pk2(s[2 * 65], s[3 * 65]); o.z = pk2(s[4 * 65], s[5 * 65]); o.w = pk2(s[6 * 65], s[7 * 65]);
        *(v4u*)(dst + (size_t)n * ldd + 8 * c) = o; }
    LDS_WAIT(); asm volatile("" ::: "memory");
}
__device__ __forceinline__ void tr_item8(const float* W, int N, int k0, int n0, unsigned char* dst, int ldd, float scale, LAS float* scr, int lane) {
    const float* src = W + (size_t)(k0 + (lane >> 4)) * N + n0 + 4 * (lane & 15);
    f32x4 v[16];
#pragma unroll
    for (int i = 0; i < 16; ++i) v[i] = *(const f32x4*)(src + (size_t)(4 * i) * N);
#pragma unroll
    for (int i = 0; i < 16; ++i) { LAS float* p = scr + (4 * i + (lane >> 4)) * 65 + 4 * (lane & 15); p[0] = v[i].x * scale; p[1] = v[i].y * scale; p[2] = v[i].z * scale; p[3] = v[i].w * scale; }
    LDS_WAIT(); asm volatile("" ::: "memory");
    const int c = lane & 3;
#pragma unroll
    for (int q = 0; q < 4; ++q) { const int n = (lane >> 2) + 16 * q; const LAS float* s = scr + (16 * c) * 65 + n;
        v4u o; o.x = pg8::pk4_fp8(s[0 * 65], s[1 * 65], s[2 * 65], s[3 * 65]); o.y = pg8::pk4_fp8(s[4 * 65], s[5 * 65], s[6 * 65], s[7 * 65]);
        o.z = pg8::pk4_fp8(s[8 * 65], s[9 * 65], s[10 * 65], s[11 * 65]); o.w = pg8::pk4_fp8(s[12 * 65], s[13 * 65], s[14 * 65], s[15 * 65]);
        *(v4u*)(dst + (size_t)n * ldd + 16 * c) = o; }
    LDS_WAIT(); asm volatile("" ::: "memory");
}
template <int MODE> __device__ __forceinline__ void tr_matrix_item8(const float* W, int K, int N, unsigned char* dstbase, float scale, int r, LAS float* scr, int lane) {
    const int nblk = N / 64, kb = r / nblk, nb = r % nblk, k0 = 64 * kb, n0 = 64 * nb;
    int row;
    if (MODE == 0) row = n0;
    else if (MODE == 1) row = 256 * (n0 >> 7) + (n0 & 127);
    else row = 256 * (n0 >> 7) + 128 + (n0 & 127);
    tr_item8(W, N, k0, n0, dstbase + (size_t)row * K + k0, K, scale, scr, lane);
}
template <int MODE> __device__ __forceinline__ void tr_matrix_item(const float* W, int K, int N, bf16* dstbase, int r, LAS float* scr, int lane) {
    const int nblk = N / 64, kb = r / nblk, nb = r % nblk, k0 = 64 * kb, n0 = 64 * nb;
    int row;
    if (MODE == 0) row = n0;
    else if (MODE == 1) row = 256 * (n0 >> 7) + (n0 & 127);
    else if (MODE == 2) row = 256 * (n0 >> 7) + 128 + (n0 & 127);
    else { const int h = n0 >> 8, rr = n0 & 255, map = rr >> 7, d = rr & 127; row = 256 * h + (d < 64 ? map * 64 : 128 + map * 64); }
    tr_item(W, N, k0, n0, dstbase + (size_t)row * K + k0, K, scr, lane);
}
struct TrDesc { const float* src; unsigned char* dst; const float* gain; int N, pitch, f8; float scale; };
__device__ __forceinline__ void tr_load(const TrDesc& d, f32x4 (&v)[16], int lane) {
    const float* s = d.src + (size_t)(lane >> 4) * d.N + 4 * (lane & 15);
#pragma unroll
    for (int i = 0; i < 16; ++i) v[i] = __builtin_nontemporal_load((const f32x4*)(s + (size_t)(4 * i) * d.N));
}
__device__ __forceinline__ void tr_store(const TrDesc& d, const f32x4 (&v)[16], LAS float* scr, int lane) {
    if (d.gain) {
#pragma unroll
        for (int i = 0; i < 16; ++i) { const float gk = d.gain[4 * i + (lane >> 4)] * d.scale; LAS float* p = scr + (4 * i + (lane >> 4)) * 65 + 4 * (lane & 15); p[0] = v[i].x * gk; p[1] = v[i].y * gk; p[2] = v[i].z * gk; p[3] = v[i].w * gk; }
    } else {
#pragma unroll
        for (int i = 0; i < 16; ++i) { LAS float* p = scr + (4 * i + (lane >> 4)) * 65 + 4 * (lane & 15); p[0] = v[i].x * d.scale; p[1] = v[i].y * d.scale; p[2] = v[i].z * d.scale; p[3] = v[i].w * d.scale; }
    }
    LDS_WAIT(); asm volatile("" ::: "memory");
    if (d.f8) {
        const int c = lane & 3;
#pragma unroll
        for (int q = 0; q < 4; ++q) { const int n = (lane >> 2) + 16 * q; const LAS float* s = scr + (16 * c) * 65 + n;
            v4u o; o.x = pg8::pk4_fp8(s[0 * 65], s[1 * 65], s[2 * 65], s[3 * 65]); o.y = pg8::pk4_fp8(s[4 * 65], s[5 * 65], s[6 * 65], s[7 * 65]);
            o.z = pg8::pk4_fp8(s[8 * 65], s[9 * 65], s[10 * 65], s[11 * 65]); o.w = pg8::pk4_fp8(s[12 * 65], s[13 * 65], s[14 * 65], s[15 * 65]);
            __builtin_nontemporal_store(o, (v4u*)(d.dst + (size_t)n * d.pitch + 16 * c)); }
    } else {
        const int c = lane & 7;
#pragma unroll
        for (int q = 0; q < 8; ++q) { const int n = (lane >> 3) + 8 * q; const LAS float* s = scr + (8 * c) * 65 + n;
            v4u o; o.x = pk2(s[0 * 65], s[1 * 65]); o.y = pk2(s[2 * 65], s[3 * 65]); o.z = pk2(s[4 * 65], s[5 * 65]); o.w = pk2(s[6 * 65], s[7 * 65]);
            __builtin_nontemporal_store(o, (v4u*)(d.dst + (size_t)n * d.pitch + 16 * c)); }
    }
    LDS_WAIT(); asm volatile("" ::: "memory");
}
__device__ __forceinline__ void tr_load_w(const TrDesc& d, f32x4 (&v)[16], int lane) {
    const float* s = d.src + (size_t)(lane >> 3) * d.N + 4 * (lane & 7);
#pragma unroll
    for (int i = 0; i < 16; ++i) v[i] = __builtin_nontemporal_load((const f32x4*)(s + (size_t)(8 * i) * d.N));
}
__device__ __forceinline__ void tr_store_w(const TrDesc& d, const f32x4 (&v)[16], LAS float* scr, int lane) {
#pragma unroll
    for (int i = 0; i < 16; ++i) { LAS float* p = scr + (8 * i + (lane >> 3)) * 33 + 4 * (lane & 7); p[0] = v[i].x * d.scale; p[1] = v[i].y * d.scale; p[2] = v[i].z * d.scale; p[3] = v[i].w * d.scale; }
    LDS_WAIT(); asm volatile("" ::: "memory");
    const int c = lane & 7;
#pragma unroll
    for (int q = 0; q < 4; ++q) { const int n = (lane >> 3) + 8 * q; const LAS float* s = scr + (16 * c) * 33 + n;
        v4u o; o.x = pg8::pk4_fp8(s[0 * 33], s[1 * 33], s[2 * 33], s[3 * 33]); o.y = pg8::pk4_fp8(s[4 * 33], s[5 * 33], s[6 * 33], s[7 * 33]);
        o.z = pg8::pk4_fp8(s[8 * 33], s[9 * 33], s[10 * 33], s[11 * 33]); o.w = pg8::pk4_fp8(s[12 * 33], s[13 * 33], s[14 * 33], s[15 * 33]);
        __builtin_nontemporal_store(o, (v4u*)(d.dst + (size_t)n * d.pitch + 16 * c)); }
    LDS_WAIT(); asm volatile("" ::: "memory");
}
__device__ __forceinline__ int tr_row(int mode, int n0) {
    if (mode == 0) return n0;
    if (mode == 1) return 256 * (n0 >> 7) + (n0 & 127);
    if (mode == 2) return 256 * (n0 >> 7) + 128 + (n0 & 127);
    const int h = n0 >> 8, rr = n0 & 255, map = rr >> 7, dd = rr & 127; return 256 * h + (dd < 64 ? map * 64 : 128 + map * 64);
}
__device__ __forceinline__ void sincos_pi(double r, double& s, double& c) {
    const double x2 = r * r;
    double ps = -1.0 / 25852016738884976640000.0;
    ps = ps * x2 + 1.0 / 51090942171709440000.0;  ps = ps * x2 - 1.0 / 121645100408832000.0; ps = ps * x2 + 1.0 / 355687428096000.0; ps = ps * x2 - 1.0 / 1307674368000.0;
    ps = ps * x2 + 1.0 / 6227020800.0; ps = ps * x2 - 1.0 / 39916800.0; ps = ps * x2 + 1.0 / 362880.0; ps = ps * x2 - 1.0 / 5040.0; ps = ps * x2 + 1.0 / 120.0; ps = ps * x2 - 1.0 / 6.0; ps = ps * x2 + 1.0;
    s = ps * r;
    double pc = 1.0 / 1124000727777607680000.0;
    pc = pc * x2 - 1.0 / 2432902008176640000.0; pc = pc * x2 + 1.0 / 6402373705728000.0; pc = pc * x2 - 1.0 / 20922789888000.0; pc = pc * x2 + 1.0 / 87178291200.0;
    pc = pc * x2 - 1.0 / 479001600.0; pc = pc * x2 + 1.0 / 3628800.0; pc = pc * x2 - 1.0 / 40320.0; pc = pc * x2 + 1.0 / 720.0; pc = pc * x2 - 1.0 / 24.0; pc = pc * x2 + 0.5; pc = pc * x2 - 1.0;
    c = -pc;
}
__device__ __forceinline__ void rms_row_bf16(const float* xrow, const float* ga, bf16* oa, const float* gb, bf16* ob, int lane) {
    const f32x4* xr = (const f32x4*)xrow + lane; f32x4 v[8]; float s = 0.f;
#pragma unroll
    for (int j = 0; j < 8; ++j) { v[j] = xr[64 * j]; s += dot4(v[j], v[j]); }
    const float rstd = 1.0f / sqrtf(wave_sum(s) * (1.0f / DM) + NORM_EPS);
#pragma unroll
    for (int j = 0; j < 8; ++j) { const f32x4 g = ((const f32x4*)ga)[lane + 64 * j]; const f32x4 y = v[j] * rstd * g; v2u o; o.x = pk2(y.x, y.y); o.y = pk2(y.z, y.w); ((v2u*)oa)[lane + 64 * j] = o; }
    if (ob) {
#pragma unroll
        for (int j = 0; j < 8; ++j) { const f32x4 g = ((const f32x4*)gb)[lane + 64 * j]; const f32x4 y = v[j] * rstd * g; v2u o; o.x = pk2(y.x, y.y); o.y = pk2(y.z, y.w); ((v2u*)ob)[lane + 64 * j] = o; }
    }
}

template <int W> __device__ __forceinline__ void pool_rows(const float* xc  , const LAS float* rs, const f32x4 gn, const int t0, bf16* mg) {
    f32x4 prev[16];
#pragma unroll
    for (int i = 0; i < 16; ++i) { const int tt = t0 - 16 + i; const bool need = i >= 16 - (W - 1);
        prev[i] = (need && tt >= 0) ? *(const f32x4*)(xc + (size_t)tt * DM) * rs[i - 1 < 0 ? 0 : i - 1] * gn : (f32x4){0.f, 0.f, 0.f, 0.f}; }
    f32x4 sum = {0.f, 0.f, 0.f, 0.f};
#pragma unroll
    for (int i = 16 - (W - 1); i < 16; ++i) sum += prev[i];
    for (int blk = 0; blk < 4; ++blk) {
        f32x4 cur[16];
#pragma unroll
        for (int i = 0; i < 16; ++i) cur[i] = *(const f32x4*)(xc + (size_t)(t0 + 16 * blk + i) * DM) * rs[15 + 16 * blk + i] * gn;
#pragma unroll
        for (int i = 0; i < 16; ++i) { const int t = t0 + 16 * blk + i; sum += cur[i];
            const float inv = 1.0f / (float)((t + 1 < W) ? t + 1 : W); const f32x4 m = sum * inv - cur[i];
            v2u o; o.x = pk2(m.x, m.y); o.y = pk2(m.z, m.w); *(v2u*)(mg + (size_t)(16 * blk + i) * 512) = o;
            sum -= (i - (W - 1) >= 0) ? cur[i - (W - 1) >= 0 ? i - (W - 1) : 0] : prev[(16 + i - (W - 1)) & 15]; }
#pragma unroll
        for (int i = 0; i < 16; ++i) prev[i] = cur[i];
    }
}

struct Args { const void* in[25]; float* out; unsigned char* ws; int ph_lo, ph_hi, li, pad; };
__global__ void __launch_bounds__(NWAVES * 64, 2) yoco_fwd(Args args) {
    extern __shared__ __attribute__((aligned(16))) unsigned char lds[];
    LAS unsigned char* const L = (LAS unsigned char*)lds;
    volatile LAS unsigned* const MISC = (volatile LAS unsigned*)(L + MISC_OFF);
    const int wave = __builtin_amdgcn_readfirstlane((int)threadIdx.x >> 6);
    const int G = gridDim.x, gw = blockIdx.x * NWAVES + wave, NGW = G * NWAVES;
    unsigned char* const ws = args.ws;
    gu32* const ctl = (gu32*)(ws + WS_CTL);
    const float* x = (const float*)args.in[0]; const int* positions = (const int*)args.in[1]; const float* norm_mix_a = (const float*)args.in[2]; const float* pool_w = (const float*)args.in[3];
    const float* pool_scale = (const float*)args.in[4]; const float* norm_kv = (const float*)args.in[5]; const float* w_k = (const float*)args.in[6]; const float* w_v = (const float*)args.in[7];
    const float* norm_mix_b = (const float*)args.in[8]; const float* w_q = (const float*)args.in[9]; const float* lq1 = (const float*)args.in[10]; const float* lk1 = (const float*)args.in[11];
    const float* lq2 = (const float*)args.in[12]; const float* lk2 = (const float*)args.in[13]; const float* subln_w = (const float*)args.in[14]; const float* w_o = (const float*)args.in[15];
    const float* norm_ffn = (const float*)args.in[16]; const float* d_gate = (const float*)args.in[17]; const float* d_up = (const float*)args.in[18]; const float* d_down = (const float*)args.in[19];
    const float* router_w = (const float*)args.in[20]; const float* m_gate = (const float*)args.in[21]; const float* m_up = (const float*)args.in[22]; const float* m_down = (const float*)args.in[23];
    const float* norm_final = (const float*)args.in[24];
    float* SS1 = (float*)(ws + WS_SS1); float* SS2 = (float*)(ws + WS_SS2); float* RS1 = (float*)(ws + WS_RS1); i32x4* TOKI = (i32x4*)(ws + WS_TOKI); f32x2* TOKG = (f32x2*)(ws + WS_TOKG); float* ROPE = (float*)(ws + WS_ROPE);
    bf16* WPOOL = (bf16*)(ws + WS_WPOOL); bf16* WKVQ = (bf16*)(ws + WS_WKVQ); bf16* WO = (bf16*)(ws + WS_WO); bf16* WGU = (bf16*)(ws + WS_WGU); bf16* WD = (bf16*)(ws + WS_WD);
    unsigned char* WEGU8 = ws + WS_WEGU; unsigned char* WED8 = ws + WS_WED; float* X1 = (float*)(ws + WS_X1); bf16* HB = (bf16*)(ws + WS_H);
    bf16* HID = (bf16*)(ws + WS_HID); bf16* MG = (bf16*)(ws + WS_MG); bf16* H2 = (bf16*)(ws + WS_H2); bf16* K16 = (bf16*)(ws + WS_K16); bf16* V16 = (bf16*)(ws + WS_V16); bf16* Q16 = (bf16*)(ws + WS_Q16);
    bf16* O16 = (bf16*)(ws + WS_O32); bf16* ON = (bf16*)(ws + WS_ON); unsigned char* HIDE8 = ws + WS_HIDE; unsigned char* XG8 = ws + WS_XG; bf16* YB = (bf16*)(ws + WS_Y); float* YPART = (float*)(ws + WS_YPART);

    for (int u = threadIdx.x; u < (LDS_BYTES - LDSCTL_OFF) / 4; u += NWAVES * 64) ((LAS unsigned*)(L + LDSCTL_OFF))[u] = 0u;
    __syncthreads();
    XcdBarrier bar; bar.bar = (unsigned*)(ctl + CW_BAR); bar.x = 0; bar.st = nullptr; bar.w = wave;
    if (N_LAUNCHES == 1) bar = xcd_barrier_post((unsigned*)(ctl + CW_BAR), MISC + 8, wave);
#define GRID_BAR(seam) do { if (N_LAUNCHES != 1) { if (wave == 0 && fresh_lane() == 0) __hip_atomic_store(ctl + CW_TMO, 0xBADBA0u | (unsigned)(seam), RLX_AGENT); } else { xcd_barrier(bar); } } while (0)
    const int lo = args.ph_lo, hi = args.ph_hi;
#define FRESH_TID() const int lane = fresh_lane(), tid = wave * 64 + lane; (void)tid; (void)lane
#define IN(k) (lo <= (k) && (k) < hi)
#define BOTH(k) (IN(k) && IN((k) + 1))
#ifndef PROBE_REP_PHASE
#define PROBE_REP_PHASE -1
#endif
#define REPN(k) ((k) == PROBE_REP_PHASE ? 2 : 1)
#define SMALLREP_N(id_) for (int rep_ = 0; rep_ < ((PROBE_REP_PHASE == 100 || PROBE_REP_PHASE == (id_)) ? 2 : 1); ++rep_)

    constexpr int I_POOL = 64, I_SQ = 32 * 32, I_DG = 32 * 88, I_DD = 88 * 32, I_EG = 32 * 112, I_ED = 112 * 32;
    constexpr int N_EARLY = 4 * I_POOL + 4 * I_SQ + 2 * I_DG + I_DD, N_MOE = 16 * I_EG + 8 * I_ED, NITEMS = N_EARLY + N_MOE;
#define TR_SET(W_, K_, N_, DST_, MODE_, F8_, SC_, GAIN_, R_) do { const int nblk_ = (N_) / 64, kb_ = (R_) / nblk_, nb_ = (R_) % nblk_, k0_ = 64 * kb_, n0_ = 64 * nb_; const int es_ = (F8_) ? 1 : 2; \
        d_.src = (W_) + (size_t)k0_ * (N_) + n0_; d_.N = (N_); d_.pitch = (K_) * es_; d_.f8 = (F8_); d_.scale = (SC_); d_.gain = (GAIN_) ? (const float*)(GAIN_) + k0_ : nullptr; d_.dst = (unsigned char*)(DST_) + ((size_t)tr_row(MODE_, n0_) * (K_) + k0_) * es_; } while (0)
#define TR_DECODE(it_) do { int r = (it_) % NITEMS; \
        if (r < 4 * I_POOL) { const int g = r / I_POOL; TR_SET(pool_w + (size_t)g * 512 * 512, 512, 512, WPOOL + (size_t)g * 512 * 512, 0, 0, 1.0f, (const float*)nullptr, r % I_POOL); break; } r -= 4 * I_POOL; \
        if (r < I_SQ) { TR_SET(w_k, DM, DM, WKVQ, 3, 0, 1.0f, norm_kv, r); break; } r -= I_SQ; \
        if (r < I_SQ) { TR_SET(w_v, DM, DM, WKVQ + (size_t)2048 * DM, 0, 0, 1.0f, norm_kv, r); break; } r -= I_SQ; \
        if (r < I_SQ) { TR_SET(w_q, DM, DM, WKVQ + (size_t)4096 * DM, 3, 0, 1.0f, norm_mix_b, r); break; } r -= I_SQ; \
        if (r < I_SQ) { TR_SET(w_o, DM, DM, WO, 0, 0, 1.0f, (const float*)nullptr, r); break; } r -= I_SQ; \
        if (r < I_DG) { TR_SET(d_gate, DM, FF, WGU, 1, 1, SW_GUD, norm_ffn, r); break; } r -= I_DG; \
        if (r < I_DG) { TR_SET(d_up, DM, FF, WGU, 2, 1, SW_GUD, norm_ffn, r); break; } r -= I_DG; \
        if (r < I_DD) { TR_SET(d_down, FF, DM, WD, 0, 0, 1.0f, (const float*)nullptr, r); break; } r -= I_DD; \
        if (r < 8 * I_EG) { const int e = r / I_EG; TR_SET(m_gate + (size_t)e * DM * DE, DM, DE, WEGU8 + (size_t)e * 2 * DE * DM, 1, 1, SW_GU, (const float*)nullptr, r % I_EG); break; } r -= 8 * I_EG; \
        if (r < 8 * I_EG) { const int e = r / I_EG; TR_SET(m_up + (size_t)e * DM * DE, DM, DE, WEGU8 + (size_t)e * 2 * DE * DM, 2, 1, SW_GU, (const float*)nullptr, r % I_EG); break; } r -= 8 * I_EG; \
        { const int e = r / I_ED; TR_SET(m_down + (size_t)e * DE * DM, DE, DM, WED8 + (size_t)e * DM * DE, 0, 1, SW_D, (const float*)nullptr, r % I_ED); } } while (0)
#define TR_RUN_XG(DEC_, LD_, ST_, SCRB_, first_, end_, stride_) do { const int ln_ = fresh_lane(); LAS float* scr = (LAS float*)(L + wave * (SCRB_)); const int NIT_ = (end_), st_ = (stride_); TrDesc dA, dB; f32x4 vA[16], vB[16]; int it = (first_); \
        if (it < NIT_) { { TrDesc& d_ = dA; DEC_(it); } LD_(dA, vA, ln_); \
            for (;;) { int nx = it + st_; bool has = nx < NIT_; \
                { TrDesc& d_ = dB; DEC_(has ? nx : it); } LD_(dB, vB, ln_); \
                ST_(dA, vA, scr, ln_); \
                if (!has) break; \
                it = nx; nx = it + st_; has = nx < NIT_; \
                { TrDesc& d_ = dA; DEC_(has ? nx : it); } LD_(dA, vA, ln_); \
                ST_(dB, vB, scr, ln_); \
                if (!has) break; \
                it = nx; } } } while (0)
#define TR_RUN_X(DEC_, first_, end_, stride_) TR_RUN_XG(DEC_, tr_load, tr_store, 16640, first_, end_, stride_)
#define TR_RUN(first_, end_, stride_) TR_RUN_X(TR_DECODE, first_, end_, stride_)
#define TR_SET_W(W_, K_, N_, DST_, MODE_, SC_, R_, PITCH_) do { const int nblk_ = (N_) / 32, kb_ = (R_) / nblk_, nb_ = (R_) % nblk_, k0_ = 128 * kb_, n0_ = 32 * nb_; \
        d_.src = (W_) + (size_t)k0_ * (N_) + n0_; d_.N = (N_); d_.pitch = (PITCH_); d_.f8 = 1; d_.scale = (SC_); d_.gain = nullptr; d_.dst = (unsigned char*)(DST_) + ((size_t)tr_row(MODE_, n0_) * (PITCH_) + k0_); } while (0)
#define TR_DECODE_MOE(it_) do { int r = ((it_) - N_EARLY) % N_MOE; \
        if (r < 8 * I_EG) { const int e = r / I_EG; TR_SET_W(m_gate + (size_t)e * DM * DE, DM, DE, WEGU8 + (size_t)e * 2 * DE * XP, 1, SW_GU, r % I_EG, XP); break; } r -= 8 * I_EG; \
        if (r < 8 * I_EG) { const int e = r / I_EG; TR_SET_W(m_up + (size_t)e * DM * DE, DM, DE, WEGU8 + (size_t)e * 2 * DE * XP, 2, SW_GU, r % I_EG, XP); break; } r -= 8 * I_EG; \
        { const int e = r / I_ED; TR_SET_W(m_down + (size_t)e * DE * DM, DE, DM, WED8 + (size_t)e * DM * DE, 0, SW_D, r % I_ED, DE); } } while (0)
    if (IN(1)) { FRESH_TID();
        SMALLREP_N(101) for (int rc = blockIdx.x; rc < S_ / 64; rc += G) {
            const int t0 = rc * 64;
            LAS float* rs = (LAS float*)(L + 135168);
            for (int jr = wave; jr < 79; jr += NWAVES) { const int tt = t0 - 15 + jr;
                if (tt >= 0) { const f32x4* xr = (const f32x4*)(x + (size_t)tt * DM) + lane; float s = 0.f;
#pragma unroll
                    for (int j = 0; j < 8; ++j) { const f32x4 v = xr[64 * j]; s += dot4(v, v); }
                    s = wave_sum(s); if (lane == 0) rs[jr] = 1.0f / sqrtf(s * (1.0f / DM) + NORM_EPS); } }
            __syncthreads();
            const int c = 4 * tid, g = c >> 9;
            const f32x4 gn = *(const f32x4*)(norm_mix_a + c);
            bf16* mg = MG + ((size_t)g * S_ + t0) * 512 + (c & 511);
            if (g == 0) pool_rows<2>(x + c, rs, gn, t0, mg); else if (g == 1) pool_rows<4>(x + c, rs, gn, t0, mg); else if (g == 2) pool_rows<8>(x + c, rs, gn, t0, mg); else pool_rows<16>(x + c, rs, gn, t0, mg);
            __syncthreads();
        }
        SMALLREP_N(102) for (int idx = blockIdx.x * 512 + tid; idx < S_ * 64; idx += G * 512) {
            const int t = idx >> 6, i = idx & 63;
            double f = 1.0; for (int k = 0; k < i; ++k) f *= 0.8659643233600653;
            const float ang = (float)positions[t] * (float)f;
            const double a = (double)ang, kk = __builtin_rint(a * 0.15915494309189535), r = __builtin_fma(-kk, 6.283185307179586, a);
            double sn, cs; sincos_pi(r, sn, cs);
            f32x2 o; o.x = (float)cs; o.y = (float)sn; ((f32x2*)ROPE)[idx] = o;
        }
        TR_RUN(gw, N_EARLY * REPN(1), NGW);
        if (BOTH(1)) GRID_BAR(1);
    }
    if (IN(2)) { FRESH_TID();
        pg8::GemmOrder S; S.init(S_ / 256, 8, G, (int)blockIdx.x, MG, WPOOL, 512, 1, (size_t)S_ * 512 * 2);
        pg8::EpiResF32N E{x, X1, DM, pool_scale, nullptr, SS1, (LAS float*)(L + RING_BYTES), 1.0f, (unsigned char*)HB, SA_XD};
        pg8::gemm_phase<pg8::EpiResF32N, pg8::GemmOrder, true, true>(L, 512 * 2, S, E, wave);
        if (BOTH(2)) GRID_BAR(2);
    }
    if (IN(4)) { FRESH_TID();
        pg8::GemmOrder S; S.init(S_ / 256, 2 * FF / 256, G, (int)blockIdx.x, HB, WGU, DM / 2, 30, 0); S.rep = REPN(4);
        pg8::EpiSwiGLU E{HID, FF, SS1, 1.0f / DM, NORM_EPS, 1.0f / (SA_XD * SW_GUD)};
        pg8::gemm_phase<pg8::EpiSwiGLU, pg8::GemmOrder, true, true, true>(L, DM, S, E, wave);
        if (BOTH(4)) GRID_BAR(4);
    }
    if (IN(5)) { FRESH_TID();
        pg8::GemmOrder S; S.init(S_ / 256, DM / 256, G, (int)blockIdx.x, HID, WD, FF, 30, 0);
        pg8::EpiResF32N E{X1, X1, DM, nullptr, HB, SS2, (LAS float*)(L + RING_BYTES), 1.0f, nullptr, 0.f};
        pg8::gemm_phase<pg8::EpiResF32N, pg8::GemmOrder, true, true>(L, FF * 2, S, E, wave);
        if (BOTH(5)) GRID_BAR(5);
    }
    if (IN(7)) { FRESH_TID();
        pg8::GemmOrder S; S.init(S_ / 256, 24, G, (int)blockIdx.x, HB, WKVQ, DM, 30, 0); S.rep = REPN(7);
        pg8::EpiKVQ E{K16, V16, Q16, ROPE, S_, SS2, 1.0f / DM, NORM_EPS};
        pg8::gemm_phase<pg8::EpiKVQ, pg8::GemmOrder, true, true>(L, DM * 2, S, E, wave);
#ifdef PAD_NOPS
        asm volatile(".rept " PAD_NOPS "\n\ts_nop 0\n\t.endr" ::: "memory");
#endif
        if (BOTH(7)) GRID_BAR(7);
    }
    if (IN(8)) { FRESH_TID();
        constexpr int NIT = 512 * REPN(8);
        int moe_chunk = 0;
        for (int Li = blockIdx.x; Li < NIT; Li += G) {
            const int vh = (Li & 7) + 8 * ((Li >> 8) & 1), xp = (Li >> 3) & 31;
            for (int pass = 0; pass < 2; ++pass) {
                const int qb = pass ? xp : 63 - xp;
                attn::Block2 cur;
                cur.Q = (const attn::bf16*)Q16 + ((size_t)vh * S_ + (size_t)qb * 256) * 128; cur.K = (const attn::bf16*)K16 + (size_t)vh * S_ * 128;
                cur.V = (const attn::bf16*)V16 + (size_t)(vh >> 1) * S_ * 256; cur.O = O16 + ((size_t)vh * S_ + (size_t)qb * 256) * 256; cur.P0 = qb * 256;
                attn::attn_block2(cur, (char*)lds, L, wave);
                if (pass == 0 && moe_chunk < 2) {
                    const int per_ = (N_MOE + NGW - 1) / NGW, half_ = (per_ + 1) / 2, end_ = N_EARLY + NGW * half_ * (moe_chunk + 1);
                    TR_RUN_XG(TR_DECODE_MOE, tr_load_w, tr_store_w, 17408, N_EARLY + gw + NGW * half_ * moe_chunk, end_ < NITEMS ? end_ : NITEMS, NGW);
                    ++moe_chunk; __syncthreads();
                }
            }
        }
        for (; moe_chunk < 2; ++moe_chunk) {
            const int per_ = (N_MOE + NGW - 1) / NGW, half_ = (per_ + 1) / 2, end_ = N_EARLY + NGW * half_ * (moe_chunk + 1);
            TR_RUN_XG(TR_DECODE_MOE, tr_load_w, tr_store_w, 17408, N_EARLY + gw + NGW * half_ * moe_chunk, end_ < NITEMS ? end_ : NITEMS, NGW); __syncthreads();
        }
        if (BOTH(8)) GRID_BAR(8);
    }
    if (IN(9)) { FRESH_TID();
        const float s1 = wave_sum(lq1[lane] * lk1[lane] + lq1[lane + 64] * lk1[lane + 64]), s2 = wave_sum(lq2[lane] * lk2[lane] + lq2[lane + 64] * lk2[lane + 64]);
        const float lam = expf(s1) - expf(s2) + LAMBDA_INIT;
        const f32x4 sw = *(const f32x4*)(subln_w + 4 * lane) * (1.0f - LAMBDA_INIT);
#define P9_LOAD(m_) do { _Pragma("unroll") for (int h = 0; h < NHEAD; ++h) { \
            u1[h] = __builtin_nontemporal_load((const v2u*)(O16 + ((size_t)(h * 2) * S_ + (m_)) * 256 + 4 * lane)); u2[h] = __builtin_nontemporal_load((const v2u*)(O16 + ((size_t)(h * 2 + 1) * S_ + (m_)) * 256 + 4 * lane)); } } while (0)
        SMALLREP_N(103) { v2u u1[NHEAD], u2[NHEAD];
            if (gw < S_) P9_LOAD(gw);
            for (int m = gw; m < S_; m += NGW) {
                f32x4 o[NHEAD]; float ss[NHEAD];
#pragma unroll
                for (int h = 0; h < NHEAD; ++h) {
                    const f32x4 o1 = {__uint_as_float(u1[h].x << 16), __uint_as_float(u1[h].x & 0xffff0000u), __uint_as_float(u1[h].y << 16), __uint_as_float(u1[h].y & 0xffff0000u)};
                    const f32x4 o2 = {__uint_as_float(u2[h].x << 16), __uint_as_float(u2[h].x & 0xffff0000u), __uint_as_float(u2[h].y << 16), __uint_as_float(u2[h].y & 0xffff0000u)};
                    o[h] = o1 - lam * o2; ss[h] = dot4(o[h], o[h]); }
                { const int mn = m + NGW; const int ml = mn < S_ ? mn : m; P9_LOAD(ml); }
#pragma unroll
                for (int off = 1; off < 64; off <<= 1) { float t[NHEAD];
#pragma unroll
                    for (int h = 0; h < NHEAD; ++h) t[h] = __shfl_xor(ss[h], off);
#pragma unroll
                    for (int h = 0; h < NHEAD; ++h) ss[h] += t[h]; }
#pragma unroll
                for (int h = 0; h < NHEAD; ++h) {
                    const float r = 1.0f / sqrtf(ss[h] * (1.0f / 256.0f) + SUBLN_EPS);
                    const f32x4 y = o[h] * r * sw; v2u w; w.x = pk2(y.x, y.y); w.y = pk2(y.z, y.w);
                    *(v2u*)(ON + (size_t)m * DM + h * 256 + 4 * lane) = w; }
            }
        }
#undef P9_LOAD
        if (BOTH(9)) GRID_BAR(9);
    }
    if (IN(10)) { FRESH_TID();
        pg8::GemmOrder S; S.init(S_ / 256, DM / 256, G, (int)blockIdx.x, ON, WO, DM, 30, 0);
        pg8::EpiResF32 E{X1, X1, DM, nullptr};
        pg8::gemm_phase<pg8::EpiResF32, pg8::GemmOrder, true, true>(L, DM * 2, S, E, wave);
        if (BOTH(10)) GRID_BAR(10);
    }
    if (IN(11)) { FRESH_TID();
        LAS float* rw = (LAS float*)L;
        LAS int* lcnt = (LAS int*)(L + 65536); LAS int* gbase = lcnt + 8; LAS int* rinfo = lcnt + 16;
        LAS float* rgate = (LAS float*)(L + 65536 + 64 + 1024);
        LAS float* rsd = rgate + 128;
        LAS int* part = (LAS int*)(L + 65536 + 4096);
        gu32* bcnt = ctl + CW_BC;
        for (int i = tid; i < DM * NE / 4; i += NWAVES * 64) ((LAS f32x4*)rw)[i] = ((const f32x4*)router_w)[i];
        __syncthreads();
        const float* gn = norm_ffn + DM;
        for (int rb = blockIdx.x; rb < S_ / 64; rb += G) {
            float xv[32];
            { const float* xr0 = X1 + (size_t)(rb * 64 + wave * 8) * DM + lane;
#pragma unroll
              for (int i = 0; i < 32; ++i) xv[i] = xr0[64 * i]; }
            for (int rr = 0; rr < 8; ++rr) {
                const int row = rb * 64 + wave * 8 + rr;
                float xn[32];
                { const float* xr1 = X1 + (size_t)(rr < 7 ? row + 1 : row) * DM + lane;
#pragma unroll
                  for (int i = 0; i < 32; ++i) xn[i] = xr1[64 * i]; }
                float red[9] = {0.f, 0.f, 0.f, 0.f, 0.f, 0.f, 0.f, 0.f, 0.f};
#pragma unroll
                for (int i = 0; i < 32; ++i) { red[8] += xv[i] * xv[i]; const float hv = xv[i] * gn[lane + 64 * i]; const LAS f32x4* wp = (const LAS f32x4*)(rw + (lane + 64 * i) * 8); const f32x4 w0 = wp[0], w1 = wp[1];
                    red[0] += hv * w0.x; red[1] += hv * w0.y; red[2] += hv * w0.z; red[3] += hv * w0.w; red[4] += hv * w1.x; red[5] += hv * w1.y; red[6] += hv * w1.z; red[7] += hv * w1.w; }
#pragma unroll
                for (int off = 1; off < 64; off <<= 1) { float t[9];
#pragma unroll
                    for (int e = 0; e < 9; ++e) t[e] = __shfl_xor(red[e], off);
#pragma unroll
                    for (int e = 0; e < 9; ++e) red[e] += t[e]; }
                const float rstd = 1.0f / sqrtf(red[8] * (1.0f / DM) + NORM_EPS);
                float lg[8];
#pragma unroll
                for (int e = 0; e < 8; ++e) lg[e] = red[e] * rstd;
#pragma unroll
                for (int i = 0; i < 32; ++i) xv[i] = xn[i];
                int e1 = 0; float l1 = lg[0];
#pragma unroll
                for (int e = 1; e < 8; ++e) if (lg[e] > l1) { l1 = lg[e]; e1 = e; }
                int e2 = -1; float l2 = -__builtin_inff();
#pragma unroll
                for (int e = 0; e < 8; ++e) if (e != e1 && lg[e] > l2) { l2 = lg[e]; e2 = e; }
                const float ex = expf(l2 - l1), g1 = 1.0f / (1.0f + ex), g2 = ex / (1.0f + ex);
                if (lane == 0) { const int q = wave * 8 + rr; rinfo[q * 4 + 0] = e1; rinfo[q * 4 + 2] = e2; rgate[q * 2] = g1; rgate[q * 2 + 1] = g2; rsd[q] = rstd; }
            }
            __syncthreads();
            if (tid < 8) { int c = 0; for (int q = 0; q < 64; ++q) c += (rinfo[q * 4] == tid ? 1 : 0) + (rinfo[q * 4 + 2] == tid ? 1 : 0); __hip_atomic_store(bcnt + rb * 8 + tid, (unsigned)c, RLX_AGENT); }
            if (tid < 64) { const int row = rb * 64 + tid; int r1 = 0, r2 = 0; const int e1 = rinfo[tid * 4], e2 = rinfo[tid * 4 + 2];
                for (int q = 0; q < tid; ++q) { const int a1 = rinfo[q * 4], a2 = rinfo[q * 4 + 2]; r1 += (a1 == e1 ? 1 : 0) + (a2 == e1 ? 1 : 0); r2 += (a1 == e2 ? 1 : 0) + (a2 == e2 ? 1 : 0); }
                i32x4 ti; ti.x = e1; ti.y = r1; ti.z = e2; ti.w = r2; TOKI[row] = ti; f32x2 tg; tg.x = rgate[tid * 2]; tg.y = rgate[tid * 2 + 1]; TOKG[row] = tg; RS1[row] = rsd[tid]; }
            __syncthreads();
        }
        if (N_LAUNCHES == 1) xcd_barrier(bar);
        for (int rb = blockIdx.x; rb < S_ / 64; rb += G) {
            { const int e = tid & 7, ch = tid >> 3; int c = 0;
              for (int j = 0; j < 4; ++j) { const int rb2 = ch * 4 + j; if (rb2 < rb) c += (int)__hip_atomic_load(bcnt + rb2 * 8 + e, RLX_AGENT); }
              part[ch * 8 + e] = c; }
            __syncthreads();
            if (tid < 8) { int c = 0; for (int ch = 0; ch < 64; ++ch) c += part[ch * 8 + tid]; gbase[tid] = c;
                if (rb == S_ / 64 - 1) __hip_atomic_store(ctl + CW_CNT + 64 * tid, (unsigned)(c + (int)__hip_atomic_load(bcnt + rb * 8 + tid, RLX_AGENT)), RLX_AGENT); }
            __syncthreads();
            if (tid < 64) { const int row = rb * 64 + tid; i32x4 ti = TOKI[row]; ti.y += gbase[ti.x]; ti.w += gbase[ti.z]; TOKI[row] = ti; rinfo[tid * 4] = ti.x; rinfo[tid * 4 + 1] = ti.y; rinfo[tid * 4 + 2] = ti.z; rinfo[tid * 4 + 3] = ti.w; rsd[tid] = RS1[row]; }
            __syncthreads();
            f32x4 xc[8];
            { const f32x4* x0 = (const f32x4*)(X1 + (size_t)(rb * 64 + wave * 8) * DM) + lane;
#pragma unroll
              for (int j = 0; j < 8; ++j) xc[j] = x0[64 * j]; }
            for (int rr = 0; rr < 8; ++rr) {
                const int q = wave * 8 + rr, row = rb * 64 + q; const int e1 = rinfo[q * 4], e2 = rinfo[q * 4 + 2]; const int sl1 = rinfo[q * 4 + 1], sl2 = rinfo[q * 4 + 3]; const float rstd = rsd[q];
                f32x4 xnx[8];
                { const f32x4* x1p = (const f32x4*)(X1 + (size_t)(rr < 7 ? row + 1 : row) * DM) + lane;
#pragma unroll
                  for (int j = 0; j < 8; ++j) xnx[j] = x1p[64 * j]; }
                unsigned* o1 = (unsigned*)(XG8 + ((size_t)e1 * S_ + sl1) * XP) + lane; unsigned* o2 = (unsigned*)(XG8 + ((size_t)e2 * S_ + sl2) * XP) + lane;
#pragma unroll
                for (int j = 0; j < 8; ++j) { const f32x4 y = xc[j] * (rstd * SA_X) * ((const f32x4*)gn)[lane + 64 * j]; const unsigned o = pg8::pk4_fp8(y.x, y.y, y.z, y.w); o1[64 * j] = o; o2[64 * j] = o; }
#pragma unroll
                for (int j = 0; j < 8; ++j) xc[j] = xnx[j];
            }
            __syncthreads();
        }
        if (BOTH(11)) GRID_BAR(11);
    }
#define MOE_TS(ts_) do { int tot_ = 0; _Pragma("unroll") for (int e_ = 0; e_ < 8; ++e_) { const int c_ = __builtin_amdgcn_readfirstlane((int)__hip_atomic_load(ctl + CW_CNT + 64 * e_, RLX_AGENT)); (ts_)[e_] = tot_; tot_ += (c_ + 255) >> 8; } (ts_)[8] = tot_; } while (0)
    if (IN(13)) { FRESH_TID();
        pg8::MoeOrder S; MOE_TS(S.ts); S.rep = REPN(13); S.nM = S.ts[8]; S.nN = 2 * DE / 256; S.nwg = S.nM * S.nN; S.G = G; S.c = (int)blockIdx.x;
#ifdef PROBE_P13_CUS
        S.G = PROBE_P13_CUS; if ((int)blockIdx.x >= PROBE_P13_CUS) S.nwg = 0;
#endif
        S.A = (const char*)XG8; S.B = (const char*)WEGU8; S.tstepA = (size_t)256 * XP; S.tstepB = (size_t)256 * XP; S.estride = (size_t)2 * DE * XP; S.ecapA = (size_t)S_ * XP;
        pg8::EpiSwiGLU8 E{HIDE8, DE, 1.0f / (SA_X * SW_GU), SA_H, nullptr, 0.f, 0.f};
        pg8::gemm_phase<pg8::EpiSwiGLU8, pg8::MoeOrder, true, true, true>(L, XP, S, E, wave, DM);
        if (BOTH(13)) GRID_BAR(13);
    }
#define MOE_SK(R_) 4
    if (IN(14)) { FRESH_TID();
#ifndef PROBE_NMAIN
#define PROBE_NMAIN 128
#endif
        pg8::MoeOrder S; MOE_TS(S.ts); const int nT = S.ts[8]; const int nMain = PROBE_NMAIN; const bool split = (G == 256) && nT > nMain && REPN(14) == 1;
        S.rep = REPN(14); S.nM = split ? nMain : nT; S.nN = DM / 256; S.nwg = S.nM * S.nN; S.G = G; S.c = (int)blockIdx.x;
        S.A = (const char*)HIDE8; S.B = (const char*)WED8; S.tstepA = (size_t)256 * DE; S.tstepB = (size_t)256 * DE; S.estride = (size_t)DM * DE; S.ecapA = 0;
        pg8::EpiBf16S E{YB, DM, 1.0f / (SA_H * SW_D)};
        pg8::gemm_phase<pg8::EpiBf16S, pg8::MoeOrder, true, true, true>(L, DE, S, E, wave);
        if (split) {
            const int R = nT - nMain, SK = MOE_SK(R);
            pg8::SplitOrder S2; S2.base = nMain; S2.R = R; S2.SK = SK; S2.nsub = 8 * R * SK; S2.G = G; S2.c = (int)blockIdx.x; S2.klen = DE / SK;
#pragma unroll
            for (int e_ = 0; e_ < 9; ++e_) S2.ts[e_] = S.ts[e_];
            S2.A = S.A; S2.B = S.B; S2.tstepA = S.tstepA; S2.tstepB = S.tstepB; S2.estride = S.estride;
            pg8::EpiBf16S E2{(bf16*)YPART, DM, 1.0f / (SA_H * SW_D)};
            pg8::gemm_phase<pg8::EpiBf16S, pg8::SplitOrder, true, true, true>(L, DE, S2, E2, wave, S2.klen);
            if ((int)blockIdx.x < S2.nsub) {
                const int sk = (int)blockIdx.x % SK, unit = (int)blockIdx.x / SK, rtl = unit >> 3, pn = unit & 7;
                __syncthreads();
                if (threadIdx.x == 0) {
                    __hip_atomic_fetch_add(ctl + CW_KS + unit, 1u, __ATOMIC_RELEASE, __HIP_MEMORY_SCOPE_AGENT);
                    while (__hip_atomic_load(ctl + CW_KS + unit, __ATOMIC_ACQUIRE, __HIP_MEMORY_SCOPE_AGENT) < (unsigned)SK) __builtin_amdgcn_s_sleep(2);
                }
                __syncthreads();
                const int RS = (256 + SK - 1) / SK, rbeg = sk * RS, rend = rbeg + RS < 256 ? rbeg + RS : 256;
                const int cc = fresh_lane() * 4;
                for (int r = rbeg + wave; r < rend; r += NWAVES) {
                    f32x4 acc = {0.f, 0.f, 0.f, 0.f};
                    for (int k2 = 0; k2 < SK; ++k2) { const v2u u = *(const v2u*)((const bf16*)YPART + ((size_t)(k2 * R + rtl) * 256 + r) * DM + pn * 256 + cc);
                        acc.x += __uint_as_float(u.x << 16); acc.y += __uint_as_float(u.x & 0xffff0000u); acc.z += __uint_as_float(u.y << 16); acc.w += __uint_as_float(u.y & 0xffff0000u); }
                    v2u w; w.x = pk2(acc.x, acc.y); w.y = pk2(acc.z, acc.w);
                    *(v2u*)(YB + ((size_t)(nMain + rtl) * 256 + r) * DM + pn * 256 + cc) = w;
                }
            }
        }
        if (BOTH(14)) GRID_BAR(14);
    }
    if (IN(15)) { FRESH_TID();
        int ts[9]; MOE_TS(ts);
        unsigned poison = __hip_atomic_load(ctl + CW_TMO, RLX_AGENT) | __hip_atomic_load(ctl + CW_BAR + XB_TMO, RLX_AGENT);
#define P15_LOAD(UA, UB, XV, I_) do { const int mc_ = mi_[I_] < S_ ? mi_[I_] : S_ - 1; int t1 = 0, t2 = 0; \
            _Pragma("unroll") for (int e = 0; e < 8; ++e) { t1 = (tis_[I_].x == e) ? ts[e] : t1; t2 = (tis_[I_].z == e) ? ts[e] : t2; } \
            const v2u* y1 = (const v2u*)(YB + (size_t)(256 * t1 + tis_[I_].y) * DM) + lane; const v2u* y2 = (const v2u*)(YB + (size_t)(256 * t2 + tis_[I_].w) * DM) + lane; \
            const f32x4* xr = (const f32x4*)(X1 + (size_t)mc_ * DM) + lane; \
            _Pragma("unroll") for (int j = 0; j < 8; ++j) { UA[j] = __builtin_nontemporal_load(y1 + 64 * j); UB[j] = __builtin_nontemporal_load(y2 + 64 * j); XV[j] = __builtin_nontemporal_load(xr + 64 * j); } } while (0)
#define P15_FIN(UA, UB, XV, I_) do { const bool first_lo = tis_[I_].x < tis_[I_].z; f32x4 v[8]; float s = 0.f; \
            _Pragma("unroll") for (int j = 0; j < 8; ++j) { const v2u ua = UA[j], ub = UB[j]; \
                const f32x4 a = (f32x4){__uint_as_float(ua.x << 16), __uint_as_float(ua.x & 0xffff0000u), __uint_as_float(ua.y << 16), __uint_as_float(ua.y & 0xffff0000u)} * tgs_[I_].x; \
                const f32x4 b = (f32x4){__uint_as_float(ub.x << 16), __uint_as_float(ub.x & 0xffff0000u), __uint_as_float(ub.y << 16), __uint_as_float(ub.y & 0xffff0000u)} * tgs_[I_].y; \
                v[j] = XV[j] + (first_lo ? (a + b) : (b + a)); s += dot4(v[j], v[j]); } \
            float rstd = 1.0f / sqrtf(wave_sum(s) * (1.0f / DM) + NORM_EPS); \
            if (poison) rstd = __builtin_nanf(""); \
            if (mi_[I_] < S_) { f32x4* o = (f32x4*)(args.out + (size_t)mi_[I_] * DM) + lane; \
                _Pragma("unroll") for (int j = 0; j < 8; ++j) __builtin_nontemporal_store(v[j] * rstd * ((const f32x4*)norm_final)[lane + 64 * j], o + 64 * j); } } while (0)
        SMALLREP_N(104) for (int mb = gw; mb < S_; mb += 8 * NGW) {
            int mi_[8]; i32x4 tis_[8]; f32x2 tgs_[8];
#pragma unroll
            for (int i = 0; i < 8; ++i) { mi_[i] = mb + i * NGW; const int mc_ = mi_[i] < S_ ? mi_[i] : S_ - 1; tis_[i] = TOKI[mc_]; tgs_[i] = TOKG[mc_]; }
            v2u ua0[8], ub0[8], ua1[8], ub1[8]; f32x4 xv0[8], xv1[8];
            P15_LOAD(ua0, ub0, xv0, 0);
            P15_LOAD(ua1, ub1, xv1, 1); P15_FIN(ua0, ub0, xv0, 0);
            P15_LOAD(ua0, ub0, xv0, 2); P15_FIN(ua1, ub1, xv1, 1);
            P15_LOAD(ua1, ub1, xv1, 3); P15_FIN(ua0, ub0, xv0, 2);
            P15_LOAD(ua0, ub0, xv0, 4); P15_FIN(ua1, ub1, xv1, 3);
            P15_LOAD(ua1, ub1, xv1, 5); P15_FIN(ua0, ub0, xv0, 4);
            P15_LOAD(ua0, ub0, xv0, 6); P15_FIN(ua1, ub1, xv1, 5);
            P15_LOAD(ua1, ub1, xv1, 7); P15_FIN(ua0, ub0, xv0, 6);
            P15_FIN(ua1, ub1, xv1, 7);
        }
#undef P15_LOAD
#undef P15_FIN
    }
#undef TR_RUN
#undef TR_RUN_X
#undef TR_RUN_XG
#undef TR_SET_W
#undef TR_DECODE_MOE
#undef TR_DECODE
#undef TR_SET
#undef IN
#undef BOTH
#undef GRID_BAR
#undef MOE_TS
}

extern "C" void kernel_launch(void* const* d_in, const int* in_sizes, int n_in, void* d_out, int out_size, void* d_ws, size_t ws_size, hipStream_t stream) {
    static int grid = 0;
    if (grid == 0) {
        if (n_in != 25 || in_sizes[0] != S_ * DM || out_size != S_ * DM || ws_size < WS_END) { fprintf(stderr, "kernel_launch: shape / workspace mismatch (n_in %d, in0 %d, out %d, ws %zu, need %zu); nothing launched\n", n_in, n_in > 0 ? in_sizes[0] : -1, out_size, ws_size, (size_t)WS_END); grid = -1; return; }
        int dev = 0, cus = 0;
        if (hipGetDevice(&dev) != hipSuccess || hipDeviceGetAttribute(&cus, hipDeviceAttributeMultiprocessorCount, dev) != hipSuccess) { fprintf(stderr, "kernel_launch: device query failed\n"); grid = -1; return; }
        if (hipFuncSetAttribute((const void*)yoco_fwd, hipFuncAttributeMaxDynamicSharedMemorySize, LDS_BYTES) != hipSuccess) { fprintf(stderr, "kernel_launch: hipFuncSetAttribute failed\n"); grid = -1; return; }
        int per_cu = 0;
        if (hipOccupancyMaxActiveBlocksPerMultiprocessor(&per_cu, (const void*)yoco_fwd, NWAVES * 64, LDS_BYTES) != hipSuccess || per_cu < 1) { fprintf(stderr, "kernel_launch: occupancy query reports %d workgroups per CU\n", per_cu); }
        (void)hipGetLastError();
        grid = cus;
    }
    if (grid < 0) return;
    if (hipMemsetAsync((char*)d_ws + WS_CTL, 0, CTL_ZERO_BYTES, stream) != hipSuccess) { fprintf(stderr, "kernel_launch: memset failed\n"); return; }
    Args a{};
    for (int i = 0; i < 25; ++i) a.in[i] = d_in[i];
    a.out = (float*)d_out; a.ws = (unsigned char*)d_ws; a.pad = 0;
    if (N_LAUNCHES == 1) { a.ph_lo = 0; a.ph_hi = N_PHASES; a.li = 0; hipLaunchKernelGGL(yoco_fwd, dim3(grid), dim3(NWAVES * 64), LDS_BYTES, stream, a); }
    else { for (int li = 0; li < N_PHASES; ++li) { a.ph_lo = li; a.ph_hi = li + 1; a.li = li; hipLaunchKernelGGL(yoco_fwd, dim3(grid), dim3(NWAVES * 64), LDS_BYTES, stream, a); } }
    const hipError_t le = hipPeekAtLastError();
    if (le != hipSuccess) fprintf(stderr, "kernel_launch: launch failed: %s\n", hipGetErrorName(le));
}
```

```cpp
#include <hip/hip_runtime.h>
#include <hip/hip_bf16.h>
#include <cstdio>
#include <cstdint>

__device__ __forceinline__ int fresh_lane() { int l; asm volatile("v_mbcnt_lo_u32_b32 %0, -1, 0\n\tv_mbcnt_hi_u32_b32 %0, -1, %0" : "=v"(l)); return l; }

namespace pg8 {
#define PG8_LAS __attribute__((address_space(3)))
typedef unsigned short bf16_t;
typedef short bf16x8 __attribute__((ext_vector_type(8)));
typedef float f32x4 __attribute__((ext_vector_type(4)));
typedef unsigned u32x4 __attribute__((ext_vector_type(4)));
typedef int i32x4 __attribute__((ext_vector_type(4)));
typedef int i32x8 __attribute__((ext_vector_type(8)));
typedef unsigned u32x2 __attribute__((ext_vector_type(2)));
constexpr int BM = 256, BK = 64, HALF = 128, HTB = HALF * BK * 2  , STAGE_BYTES = 8 * HTB, NXCD = 8, WGM = 8;

__host__ __device__ __forceinline__ int lds_byte(int r, int c) { const int st = (r >> 4) * 2 + (c >> 5), rr = r & 15, cc = c & 31, ob = rr * 64 + cc * 2; return st * 1024 + (ob ^ (((ob >> 9) & 1) << 5)); }
__host__ __device__ __forceinline__ void stage_rc(int b, int& R, int& C) { const int st = b / 1024, sb = b % 1024, swz = sb ^ (((sb >> 9) & 1) << 5); R = (st >> 1) * 16 + swz / 64; C = (st & 1) * 32 + (swz % 64) / 2; }
__host__ __device__ __forceinline__ int perm32(int rho) { const int n = rho >> 4, i = rho & 15; return 8 * (i >> 2) + 4 * n + (i & 3); }

struct Unit { int pm, pn, aux; const char* A; const char* B; };

struct GemmOrder {
    int nM, nN, nwg, G, c, ashift, rep; const char* A; const char* B; size_t tstepA, tstepB, astride;
    __device__ __forceinline__ void init(int nM_, int nN_, int G_, int c_, const void* A_, const void* B_, int K, int ashift_, size_t astride_) {
        nM = nM_; nN = nN_; nwg = nM * nN; G = G_; c = c_; A = (const char*)A_; B = (const char*)B_; tstepA = (size_t)BM * K * 2;     tstepB = tstepA; ashift = ashift_; astride = astride_; rep = 1; }
    __device__ __forceinline__ bool next(int i, Unit& u) const {
        const long L = (long)i * G + c; if (L >= (long)nwg * rep) return false;
        int wgid = (int)(L % nwg); { const int q = nwg / NXCD, r = nwg % NXCD, xcd = wgid % NXCD, off = wgid / NXCD; wgid = (xcd < r ? xcd * (q + 1) : r * (q + 1) + (xcd - r) * q) + off; }
        const int nig = WGM * nN, gid = wgid / nig, fm = gid * WGM, gsz = (nM - fm) < WGM ? (nM - fm) : WGM;
        u.pm = fm + ((wgid % nig) % gsz); u.pn = (wgid % nig) / gsz; u.aux = 0;
        u.A = A + (size_t)(u.pn >> ashift) * astride + (size_t)u.pm * tstepA; u.B = B + (size_t)u.pn * tstepB; return true;
    }
    __device__ __forceinline__ void a_ready(const Unit&) const {}
    __device__ __forceinline__ void done(const Unit&) const {}
};
struct MoeOrder {
    int nM, nN, nwg, G, c, rep; int ts[9]; const char* A; const char* B; size_t tstepA, tstepB, estride, ecapA;
    __device__ __forceinline__ bool next(int i, Unit& u) const {
        const long L = (long)i * G + c; if (L >= (long)nwg * rep) return false;
        int wgid = (int)(L % nwg); { const int q = nwg / NXCD, r = nwg % NXCD, xcd = wgid % NXCD, off = wgid / NXCD; wgid = (xcd < r ? xcd * (q + 1) : r * (q + 1) + (xcd - r) * q) + off; }
        const int nig = WGM * nN, gid = wgid / nig, fm = gid * WGM, gsz = (nM - fm) < WGM ? (nM - fm) : WGM;
        u.pm = fm + ((wgid % nig) % gsz); u.pn = (wgid % nig) / gsz;
        int e = 0, t0 = 0;
#pragma unroll
        for (int j = 1; j < 8; ++j) { const bool ge = u.pm >= ts[j]; e += ge ? 1 : 0; t0 = ge ? ts[j] : t0; }
        u.aux = e;
        u.A = ecapA ? A + (size_t)e * ecapA + (size_t)(u.pm - t0) * tstepA : A + (size_t)u.pm * tstepA; u.B = B + (size_t)e * estride + (size_t)u.pn * tstepB; return true;
    }
    __device__ __forceinline__ void a_ready(const Unit&) const {}
    __device__ __forceinline__ void done(const Unit&) const {}
};

struct SplitOrder {
    int R, SK, nsub, G, c, klen, base; int ts[9]; const char* A; const char* B; size_t tstepA, tstepB, estride, klenB;
    __device__ __forceinline__ bool next(int i, Unit& u) const {
        const long L = (long)i * G + c; if (L >= nsub) return false;
        const int sk = (int)(L % SK), unit = (int)(L / SK), rtl = unit >> 3, pm = base + rtl;
        int e = 0;
#pragma unroll
        for (int j = 1; j < 8; ++j) e += (pm >= ts[j]) ? 1 : 0;
        u.pm = sk * R + rtl; u.pn = unit & 7; u.aux = e;
        u.A = A + (size_t)pm * tstepA + (size_t)sk * klen; u.B = B + (size_t)e * estride + (size_t)u.pn * tstepB + (size_t)sk * klenB; return true;
    }
    __device__ __forceinline__ void a_ready(const Unit&) const {}
    __device__ __forceinline__ void done(const Unit&) const {}
};

__device__ __forceinline__ unsigned cvt_pk_bf16(float lo, float hi) { unsigned r; asm volatile("v_cvt_pk_bf16_f32 %0, %1, %2" : "=v"(r) : "v"(lo), "v"(hi)); return r; }

struct EpiResF32 {
    static constexpr bool PERM = false, AFTER_DRAIN = false;
    const float* base; float* out; int ldc; const float* scale;
    __device__ __forceinline__ void operator()(const f32x4 (&acc)[2][2][4][2], const Unit& u, int wr, int wc, int fr, int fq) const {
        const int row0 = u.pm * BM + wr * 64 + fr, col0 = u.pn * BM + wc * 32 + 4 * fq;
        f32x4 sv[2][2];
#pragma unroll
        for (int bj = 0; bj < 2; ++bj)
#pragma unroll
            for (int n = 0; n < 2; ++n) sv[bj][n] = scale ? *(const f32x4*)(scale + col0 + bj * HALF + n * 16) : (f32x4){1.f, 1.f, 1.f, 1.f};
#pragma unroll
        for (int ai = 0; ai < 2; ++ai) { f32x4 bs[4][2][2];
#pragma unroll
            for (int m = 0; m < 4; ++m) { const size_t off = (size_t)(row0 + ai * HALF + m * 16) * ldc + col0;
#pragma unroll
                for (int bj = 0; bj < 2; ++bj)
#pragma unroll
                    for (int n = 0; n < 2; ++n) bs[m][bj][n] = *(const f32x4*)(base + off + bj * HALF + n * 16); }
            asm volatile("" ::: "memory");
#pragma unroll
            for (int m = 0; m < 4; ++m) { const size_t off = (size_t)(row0 + ai * HALF + m * 16) * ldc + col0;
#pragma unroll
                for (int bj = 0; bj < 2; ++bj)
#pragma unroll
                    for (int n = 0; n < 2; ++n) *(f32x4*)(out + off + bj * HALF + n * 16) = bs[m][bj][n] + acc[ai][bj][m][n] * sv[bj][n]; }
            asm volatile("" ::: "memory"); }
    }
};
__device__ __forceinline__ unsigned pk4_fp8(float a, float b, float c, float d) {
    a = __builtin_amdgcn_fmed3f(a, -448.f, 448.f); b = __builtin_amdgcn_fmed3f(b, -448.f, 448.f); c = __builtin_amdgcn_fmed3f(c, -448.f, 448.f); d = __builtin_amdgcn_fmed3f(d, -448.f, 448.f);
    int r = __builtin_amdgcn_cvt_pk_fp8_f32(a, b, 0, false); r = __builtin_amdgcn_cvt_pk_fp8_f32(c, d, r, true); return (unsigned)r; }
struct EpiResF32N {
    static constexpr bool PERM = false, AFTER_DRAIN = false;
    const float* base; float* out; int ldc; const float* scale; bf16_t* xb; float* ssp; PG8_LAS float* tab; float osc; unsigned char* x8; float s8;
    __device__ __forceinline__ void operator()(const f32x4 (&acc)[2][2][4][2], const Unit& u, int wr, int wc, int fr, int fq) const {
        const int row0 = u.pm * BM + wr * 64 + fr, col0 = u.pn * BM + wc * 32 + 4 * fq;
        f32x4 sv[2][2];
#pragma unroll
        for (int bj = 0; bj < 2; ++bj)
#pragma unroll
            for (int n = 0; n < 2; ++n) sv[bj][n] = scale ? *(const f32x4*)(scale + col0 + bj * HALF + n * 16) : (f32x4){1.f, 1.f, 1.f, 1.f};
#pragma unroll
        for (int ai = 0; ai < 2; ++ai) { f32x4 bsv[4][2][2];
#pragma unroll
            for (int m = 0; m < 4; ++m) { const size_t off = (size_t)(row0 + ai * HALF + m * 16) * ldc + col0;
#pragma unroll
                for (int bj = 0; bj < 2; ++bj)
#pragma unroll
                    for (int n = 0; n < 2; ++n) bsv[m][bj][n] = *(const f32x4*)(base + off + bj * HALF + n * 16); }
            asm volatile("" ::: "memory");
#pragma unroll
            for (int m = 0; m < 4; ++m) { const int row = row0 + ai * HALF + m * 16; const size_t off = (size_t)row * ldc + col0; float q = 0.f;
#pragma unroll
                for (int bj = 0; bj < 2; ++bj)
#pragma unroll
                    for (int n = 0; n < 2; ++n) { const f32x4 bs = bsv[m][bj][n]; const f32x4 v = bs + acc[ai][bj][m][n] * (sv[bj][n] * osc);
                        *(f32x4*)(out + off + bj * HALF + n * 16) = v; q += (v[0] * v[0] + v[1] * v[1]) + (v[2] * v[2] + v[3] * v[3]);
                        if (xb) { u32x2 w; w.x = cvt_pk_bf16(v[0], v[1]); w.y = cvt_pk_bf16(v[2], v[3]); *(u32x2*)(xb + off + bj * HALF + n * 16) = w; }
                        if (x8) *(unsigned*)(x8 + off + bj * HALF + n * 16) = pk4_fp8(v[0] * s8, v[1] * s8, v[2] * s8, v[3] * s8); }
                q += __shfl_xor(q, 16); q += __shfl_xor(q, 32);
                if (fq == 0) tab[(ai * HALF + wr * 64 + m * 16 + fr) * 4 + wc] = q;
                asm volatile("" ::: "memory"); } }
        asm volatile("s_waitcnt lgkmcnt(0)" ::: "memory"); __builtin_amdgcn_s_barrier(); asm volatile("" ::: "memory");
        const int t = (wr * 4 + wc) * 64 + fq * 16 + fr;
        if (t < BM) { const PG8_LAS f32x4* p = (const PG8_LAS f32x4*)(tab + t * 4); const f32x4 s = *p; ssp[(size_t)(u.pm * BM + t) * 8 + u.pn] = ((s[0] + s[1]) + s[2]) + s[3]; }
    }
};
struct EpiBf16S {
    static constexpr bool PERM = true, AFTER_DRAIN = false;
    bf16_t* O; int ldc; float sc;
    __device__ __forceinline__ void operator()(const f32x4 (&acc)[2][2][4][2], const Unit& u, int wr, int wc, int fr, int fq) const {
        const int row0 = u.pm * BM + wr * 64 + fr, col0 = u.pn * BM + wc * 32 + 8 * fq;
#pragma unroll
        for (int ai = 0; ai < 2; ++ai)
#pragma unroll
            for (int m = 0; m < 4; ++m) { bf16_t* rowp = O + (size_t)(row0 + ai * HALF + m * 16) * ldc + col0;
#pragma unroll
                for (int bj = 0; bj < 2; ++bj) { const f32x4 v0 = acc[ai][bj][m][0] * sc, v1 = acc[ai][bj][m][1] * sc;
                    u32x4 w; w.x = cvt_pk_bf16(v0[0], v0[1]); w.y = cvt_pk_bf16(v0[2], v0[3]); w.z = cvt_pk_bf16(v1[0], v1[1]); w.w = cvt_pk_bf16(v1[2], v1[3]);
                    *(u32x4*)(rowp + bj * HALF) = w; } }
    }
};
struct EpiF32 {
    static constexpr bool PERM = false, AFTER_DRAIN = false;
    float* out; int ldc; float sc;
    __device__ __forceinline__ void operator()(const f32x4 (&acc)[2][2][4][2], const Unit& u, int wr, int wc, int fr, int fq) const {
        const int row0 = u.pm * BM + wr * 64 + fr, col0 = u.pn * BM + wc * 32 + 4 * fq;
#pragma unroll
        for (int ai = 0; ai < 2; ++ai)
#pragma unroll
            for (int m = 0; m < 4; ++m) { float* rowp = out + (size_t)(row0 + ai * HALF + m * 16) * ldc + col0;
#pragma unroll
                for (int bj = 0; bj < 2; ++bj)
#pragma unroll
                    for (int n = 0; n < 2; ++n) *(f32x4*)(rowp + bj * HALF + n * 16) = acc[ai][bj][m][n] * sc; }
    }
};
__device__ __forceinline__ float row_rstd(const float* ssp, int row, float inv_n, float eps) { const f32x4 a = *(const f32x4*)(ssp + (size_t)row * 8), b = *(const f32x4*)(ssp + (size_t)row * 8 + 4);
    return 1.0f / sqrtf((((a[0] + a[1]) + (a[2] + a[3])) + ((b[0] + b[1]) + (b[2] + b[3]))) * inv_n + eps); }
__device__ __forceinline__ float silu_mul(float g, float u) { return g * u * __builtin_amdgcn_rcpf(1.0f + __builtin_amdgcn_exp2f(-1.4426950408889634f * g)); }
struct EpiSwiGLU {
    static constexpr bool PERM = true, AFTER_DRAIN = false;
    bf16_t* O; int ldc; const float* ssp; float inv_n, eps, sin;
    __device__ __forceinline__ void operator()(const f32x4 (&acc)[2][2][4][2], const Unit& u, int wr, int wc, int fr, int fq) const {
        const int row0 = u.pm * BM + wr * 64 + fr, col0 = u.pn * HALF + wc * 32 + 8 * fq;
        float rs8[2][4];
#pragma unroll
        for (int ai = 0; ai < 2; ++ai)
#pragma unroll
            for (int m = 0; m < 4; ++m) rs8[ai][m] = sin * row_rstd(ssp, row0 + ai * HALF + m * 16, inv_n, eps);
        asm volatile("" ::: "memory");
#pragma unroll
        for (int ai = 0; ai < 2; ++ai)
#pragma unroll
            for (int m = 0; m < 4; ++m) { const int row = row0 + ai * HALF + m * 16; bf16_t* rowp = O + (size_t)row * ldc + col0; const float rs = rs8[ai][m];
                const f32x4 g0 = acc[ai][0][m][0] * rs, g1 = acc[ai][0][m][1] * rs, u0 = acc[ai][1][m][0] * rs, u1 = acc[ai][1][m][1] * rs;
                u32x4 w; w.x = cvt_pk_bf16(silu_mul(g0[0], u0[0]), silu_mul(g0[1], u0[1])); w.y = cvt_pk_bf16(silu_mul(g0[2], u0[2]), silu_mul(g0[3], u0[3]));
                w.z = cvt_pk_bf16(silu_mul(g1[0], u1[0]), silu_mul(g1[1], u1[1])); w.w = cvt_pk_bf16(silu_mul(g1[2], u1[2]), silu_mul(g1[3], u1[3]));
                *(u32x4*)rowp = w; }
    }
};
struct EpiSwiGLU8 {
    static constexpr bool PERM = true, AFTER_DRAIN = false;
    unsigned char* O; int ldc; float sin, sout; const float* ssp; float inv_n, eps;
    __device__ __forceinline__ void operator()(const f32x4 (&acc)[2][2][4][2], const Unit& u, int wr, int wc, int fr, int fq) const {
        const int row0 = u.pm * BM + wr * 64 + fr, col0 = u.pn * HALF + wc * 32 + 8 * fq;
        float kg8[2][4];
#pragma unroll
        for (int ai = 0; ai < 2; ++ai)
#pragma unroll
            for (int m = 0; m < 4; ++m) kg8[ai][m] = ssp ? sin * row_rstd(ssp, row0 + ai * HALF + m * 16, inv_n, eps) : sin;
        asm volatile("" ::: "memory");
#pragma unroll
        for (int ai = 0; ai < 2; ++ai)
#pragma unroll
            for (int m = 0; m < 4; ++m) { const int row = row0 + ai * HALF + m * 16; unsigned char* rowp = O + (size_t)row * ldc + col0; const float kg = kg8[ai][m];
                const f32x4 g0 = acc[ai][0][m][0] * kg, g1 = acc[ai][0][m][1] * kg, u0 = acc[ai][1][m][0] * (kg * sout), u1 = acc[ai][1][m][1] * (kg * sout);
                u32x2 w; w.x = pk4_fp8(silu_mul(g0[0], u0[0]), silu_mul(g0[1], u0[1]), silu_mul(g0[2], u0[2]), silu_mul(g0[3], u0[3]));
                w.y = pk4_fp8(silu_mul(g1[0], u1[0]), silu_mul(g1[1], u1[1]), silu_mul(g1[2], u1[2]), silu_mul(g1[3], u1[3]));
                *(u32x2*)rowp = w; }
    }
};
struct EpiKVQ {
    static constexpr bool PERM = true, AFTER_DRAIN = false;
    bf16_t* K16; bf16_t* V16; bf16_t* Q16; const float* rope; int S; const float* ssp; float inv_n, eps;
    __device__ __forceinline__ void operator()(const f32x4 (&acc)[2][2][4][2], const Unit& u, int wr, int wc, int fr, int fq) const {
        const int row0 = u.pm * BM + wr * 64 + fr;
        const int kind = u.pn >> 3, head = u.pn & 7;
        float rs8[2][4];
#pragma unroll
        for (int ai = 0; ai < 2; ++ai)
#pragma unroll
            for (int m = 0; m < 4; ++m) rs8[ai][m] = row_rstd(ssp, row0 + ai * HALF + m * 16, inv_n, eps);
        asm volatile("" ::: "memory");
        if (kind == 1) {
#pragma unroll
            for (int ai = 0; ai < 2; ++ai)
#pragma unroll
                for (int m = 0; m < 4; ++m) { const int row = row0 + ai * HALF + m * 16; const float rs = rs8[ai][m];
#pragma unroll
                    for (int bj = 0; bj < 2; ++bj) { const f32x4 v0 = acc[ai][bj][m][0] * rs, v1 = acc[ai][bj][m][1] * rs;
                        u32x4 w; w.x = cvt_pk_bf16(v0[0], v0[1]); w.y = cvt_pk_bf16(v0[2], v0[3]); w.z = cvt_pk_bf16(v1[0], v1[1]); w.w = cvt_pk_bf16(v1[2], v1[3]);
                        *(u32x4*)(V16 + ((size_t)head * S + row) * 256 + bj * 128 + wc * 32 + 8 * fq) = w; } }
        } else {
            bf16_t* dst = (kind == 0 ? K16 : Q16) + (size_t)(head * 2 + (wc >> 1)) * S * 128;
            const int d0 = (wc & 1) * 32 + 8 * fq;
            f32x4 cn[4];
            { const f32x4* cs0 = (const f32x4*)(rope + ((size_t)row0 * 64 + d0) * 2); cn[0] = cs0[0]; cn[1] = cs0[1]; cn[2] = cs0[2]; cn[3] = cs0[3]; }
#pragma unroll
            for (int ai = 0; ai < 2; ++ai)
#pragma unroll
                for (int m = 0; m < 4; ++m) { const int row = row0 + ai * HALF + m * 16; const float rs = rs8[ai][m];
                    const f32x4 c01 = cn[0], c23 = cn[1], c45 = cn[2], c67 = cn[3];
                    { const int ix = ai * 4 + m + 1, rown = row0 + ((ix >> 2) & 1) * HALF + (ix & 3) * 16; const f32x4* cs = (const f32x4*)(rope + ((size_t)(ix < 8 ? rown : row) * 64 + d0) * 2);
                      cn[0] = cs[0]; cn[1] = cs[1]; cn[2] = cs[2]; cn[3] = cs[3]; }
                    asm volatile("" ::: "memory");
                    const f32x4 a0 = acc[ai][0][m][0] * rs, a1 = acc[ai][0][m][1] * rs, b0 = acc[ai][1][m][0] * rs, b1 = acc[ai][1][m][1] * rs;
                    float o1[8], o2[8];
                    o1[0] = a0[0] * c01[0] - b0[0] * c01[1]; o2[0] = b0[0] * c01[0] + a0[0] * c01[1];
                    o1[1] = a0[1] * c01[2] - b0[1] * c01[3]; o2[1] = b0[1] * c01[2] + a0[1] * c01[3];
                    o1[2] = a0[2] * c23[0] - b0[2] * c23[1]; o2[2] = b0[2] * c23[0] + a0[2] * c23[1];
                    o1[3] = a0[3] * c23[2] - b0[3] * c23[3]; o2[3] = b0[3] * c23[2] + a0[3] * c23[3];
                    o1[4] = a1[0] * c45[0] - b1[0] * c45[1]; o2[4] = b1[0] * c45[0] + a1[0] * c45[1];
                    o1[5] = a1[1] * c45[2] - b1[1] * c45[3]; o2[5] = b1[1] * c45[2] + a1[1] * c45[3];
                    o1[6] = a1[2] * c67[0] - b1[2] * c67[1]; o2[6] = b1[2] * c67[0] + a1[2] * c67[1];
                    o1[7] = a1[3] * c67[2] - b1[3] * c67[3]; o2[7] = b1[3] * c67[2] + a1[3] * c67[3];
                    u32x4 w1, w2; w1.x = cvt_pk_bf16(o1[0], o1[1]); w1.y = cvt_pk_bf16(o1[2], o1[3]); w1.z = cvt_pk_bf16(o1[4], o1[5]); w1.w = cvt_pk_bf16(o1[6], o1[7]);
                    w2.x = cvt_pk_bf16(o2[0], o2[1]); w2.y = cvt_pk_bf16(o2[2], o2[3]); w2.z = cvt_pk_bf16(o2[4], o2[5]); w2.w = cvt_pk_bf16(o2[6], o2[7]);
                    bf16_t* rp = dst + (size_t)row * 128 + d0;
                    *(u32x4*)rp = w1; *(u32x4*)(rp + 64) = w2; }
        }
    }
};

template <class Epi, class Sched, bool ALIGN_EPI = false, bool SP2 = false, bool F8 = false>
__device__ __forceinline__ void gemm_phase(PG8_LAS unsigned char* lds, const int rowbytes  , const Sched& S, const Epi& E, const int wave_id, const int kbytes = 0  , const int tmB = 0  ) {
    const int lane = fresh_lane(), wid = wave_id, tid = wid * 64 + lane, wr = wid >> 2, wc = wid & 3, fr = lane & 15, fq = lane >> 4;
    const int nt = (kbytes ? kbytes : rowbytes) / (BK * 2);
    const int rowbytesB = tmB ? BK * 2 : rowbytes;
    unsigned voffA[2], voffB[2];
#pragma unroll
    for (int i = 0; i < 2; ++i) { int R, C; stage_rc(tid * 16 + i * 8192, R, C); const int Rb = Epi::PERM ? ((R & ~31) + perm32(R & 31)) : R;
        voffA[i] = (unsigned)(R * rowbytes + C * 2); voffB[i] = (unsigned)(Rb * rowbytesB + C * 2); }
    const size_t kstep = (size_t)(BK * 2);
    const size_t kstepB = tmB ? (size_t)BM * (BK * 2) : kstep, hstepB = (size_t)HALF * rowbytesB;
    const size_t hstep = (size_t)HALF * rowbytes;
    const unsigned ldsw = (unsigned)wid * 1024u;
    const int aoff = lds_byte(wr * 64 + fr, fq * 8), boff = lds_byte(wc * 32 + fr, fq * 8);
#define PG8_SA(b, h) (((b) * 2 + (h)) * HTB)
#define PG8_SB(b, h) ((4 + (b) * 2 + (h)) * HTB)
#define PG8_STAGE(bufoff, gbase, voff) do { _Pragma("unroll") for (int _i = 0; _i < 2; ++_i) \
        __builtin_amdgcn_global_load_lds((const unsigned*)((const char*)(gbase) + (voff)[_i]), (PG8_LAS unsigned*)(lds + (bufoff) + ldsw + _i * 8192), 16, 0, 0); } while (0)
#define PG8_LDA(dst, b, h) do { _Pragma("unroll") for (int m = 0; m < 4; ++m) { if constexpr (F8) { dst##8[m] = __builtin_shufflevector(*(const PG8_LAS i32x4*)(lds + PG8_SA(b, h) + aoff + m * 2048), *(const PG8_LAS i32x4*)(lds + PG8_SA(b, h) + aoff + m * 2048 + 1024), 0, 1, 2, 3, 4, 5, 6, 7); } \
        else { _Pragma("unroll") for (int k = 0; k < 2; ++k) dst[m][k] = *(const PG8_LAS bf16x8*)(lds + PG8_SA(b, h) + aoff + m * 2048 + k * 1024); } } } while (0)
#define PG8_LDB(dst, b, h) do { _Pragma("unroll") for (int n = 0; n < 2; ++n) { if constexpr (F8) { dst##8[n] = __builtin_shufflevector(*(const PG8_LAS i32x4*)(lds + PG8_SB(b, h) + boff + n * 2048), *(const PG8_LAS i32x4*)(lds + PG8_SB(b, h) + boff + n * 2048 + 1024), 0, 1, 2, 3, 4, 5, 6, 7); } \
        else { _Pragma("unroll") for (int k = 0; k < 2; ++k) dst[n][k] = *(const PG8_LAS bf16x8*)(lds + PG8_SB(b, h) + boff + n * 2048 + k * 1024); } } } while (0)
#define PG8_MMA(ai, bj, At, Bt) do { __builtin_amdgcn_s_setprio(1); _Pragma("unroll") for (int m = 0; m < 4; ++m) _Pragma("unroll") for (int n = 0; n < 2; ++n) { \
        if constexpr (F8) { asm volatile("v_mfma_scale_f32_16x16x128_f8f6f4 %0, %1, %2, %0, %3, %3 op_sel_hi:[0,0,0]" : "+v"(acc[ai][bj][m][n]) : "v"(Bt##8[n]), "v"(At##8[m]), "v"(sc1)); }     \
        else { _Pragma("unroll") for (int k = 0; k < 2; ++k) acc[ai][bj][m][n] = __builtin_amdgcn_mfma_f32_16x16x32_bf16(Bt[n][k], At[m][k], acc[ai][bj][m][n], 0, 0, 0); } } \
        __builtin_amdgcn_s_setprio(0); } while (0)
#define PG8_WAIT_V(n) asm volatile("s_waitcnt vmcnt(" #n ")" ::: "memory")
#define PG8_WAIT_L(n) asm volatile("s_waitcnt lgkmcnt(" #n ")" ::: "memory")
#define PG8_BAR __builtin_amdgcn_s_barrier()
#define PG8_SCHED __builtin_amdgcn_sched_barrier(0)
    Unit cur, nxt; int ui = 0;
    if (!S.next(0, cur)) return;
    f32x4 acc[2][2][4][2];
#pragma unroll
    for (int a = 0; a < 2; ++a)
#pragma unroll
        for (int b = 0; b < 2; ++b)
#pragma unroll
            for (int m = 0; m < 4; ++m)
#pragma unroll
                for (int n = 0; n < 2; ++n) acc[a][b][m][n] = (f32x4){0.f, 0.f, 0.f, 0.f};
    const int sc1 = 0x7f7f7f7f;
    bf16x8 At[4][2], B0[2][2], B1[2][2]; i32x8 At8[4], B08[2], B18[2];
    const char* cA = cur.A; const char* cB = cur.B;
    S.a_ready(cur);
    if constexpr (SP2) {
        PG8_STAGE(PG8_SB(0, 0), cB, voffB); PG8_STAGE(PG8_SB(0, 1), cB + hstepB, voffB); PG8_STAGE(PG8_SA(0, 0), cA, voffA); PG8_STAGE(PG8_SA(0, 1), cA + hstep, voffA);
        if (wr == 1) PG8_BAR;
        PG8_WAIT_V(2); PG8_BAR;
        PG8_STAGE(PG8_SB(1, 0), cB + kstepB, voffB); PG8_STAGE(PG8_SA(1, 0), cA + kstep, voffA); PG8_STAGE(PG8_SB(1, 1), cB + hstepB + kstepB, voffB);
        PG8_WAIT_V(6); PG8_BAR;
    } else {
        PG8_STAGE(PG8_SB(0, 0), cB, voffB); PG8_STAGE(PG8_SA(0, 0), cA, voffA); PG8_STAGE(PG8_SB(0, 1), cB + hstepB, voffB); PG8_STAGE(PG8_SA(0, 1), cA + hstep, voffA);
        if (wr == 1) PG8_BAR;
        PG8_WAIT_V(4); PG8_BAR;
        PG8_STAGE(PG8_SB(1, 0), cB + kstepB, voffB); PG8_STAGE(PG8_SA(1, 0), cA + kstep, voffA); PG8_STAGE(PG8_SB(1, 1), cB + hstepB + kstepB, voffB);
        PG8_WAIT_V(6); PG8_BAR;
    }
    for (;;) {
        const bool has_next = S.next(ui + 1, nxt);
        const char* nA = has_next ? nxt.A : cA; const char* nB = has_next ? nxt.B : cB;
        for (int t = 0; t < nt; t += 2) {
            const bool last = (t == nt - 2);
            const char* a1 = cA + (size_t)(t + 1) * kstep;
            const char* a2 = last ? nA : cA + (size_t)(t + 2) * kstep; const char* b2 = last ? nB : cB + (size_t)(t + 2) * kstepB;
            const char* a3 = a2 + kstep; const char* b3 = b2 + kstepB;
            if (last && has_next) S.a_ready(nxt);
            if constexpr (SP2) {
            PG8_LDB(B0, 0, 0); PG8_LDB(B1, 0, 1); PG8_SCHED; PG8_LDA(At, 0, 0); PG8_STAGE(PG8_SA(1, 1), a1 + hstep, voffA);
            PG8_WAIT_V(8); PG8_WAIT_L(0); PG8_BAR; PG8_MMA(0, 0, At, B0); PG8_MMA(0, 1, At, B1); PG8_BAR; PG8_SCHED;
            PG8_LDA(At, 0, 1); PG8_STAGE(PG8_SB(0, 0), b2, voffB); PG8_STAGE(PG8_SB(0, 1), b2 + hstepB, voffB); PG8_STAGE(PG8_SA(0, 0), a2, voffA);
            PG8_WAIT_V(8); PG8_WAIT_L(0); PG8_BAR; PG8_MMA(1, 0, At, B0); PG8_MMA(1, 1, At, B1); PG8_BAR; PG8_SCHED;
            PG8_LDB(B0, 1, 0); PG8_LDB(B1, 1, 1); PG8_SCHED; PG8_LDA(At, 1, 0); PG8_STAGE(PG8_SA(0, 1), a2 + hstep, voffA);
            PG8_WAIT_V(8); PG8_WAIT_L(0); PG8_BAR; PG8_MMA(0, 0, At, B0); PG8_MMA(0, 1, At, B1); PG8_BAR; PG8_SCHED;
            PG8_LDA(At, 1, 1); PG8_STAGE(PG8_SB(1, 0), b3, voffB); PG8_STAGE(PG8_SB(1, 1), b3 + hstepB, voffB); PG8_STAGE(PG8_SA(1, 0), a3, voffA);
            PG8_WAIT_V(8); PG8_WAIT_L(0); PG8_BAR; PG8_MMA(1, 0, At, B0); PG8_MMA(1, 1, At, B1); PG8_BAR; PG8_SCHED;
            } else {
            PG8_LDB(B0, 0, 0); PG8_SCHED; PG8_LDA(At, 0, 0); PG8_STAGE(PG8_SA(1, 1), a1 + hstep, voffA);
            PG8_WAIT_L(8); PG8_BAR; PG8_WAIT_L(0); PG8_MMA(0, 0, At, B0); PG8_BAR; PG8_SCHED;
            PG8_LDB(B1, 0, 1); PG8_STAGE(PG8_SB(0, 0), b2, voffB);
            PG8_BAR; PG8_WAIT_L(0); PG8_MMA(0, 1, At, B1); PG8_BAR;
            PG8_LDA(At, 0, 1); PG8_STAGE(PG8_SA(0, 0), a2, voffA);
            PG8_BAR; PG8_WAIT_L(0); PG8_MMA(1, 0, At, B0); PG8_BAR; PG8_SCHED;
            PG8_STAGE(PG8_SB(0, 1), b2 + hstepB, voffB);
            PG8_WAIT_V(6); PG8_BAR; PG8_MMA(1, 1, At, B1); PG8_BAR;
            PG8_LDB(B0, 1, 0); PG8_SCHED; PG8_LDA(At, 1, 0); PG8_STAGE(PG8_SA(0, 1), a2 + hstep, voffA);
            PG8_WAIT_L(8); PG8_BAR; PG8_WAIT_L(0); PG8_MMA(0, 0, At, B0); PG8_BAR; PG8_SCHED;
            PG8_LDB(B1, 1, 1); PG8_STAGE(PG8_SB(1, 0), b3, voffB);
            PG8_BAR; PG8_WAIT_L(0); PG8_MMA(0, 1, At, B1); PG8_BAR;
            PG8_LDA(At, 1, 1); PG8_STAGE(PG8_SA(1, 0), a3, voffA);
            PG8_BAR; PG8_WAIT_L(0); PG8_MMA(1, 0, At, B0); PG8_BAR; PG8_SCHED;
            PG8_STAGE(PG8_SB(1, 1), b3 + hstepB, voffB);
            PG8_WAIT_V(6); PG8_BAR; PG8_MMA(1, 1, At, B1); PG8_BAR;
            }
        }
        if constexpr (ALIGN_EPI) { if (wr == 0) PG8_BAR; }
        if constexpr (F8) { asm volatile("s_nop 15\n\ts_nop 15" ::: "memory"); }
        if constexpr (!Epi::AFTER_DRAIN) { const int le_ = fresh_lane(); E(acc, cur, wr, wc, le_ & 15, le_ >> 4); S.done(cur); }
        if (!has_next) break;
#pragma unroll
        for (int a = 0; a < 2; ++a)
#pragma unroll
            for (int b = 0; b < 2; ++b)
#pragma unroll
                for (int m = 0; m < 4; ++m)
#pragma unroll
                    for (int n = 0; n < 2; ++n) acc[a][b][m][n] = (f32x4){0.f, 0.f, 0.f, 0.f};
        if constexpr (F8) { asm volatile("s_nop 7" ::: "memory"); }
        cur = nxt; cA = nA; cB = nB; ++ui;
        if constexpr (ALIGN_EPI) { if (wr == 1) PG8_BAR; }
    }
    PG8_WAIT_V(0);
    if constexpr (!ALIGN_EPI) { if (wr == 0) PG8_BAR; }
    PG8_BAR;
    if constexpr (Epi::AFTER_DRAIN) { E.fused(acc, cur, wr, wc, fr, fq, lds, wid, lane); S.done(cur); }
#undef PG8_SA
#undef PG8_SB
#undef PG8_STAGE
#undef PG8_LDA
#undef PG8_LDB
#undef PG8_MMA
#undef PG8_WAIT_V
#undef PG8_WAIT_L
#undef PG8_BAR
#undef PG8_SCHED
}

}

namespace attn {
constexpr int D = 128; constexpr float THR = 8.f; constexpr bool WSKIP = false;
constexpr float SCALE = 0.08838834764831845f;
constexpr int NW = 8, QBLK = 32, KVBLK = 64, QB = NW * QBLK;
constexpr int DV = 256;
constexpr int SHM_V = KVBLK * DV * 2, SHM_K = KVBLK * D * 2;
constexpr int LDS_BYTES = 2 * SHM_V + 2 * SHM_K + NW * 64 * 4;

using bf16 = __hip_bfloat16;
typedef short bf16x8 __attribute__((ext_vector_type(8)));
typedef short s16x4 __attribute__((ext_vector_type(4)));
typedef float f32x16 __attribute__((ext_vector_type(16)));
typedef float f32x4 __attribute__((ext_vector_type(4)));
typedef unsigned u32x4 __attribute__((ext_vector_type(4)));
template <class A, class Bt> struct same_t { static constexpr bool v = false; };
template <class A> struct same_t<A, A> { static constexpr bool v = true; };

#define KSWZ(row, colB) ((row) * 256 + ((colB) ^ (((row) & 7) << 4)))
#define SBAR() __builtin_amdgcn_sched_barrier(0)
__device__ __forceinline__ int v_st(int k, int c) { const int kk = (k & ~0xC) | ((k & 4) << 1) | ((k & 8) >> 1); return ((kk >> 3) * 4 + (c >> 5)) * 512 + ((kk & 7) * 32 + (c & 31)) * 2; }
__device__ __forceinline__ int v_rd_base(int lane) { return ((lane & 3) << 3) | (((lane >> 2) & 3) << 6) | (((lane >> 4) & 1) << 5) | (((lane >> 5) & 1) << 8); }
constexpr int v_rd_off(int d0, int ks, int half) { return d0 * 512 + ks * 4096 + half * 2048; }
__device__ __forceinline__ int crow(int r, int hi) { return (r & 3) + 8 * (r >> 2) + 4 * hi; }
__device__ __forceinline__ unsigned cvtpk(float lo, float hi) {
    unsigned r; asm volatile("v_cvt_pk_bf16_f32 %0, %1, %2" : "=v"(r) : "v"(lo), "v"(hi)); return r;
}
__device__ __forceinline__ bf16x8 pack8(f32x4 a, f32x4 b) {
    u32x4 w = {cvtpk(a[0], a[1]), cvtpk(a[2], a[3]), cvtpk(b[0], b[1]), cvtpk(b[2], b[3])};
    return *reinterpret_cast<bf16x8*>(&w);
}
template <class T> __device__ __forceinline__ bf16x8 load8(const T* p) {
    if constexpr (same_t<T, float>::v) { return pack8(*(const f32x4*)p, *(const f32x4*)(p + 4)); }
    else { return *reinterpret_cast<const bf16x8*>(p); }
}
__device__ __forceinline__ void mask_tile(f32x16& p0, f32x16& p1, int dq, unsigned W) {
    const float NEG = -__builtin_inff();
#pragma unroll
    for (int r = 0; r < 16; ++r) {
        const int c = (r & 3) + 8 * (r >> 2);
        if ((unsigned)(dq - c) >= W) p0[r] = NEG;
        if ((unsigned)(dq - c - 32) >= W) p1[r] = NEG;
    }
}
__device__ __forceinline__ void partialSM(f32x16& p0, f32x16& p1, float& m_reg, float& mn, float& alpha) {
    float pmax = p0[0]; for (int r = 1; r < 16; ++r) pmax = fmaxf(pmax, p0[r]); for (int r = 0; r < 16; ++r) pmax = fmaxf(pmax, p1[r]);
    { auto rr = __builtin_amdgcn_permlane32_swap(__float_as_uint(pmax), __float_as_uint(pmax), false, false);
      pmax = fmaxf(__uint_as_float(rr[0]), __uint_as_float(rr[1])); }
    constexpr float C2 = 1.4426950408889634f * SCALE;
    if (__builtin_expect(__all((pmax - m_reg) * SCALE <= THR), 1)) { mn = m_reg; alpha = 1.f; }
    else { mn = fmaxf(m_reg, pmax); alpha = __builtin_amdgcn_exp2f((m_reg - mn) * C2); m_reg = mn; }
    const float mnL = -mn * C2;
    for (int r = 0; r < 16; ++r) p0[r] = fmaf(p0[r], C2, mnL); for (int r = 0; r < 16; ++r) p1[r] = fmaf(p1[r], C2, mnL);
    for (int r = 0; r < 16; ++r) p0[r] = __builtin_amdgcn_exp2f(p0[r]);
}
__device__ __forceinline__ void finishSM(f32x16& p0, f32x16& p1, float alpha, float& l_reg, bf16x8& pa0, bf16x8& pa1, bf16x8& pa2, bf16x8& pa3) {
    for (int r = 0; r < 16; ++r) p1[r] = __builtin_amdgcn_exp2f(p1[r]);
    float ps = 0; for (int r = 0; r < 16; ++r) ps += p0[r]; for (int r = 0; r < 16; ++r) ps += p1[r];
    { auto rr = __builtin_amdgcn_permlane32_swap(__float_as_uint(ps), __float_as_uint(ps), false, false);
      ps = __uint_as_float(rr[0]) + __uint_as_float(rr[1]); }
    l_reg = l_reg * alpha + ps;
#define PK4(P, B_, OUT) do { unsigned a0 = cvtpk(P[B_+0], P[B_+1]), a1 = cvtpk(P[B_+2], P[B_+3]);                          \
        unsigned b0 = cvtpk(P[B_+4], P[B_+5]), b1 = cvtpk(P[B_+6], P[B_+7]);                                             \
        auto r0 = __builtin_amdgcn_permlane32_swap(a0, b0, false, false); auto r1 = __builtin_amdgcn_permlane32_swap(a1, b1, false, false); \
        u32x4 w = {r0[0], r1[0], r0[1], r1[1]}; OUT = *reinterpret_cast<bf16x8*>(&w); } while (0)
    PK4(p0, 0, pa0); PK4(p0, 8, pa1); PK4(p1, 0, pa2); PK4(p1, 8, pa3);
#undef PK4
}
template <int KB, bool SK>
__device__ __forceinline__ void qkt(f32x16& p0, f32x16& p1, const char* K_lds, int r32, int hi, const bf16x8* qr, bool act) {
    if (SK && !act) { const float NEG = -__builtin_inff();
#pragma unroll
        for (int r = 0; r < 16; ++r) { p0[r] = NEG; p1[r] = NEG; } return; }
    p0 = f32x16{}; p1 = f32x16{};
    const char* kb[4];
#pragma unroll
    for (int dd = 0; dd < 4; ++dd) kb[dd] = K_lds + KB * SHM_K + KSWZ(r32, (dd * 16 + hi * 8) * 2);
#pragma unroll
    for (int d0 = 0; d0 < 8; ++d0) { const char* a = kb[d0 & 3] + (d0 >> 2) * 128;
        bf16x8 b0 = *reinterpret_cast<const bf16x8*>(a);
        bf16x8 b1 = *reinterpret_cast<const bf16x8*>(a + 32 * 256);
        p0 = __builtin_amdgcn_mfma_f32_32x32x16_bf16(b0, qr[d0], p0, 0, 0, 0);
        p1 = __builtin_amdgcn_mfma_f32_32x32x16_bf16(b1, qr[d0], p1, 0, 0, 0); }
}


#define AT2_LAS __attribute__((address_space(3)))
template <int VB>
__device__ __forceinline__ void pv_tile8(f32x16* o, const AT2_LAS char* vb, bf16x8 pa0, bf16x8 pa1, bf16x8 pa2, bf16x8 pa3) {
#define TRR(off) __builtin_amdgcn_ds_read_tr16_b64_v4i16((AT2_LAS s16x4*)(vb + (off)))
#pragma unroll
    for (int d0 = 0; d0 < 8; ++d0) { const int b_ = VB * SHM_V + d0 * 512;
        const s16x4 l0 = TRR(b_), h0 = TRR(b_ + 4096), l1 = TRR(b_ + 8192), h1 = TRR(b_ + 12288), l2 = TRR(b_ + 16384), h2 = TRR(b_ + 20480), l3 = TRR(b_ + 24576), h3 = TRR(b_ + 28672);
        o[d0] = __builtin_amdgcn_mfma_f32_32x32x16_bf16(pa0, (bf16x8){l0[0], l0[1], l0[2], l0[3], h0[0], h0[1], h0[2], h0[3]}, o[d0], 0, 0, 0);
        o[d0] = __builtin_amdgcn_mfma_f32_32x32x16_bf16(pa1, (bf16x8){l1[0], l1[1], l1[2], l1[3], h1[0], h1[1], h1[2], h1[3]}, o[d0], 0, 0, 0);
        o[d0] = __builtin_amdgcn_mfma_f32_32x32x16_bf16(pa2, (bf16x8){l2[0], l2[1], l2[2], l2[3], h2[0], h2[1], h2[2], h2[3]}, o[d0], 0, 0, 0);
        o[d0] = __builtin_amdgcn_mfma_f32_32x32x16_bf16(pa3, (bf16x8){l3[0], l3[1], l3[2], l3[3], h3[0], h3[1], h3[2], h3[3]}, o[d0], 0, 0, 0); }
#undef TRR
}
__device__ __forceinline__ void softmax_main(f32x16& p0, f32x16& p1, float& m_reg, float& alpha, float& ps) {
    float pmax = p0[0];
#pragma unroll
    for (int r = 1; r < 16; ++r) pmax = fmaxf(pmax, p0[r]);
#pragma unroll
    for (int r = 0; r < 16; ++r) pmax = fmaxf(pmax, p1[r]);
    { auto rr = __builtin_amdgcn_permlane32_swap(__float_as_uint(pmax), __float_as_uint(pmax), false, false);
      pmax = fmaxf(__uint_as_float(rr[0]), __uint_as_float(rr[1])); }
    constexpr float C2 = 1.4426950408889634f * SCALE;
    const bool keep = __all((pmax - m_reg) * SCALE <= THR);
    const float mn = keep ? m_reg : fmaxf(m_reg, pmax);
    alpha = __builtin_amdgcn_exp2f((m_reg - mn) * C2);
    m_reg = mn;
    const float mnL = -mn * C2;
#pragma unroll
    for (int r = 0; r < 16; ++r) { p0[r] = __builtin_amdgcn_exp2f(fmaf(p0[r], C2, mnL)); p1[r] = __builtin_amdgcn_exp2f(fmaf(p1[r], C2, mnL)); }
    float s = 0.f;
#pragma unroll
    for (int r = 0; r < 16; ++r) s += p0[r];
#pragma unroll
    for (int r = 0; r < 16; ++r) s += p1[r];
    { auto rr = __builtin_amdgcn_permlane32_swap(__float_as_uint(s), __float_as_uint(s), false, false);
      ps = __uint_as_float(rr[0]) + __uint_as_float(rr[1]); }
}
__device__ __forceinline__ void pack_p(const f32x16& p0, const f32x16& p1, bf16x8& pa0, bf16x8& pa1, bf16x8& pa2, bf16x8& pa3) {
#define PK4(P, B_, OUT) do { unsigned a0 = cvtpk(P[B_+0], P[B_+1]), a1 = cvtpk(P[B_+2], P[B_+3]);                          \
        unsigned b0 = cvtpk(P[B_+4], P[B_+5]), b1 = cvtpk(P[B_+6], P[B_+7]);                                             \
        auto r0 = __builtin_amdgcn_permlane32_swap(a0, b0, false, false); auto r1 = __builtin_amdgcn_permlane32_swap(a1, b1, false, false); \
        u32x4 w = {r0[0], r1[0], r0[1], r1[1]}; OUT = *reinterpret_cast<bf16x8*>(&w); } while (0)
    PK4(p0, 0, pa0); PK4(p0, 8, pa1); PK4(p1, 0, pa2); PK4(p1, 8, pa3);
#undef PK4
}
struct Block2 { const bf16* Q; const bf16* K; const bf16* V; unsigned short* O; int P0; };
__device__ __forceinline__ void attn_block2(const Block2& cur, char* lds, AT2_LAS unsigned char* L, const int wave_id) {
    const int lane = fresh_lane(), wid = wave_id, r32 = lane & 31, hi = lane >> 5;
    const int NT = (cur.P0 + QB - 1) / KVBLK + 1;
    const int qlo = cur.P0 + wid * QBLK;
    char* K_lds = lds + 2 * SHM_V;
    float* ws = (float*)(lds + 2 * SHM_V + 2 * SHM_K) + wid * 64; float* li_l = ws, * al_l = ws + 32;
#define AT2_GLDS(g, l) __builtin_amdgcn_global_load_lds((const unsigned*)(g), (AT2_LAS unsigned*)(l), 16, 0, 0)
#define AT2_DMA_K(t, b) do { const char* kg_ = (const char*)cur.K + (size_t)(t) * (KVBLK * D * 2); const unsigned ln_ = (unsigned)fresh_lane(), kr0 = 8u * wid + (ln_ >> 4), kr1 = kr0 + 4u; \
        const unsigned koff0 = kr0 * 256u + (((ln_ & 15u) ^ (kr0 & 7u)) << 4), koff1 = kr1 * 256u + (((ln_ & 15u) ^ (kr1 & 7u)) << 4); \
        AT2_GLDS(kg_ + koff0, L + 2 * SHM_V + (b) * SHM_K + (2 * wid) * 1024); AT2_GLDS(kg_ + koff1, L + 2 * SHM_V + (b) * SHM_K + (2 * wid + 1) * 1024); } while (0)
#define AT2_DMA_V(t, b) do { const char* vg_ = (const char*)cur.V + (size_t)(t) * (KVBLK * DV * 2); const unsigned ln_ = (unsigned)fresh_lane(), kkv = 8u * wid + ((ln_ & 31u) >> 2); \
        const unsigned keyv = (kkv & ~0xCu) | ((kkv & 4u) << 1) | ((kkv & 8u) >> 1), voff = keyv * 512u + (ln_ >> 5) * 64u + (ln_ & 3u) * 16u; \
        _Pragma("unroll") for (int i_ = 0; i_ < 4; ++i_) AT2_GLDS(vg_ + i_ * 128 + voff, L + (b) * SHM_V + (4 * wid + i_) * 1024); } while (0)
    bf16x8 qr[8];
#pragma unroll
    for (int d0 = 0; d0 < 8; ++d0) qr[d0] = load8<bf16>(cur.Q + (size_t)(wid * QBLK + r32) * D + d0 * 16 + hi * 8);
    AT2_DMA_K(0, 0);
    float m_reg = -1e30f, l_reg = 0; f32x16 o[8] = {};
    f32x16 p0, p1; float al, ps; bf16x8 pa0, pa1, pa2, pa3;
#define RESC(a) do { if (__any((a) < 1.f)) { const int lr_ = fresh_lane(), hr_ = lr_ >> 5; if (hr_ == 0) al_l[lr_ & 31] = (a); asm volatile("s_waitcnt lgkmcnt(0)" ::: "memory");              \
                     for (int d_ = 0; d_ < 8; ++d_) for (int r = 0; r < 16; ++r) o[d_][r] *= al_l[crow(r, hr_)]; } } while (0)
#define AT2_TRR(off) __builtin_amdgcn_ds_read_tr16_b64_v4i16((AT2_LAS s16x4*)(vb + (off)))
#define MX3(a_, b_, c_) fmaxf(fmaxf((a_), (b_)), (c_))
#define AT2_PK4(P, B_, OUT) do { unsigned a0_ = cvtpk(P[B_+0], P[B_+1]), a1_ = cvtpk(P[B_+2], P[B_+3]), b0_ = cvtpk(P[B_+4], P[B_+5]), b1_ = cvtpk(P[B_+6], P[B_+7]); \
        auto r0_ = __builtin_amdgcn_permlane32_swap(a0_, b0_, false, false); auto r1_ = __builtin_amdgcn_permlane32_swap(a1_, b1_, false, false); \
        u32x4 w_ = {r0_[0], r1_[0], r0_[1], r1_[1]}; OUT = *reinterpret_cast<bf16x8*>(&w_); } while (0)
#define AT2_PV_SM(VB) do { const AT2_LAS char* vb = (const AT2_LAS char*)L + v_rd_base(fresh_lane()); constexpr float C2_ = 1.4426950408889634f * SCALE; float mxa, mxb, mnL_; ps = 0.f; s16x4 fl0, fh0, fl1, fh1, fl2, fh2, fl3, fh3; \
        constexpr int vbo_ = (VB) * SHM_V; \
        fl0 = AT2_TRR(vbo_ + 0); fh0 = AT2_TRR(vbo_ + 4096); \
        fl1 = AT2_TRR(vbo_ + 8192); fh1 = AT2_TRR(vbo_ + 12288); \
        fl2 = AT2_TRR(vbo_ + 16384); fh2 = AT2_TRR(vbo_ + 20480); \
        fl3 = AT2_TRR(vbo_ + 24576); fh3 = AT2_TRR(vbo_ + 28672); \
        SBAR(); \
        o[0] = __builtin_amdgcn_mfma_f32_32x32x16_bf16(pa0, (bf16x8){fl0[0], fl0[1], fl0[2], fl0[3], fh0[0], fh0[1], fh0[2], fh0[3]}, o[0], 0, 0, 0); fl0 = AT2_TRR(vbo_ + 512); fh0 = AT2_TRR(vbo_ + 4608); mxa = MX3(p0[0], p0[1], p0[2]); mxb = MX3(p1[0], p1[1], p1[2]); mxa = MX3(mxa, p0[3], p0[4]); mxb = MX3(mxb, p1[3], p1[4]); SBAR(); \
        o[0] = __builtin_amdgcn_mfma_f32_32x32x16_bf16(pa1, (bf16x8){fl1[0], fl1[1], fl1[2], fl1[3], fh1[0], fh1[1], fh1[2], fh1[3]}, o[0], 0, 0, 0); fl1 = AT2_TRR(vbo_ + 8704); fh1 = AT2_TRR(vbo_ + 12800); mxa = MX3(mxa, p0[5], p0[6]); mxb = MX3(mxb, p1[5], p1[6]); mxa = MX3(mxa, p0[7], p0[8]); mxb = MX3(mxb, p1[7], p1[8]); SBAR(); \
        o[0] = __builtin_amdgcn_mfma_f32_32x32x16_bf16(pa2, (bf16x8){fl2[0], fl2[1], fl2[2], fl2[3], fh2[0], fh2[1], fh2[2], fh2[3]}, o[0], 0, 0, 0); fl2 = AT2_TRR(vbo_ + 16896); fh2 = AT2_TRR(vbo_ + 20992); mxa = MX3(mxa, p0[9], p0[10]); mxb = MX3(mxb, p1[9], p1[10]); mxa = MX3(mxa, p0[11], p0[12]); mxb = MX3(mxb, p1[11], p1[12]); SBAR(); \
        o[0] = __builtin_amdgcn_mfma_f32_32x32x16_bf16(pa3, (bf16x8){fl3[0], fl3[1], fl3[2], fl3[3], fh3[0], fh3[1], fh3[2], fh3[3]}, o[0], 0, 0, 0); fl3 = AT2_TRR(vbo_ + 25088); fh3 = AT2_TRR(vbo_ + 29184); mxa = MX3(mxa, p0[13], p0[14]); mxb = MX3(mxb, p1[13], p1[14]); mxa = fmaxf(mxa, p0[15]); mxb = fmaxf(mxb, p1[15]); SBAR(); \
        o[1] = __builtin_amdgcn_mfma_f32_32x32x16_bf16(pa0, (bf16x8){fl0[0], fl0[1], fl0[2], fl0[3], fh0[0], fh0[1], fh0[2], fh0[3]}, o[1], 0, 0, 0); fl0 = AT2_TRR(vbo_ + 1024); fh0 = AT2_TRR(vbo_ + 5120); mxa = fmaxf(mxa, mxb); { auto rr_ = __builtin_amdgcn_permlane32_swap(__float_as_uint(mxa), __float_as_uint(mxa), false, false); mxa = fmaxf(__uint_as_float(rr_[0]), __uint_as_float(rr_[1])); } SBAR(); \
        o[1] = __builtin_amdgcn_mfma_f32_32x32x16_bf16(pa1, (bf16x8){fl1[0], fl1[1], fl1[2], fl1[3], fh1[0], fh1[1], fh1[2], fh1[3]}, o[1], 0, 0, 0); fl1 = AT2_TRR(vbo_ + 9216); fh1 = AT2_TRR(vbo_ + 13312); { const bool keep_ = __all((mxa - m_reg) * SCALE <= THR); const float mn_ = keep_ ? m_reg : fmaxf(m_reg, mxa); al = __builtin_amdgcn_exp2f((m_reg - mn_) * C2_); m_reg = mn_; mnL_ = -mn_ * C2_; } SBAR(); \
        o[1] = __builtin_amdgcn_mfma_f32_32x32x16_bf16(pa2, (bf16x8){fl2[0], fl2[1], fl2[2], fl2[3], fh2[0], fh2[1], fh2[2], fh2[3]}, o[1], 0, 0, 0); fl2 = AT2_TRR(vbo_ + 17408); fh2 = AT2_TRR(vbo_ + 21504); p0[0] = __builtin_amdgcn_exp2f(fmaf(p0[0], C2_, mnL_)); p0[1] = __builtin_amdgcn_exp2f(fmaf(p0[1], C2_, mnL_)); SBAR(); \
        o[1] = __builtin_amdgcn_mfma_f32_32x32x16_bf16(pa3, (bf16x8){fl3[0], fl3[1], fl3[2], fl3[3], fh3[0], fh3[1], fh3[2], fh3[3]}, o[1], 0, 0, 0); fl3 = AT2_TRR(vbo_ + 25600); fh3 = AT2_TRR(vbo_ + 29696); ps += p0[0]; ps += p0[1]; p0[2] = __builtin_amdgcn_exp2f(fmaf(p0[2], C2_, mnL_)); SBAR(); \
        o[2] = __builtin_amdgcn_mfma_f32_32x32x16_bf16(pa0, (bf16x8){fl0[0], fl0[1], fl0[2], fl0[3], fh0[0], fh0[1], fh0[2], fh0[3]}, o[2], 0, 0, 0); fl0 = AT2_TRR(vbo_ + 1536); fh0 = AT2_TRR(vbo_ + 5632); ps += p0[2]; p0[3] = __builtin_amdgcn_exp2f(fmaf(p0[3], C2_, mnL_)); p0[4] = __builtin_amdgcn_exp2f(fmaf(p0[4], C2_, mnL_)); SBAR(); \
        o[2] = __builtin_amdgcn_mfma_f32_32x32x16_bf16(pa1, (bf16x8){fl1[0], fl1[1], fl1[2], fl1[3], fh1[0], fh1[1], fh1[2], fh1[3]}, o[2], 0, 0, 0); fl1 = AT2_TRR(vbo_ + 9728); fh1 = AT2_TRR(vbo_ + 13824); ps += p0[3]; ps += p0[4]; p0[5] = __builtin_amdgcn_exp2f(fmaf(p0[5], C2_, mnL_)); SBAR(); \
        o[2] = __builtin_amdgcn_mfma_f32_32x32x16_bf16(pa2, (bf16x8){fl2[0], fl2[1], fl2[2], fl2[3], fh2[0], fh2[1], fh2[2], fh2[3]}, o[2], 0, 0, 0); fl2 = AT2_TRR(vbo_ + 17920); fh2 = AT2_TRR(vbo_ + 22016); ps += p0[5]; p0[6] = __builtin_amdgcn_exp2f(fmaf(p0[6], C2_, mnL_)); p0[7] = __builtin_amdgcn_exp2f(fmaf(p0[7], C2_, mnL_)); SBAR(); \
        o[2] = __builtin_amdgcn_mfma_f32_32x32x16_bf16(pa3, (bf16x8){fl3[0], fl3[1], fl3[2], fl3[3], fh3[0], fh3[1], fh3[2], fh3[3]}, o[2], 0, 0, 0); fl3 = AT2_TRR(vbo_ + 26112); fh3 = AT2_TRR(vbo_ + 30208); ps += p0[6]; ps += p0[7]; p0[8] = __builtin_amdgcn_exp2f(fmaf(p0[8], C2_, mnL_)); SBAR(); \
        o[3] = __builtin_amdgcn_mfma_f32_32x32x16_bf16(pa0, (bf16x8){fl0[0], fl0[1], fl0[2], fl0[3], fh0[0], fh0[1], fh0[2], fh0[3]}, o[3], 0, 0, 0); fl0 = AT2_TRR(vbo_ + 2048); fh0 = AT2_TRR(vbo_ + 6144); ps += p0[8]; p0[9] = __builtin_amdgcn_exp2f(fmaf(p0[9], C2_, mnL_)); p0[10] = __builtin_amdgcn_exp2f(fmaf(p0[10], C2_, mnL_)); SBAR(); \
        o[3] = __builtin_amdgcn_mfma_f32_32x32x16_bf16(pa1, (bf16x8){fl1[0], fl1[1], fl1[2], fl1[3], fh1[0], fh1[1], fh1[2], fh1[3]}, o[3], 0, 0, 0); fl1 = AT2_TRR(vbo_ + 10240); fh1 = AT2_TRR(vbo_ + 14336); ps += p0[9]; ps += p0[10]; p0[11] = __builtin_amdgcn_exp2f(fmaf(p0[11], C2_, mnL_)); SBAR(); \
        o[3] = __builtin_amdgcn_mfma_f32_32x32x16_bf16(pa2, (bf16x8){fl2[0], fl2[1], fl2[2], fl2[3], fh2[0], fh2[1], fh2[2], fh2[3]}, o[3], 0, 0, 0); fl2 = AT2_TRR(vbo_ + 18432); fh2 = AT2_TRR(vbo_ + 22528); ps += p0[11]; p0[12] = __builtin_amdgcn_exp2f(fmaf(p0[12], C2_, mnL_)); p0[13] = __builtin_amdgcn_exp2f(fmaf(p0[13], C2_, mnL_)); SBAR(); \
        o[3] = __builtin_amdgcn_mfma_f32_32x32x16_bf16(pa3, (bf16x8){fl3[0], fl3[1], fl3[2], fl3[3], fh3[0], fh3[1], fh3[2], fh3[3]}, o[3], 0, 0, 0); fl3 = AT2_TRR(vbo_ + 26624); fh3 = AT2_TRR(vbo_ + 30720); ps += p0[12]; ps += p0[13]; p0[14] = __builtin_amdgcn_exp2f(fmaf(p0[14], C2_, mnL_)); SBAR(); \
        o[4] = __builtin_amdgcn_mfma_f32_32x32x16_bf16(pa0, (bf16x8){fl0[0], fl0[1], fl0[2], fl0[3], fh0[0], fh0[1], fh0[2], fh0[3]}, o[4], 0, 0, 0); fl0 = AT2_TRR(vbo_ + 2560); fh0 = AT2_TRR(vbo_ + 6656); ps += p0[14]; p0[15] = __builtin_amdgcn_exp2f(fmaf(p0[15], C2_, mnL_)); p1[0] = __builtin_amdgcn_exp2f(fmaf(p1[0], C2_, mnL_)); SBAR(); \
        o[4] = __builtin_amdgcn_mfma_f32_32x32x16_bf16(pa1, (bf16x8){fl1[0], fl1[1], fl1[2], fl1[3], fh1[0], fh1[1], fh1[2], fh1[3]}, o[4], 0, 0, 0); fl1 = AT2_TRR(vbo_ + 10752); fh1 = AT2_TRR(vbo_ + 14848); ps += p0[15]; ps += p1[0]; p1[1] = __builtin_amdgcn_exp2f(fmaf(p1[1], C2_, mnL_)); SBAR(); \
        o[4] = __builtin_amdgcn_mfma_f32_32x32x16_bf16(pa2, (bf16x8){fl2[0], fl2[1], fl2[2], fl2[3], fh2[0], fh2[1], fh2[2], fh2[3]}, o[4], 0, 0, 0); fl2 = AT2_TRR(vbo_ + 18944); fh2 = AT2_TRR(vbo_ + 23040); ps += p1[1]; p1[2] = __builtin_amdgcn_exp2f(fmaf(p1[2], C2_, mnL_)); p1[3] = __builtin_amdgcn_exp2f(fmaf(p1[3], C2_, mnL_)); SBAR(); \
        o[4] = __builtin_amdgcn_mfma_f32_32x32x16_bf16(pa3, (bf16x8){fl3[0], fl3[1], fl3[2], fl3[3], fh3[0], fh3[1], fh3[2], fh3[3]}, o[4], 0, 0, 0); fl3 = AT2_TRR(vbo_ + 27136); fh3 = AT2_TRR(vbo_ + 31232); ps += p1[2]; ps += p1[3]; p1[4] = __builtin_amdgcn_exp2f(fmaf(p1[4], C2_, mnL_)); SBAR(); \
        o[5] = __builtin_amdgcn_mfma_f32_32x32x16_bf16(pa0, (bf16x8){fl0[0], fl0[1], fl0[2], fl0[3], fh0[0], fh0[1], fh0[2], fh0[3]}, o[5], 0, 0, 0); fl0 = AT2_TRR(vbo_ + 3072); fh0 = AT2_TRR(vbo_ + 7168); ps += p1[4]; p1[5] = __builtin_amdgcn_exp2f(fmaf(p1[5], C2_, mnL_)); p1[6] = __builtin_amdgcn_exp2f(fmaf(p1[6], C2_, mnL_)); SBAR(); \
        o[5] = __builtin_amdgcn_mfma_f32_32x32x16_bf16(pa1, (bf16x8){fl1[0], fl1[1], fl1[2], fl1[3], fh1[0], fh1[1], fh1[2], fh1[3]}, o[5], 0, 0, 0); fl1 = AT2_TRR(vbo_ + 11264); fh1 = AT2_TRR(vbo_ + 15360); ps += p1[5]; ps += p1[6]; p1[7] = __builtin_amdgcn_exp2f(fmaf(p1[7], C2_, mnL_)); SBAR(); \
        o[5] = __builtin_amdgcn_mfma_f32_32x32x16_bf16(pa2, (bf16x8){fl2[0], fl2[1], fl2[2], fl2[3], fh2[0], fh2[1], fh2[2], fh2[3]}, o[5], 0, 0, 0); fl2 = AT2_TRR(vbo_ + 19456); fh2 = AT2_TRR(vbo_ + 23552); ps += p1[7]; p1[8] = __builtin_amdgcn_exp2f(fmaf(p1[8], C2_, mnL_)); p1[9] = __builtin_amdgcn_exp2f(fmaf(p1[9], C2_, mnL_)); SBAR(); \
        o[5] = __builtin_amdgcn_mfma_f32_32x32x16_bf16(pa3, (bf16x8){fl3[0], fl3[1], fl3[2], fl3[3], fh3[0], fh3[1], fh3[2], fh3[3]}, o[5], 0, 0, 0); fl3 = AT2_TRR(vbo_ + 27648); fh3 = AT2_TRR(vbo_ + 31744); ps += p1[8]; ps += p1[9]; p1[10] = __builtin_amdgcn_exp2f(fmaf(p1[10], C2_, mnL_)); SBAR(); \
        o[6] = __builtin_amdgcn_mfma_f32_32x32x16_bf16(pa0, (bf16x8){fl0[0], fl0[1], fl0[2], fl0[3], fh0[0], fh0[1], fh0[2], fh0[3]}, o[6], 0, 0, 0); fl0 = AT2_TRR(vbo_ + 3584); fh0 = AT2_TRR(vbo_ + 7680); ps += p1[10]; p1[11] = __builtin_amdgcn_exp2f(fmaf(p1[11], C2_, mnL_)); p1[12] = __builtin_amdgcn_exp2f(fmaf(p1[12], C2_, mnL_)); SBAR(); \
        o[6] = __builtin_amdgcn_mfma_f32_32x32x16_bf16(pa1, (bf16x8){fl1[0], fl1[1], fl1[2], fl1[3], fh1[0], fh1[1], fh1[2], fh1[3]}, o[6], 0, 0, 0); fl1 = AT2_TRR(vbo_ + 11776); fh1 = AT2_TRR(vbo_ + 15872); ps += p1[11]; ps += p1[12]; p1[13] = __builtin_amdgcn_exp2f(fmaf(p1[13], C2_, mnL_)); SBAR(); \
        o[6] = __builtin_amdgcn_mfma_f32_32x32x16_bf16(pa2, (bf16x8){fl2[0], fl2[1], fl2[2], fl2[3], fh2[0], fh2[1], fh2[2], fh2[3]}, o[6], 0, 0, 0); fl2 = AT2_TRR(vbo_ + 19968); fh2 = AT2_TRR(vbo_ + 24064); ps += p1[13]; p1[14] = __builtin_amdgcn_exp2f(fmaf(p1[14], C2_, mnL_)); p1[15] = __builtin_amdgcn_exp2f(fmaf(p1[15], C2_, mnL_)); SBAR(); \
        o[6] = __builtin_amdgcn_mfma_f32_32x32x16_bf16(pa3, (bf16x8){fl3[0], fl3[1], fl3[2], fl3[3], fh3[0], fh3[1], fh3[2], fh3[3]}, o[6], 0, 0, 0); fl3 = AT2_TRR(vbo_ + 28160); fh3 = AT2_TRR(vbo_ + 32256); ps += p1[14]; ps += p1[15]; { auto rr_ = __builtin_amdgcn_permlane32_swap(__float_as_uint(ps), __float_as_uint(ps), false, false); ps = __uint_as_float(rr_[0]) + __uint_as_float(rr_[1]); } SBAR(); \
        o[7] = __builtin_amdgcn_mfma_f32_32x32x16_bf16(pa0, (bf16x8){fl0[0], fl0[1], fl0[2], fl0[3], fh0[0], fh0[1], fh0[2], fh0[3]}, o[7], 0, 0, 0); AT2_PK4(p0, 0, pa0); SBAR(); \
        o[7] = __builtin_amdgcn_mfma_f32_32x32x16_bf16(pa1, (bf16x8){fl1[0], fl1[1], fl1[2], fl1[3], fh1[0], fh1[1], fh1[2], fh1[3]}, o[7], 0, 0, 0); AT2_PK4(p0, 8, pa1); SBAR(); \
        o[7] = __builtin_amdgcn_mfma_f32_32x32x16_bf16(pa2, (bf16x8){fl2[0], fl2[1], fl2[2], fl2[3], fh2[0], fh2[1], fh2[2], fh2[3]}, o[7], 0, 0, 0); AT2_PK4(p1, 0, pa2); SBAR(); \
        o[7] = __builtin_amdgcn_mfma_f32_32x32x16_bf16(pa3, (bf16x8){fl3[0], fl3[1], fl3[2], fl3[3], fh3[0], fh3[1], fh3[2], fh3[3]}, o[7], 0, 0, 0); AT2_PK4(p1, 8, pa3); SBAR(); \
        } while (0)
#define AT2_LDK(p_) (*reinterpret_cast<const bf16x8*>(p_))
#define AT2_QKT_DMA(t, b) do { \
        const unsigned lq_ = (unsigned)fresh_lane(); const int r32_ = (int)(lq_ & 31u), hi_ = (int)(lq_ >> 5); \
        const char* vg_ = (const char*)cur.V + (size_t)(t) * (KVBLK * DV * 2); \
        const unsigned kkv_ = 8u * wid + ((lq_ & 31u) >> 2), keyv_ = (kkv_ & ~0xCu) | ((kkv_ & 4u) << 1) | ((kkv_ & 8u) >> 1), voff_ = keyv_ * 512u + (lq_ >> 5) * 64u + (lq_ & 3u) * 16u; \
        const bool hk_ = (t) + 1 < NT; const char* kg_ = (const char*)cur.K + (size_t)((t) + 1) * (KVBLK * D * 2); \
        const unsigned kr0_ = 8u * wid + (lq_ >> 4), koff0_ = kr0_ * 256u + (((lq_ & 15u) ^ (kr0_ & 7u)) << 4), koff1_ = (koff0_ + 1024u) ^ 64u; \
        const char* kq0_ = K_lds + (b) * SHM_K + KSWZ(r32_, (0 * 16 + hi_ * 8) * 2); const char* kq1_ = K_lds + (b) * SHM_K + KSWZ(r32_, (1 * 16 + hi_ * 8) * 2); \
        const char* kq2_ = K_lds + (b) * SHM_K + KSWZ(r32_, (2 * 16 + hi_ * 8) * 2); const char* kq3_ = K_lds + (b) * SHM_K + KSWZ(r32_, (3 * 16 + hi_ * 8) * 2); \
        p0 = f32x16{}; p1 = f32x16{}; bf16x8 ka0_, ka1_, kc0_, kc1_; \
        ka0_ = AT2_LDK(kq0_); ka1_ = AT2_LDK(kq0_ + 8192); \
        kc0_ = AT2_LDK(kq1_); kc1_ = AT2_LDK(kq1_ + 8192); p0 = __builtin_amdgcn_mfma_f32_32x32x16_bf16(ka0_, qr[0], p0, 0, 0, 0); p1 = __builtin_amdgcn_mfma_f32_32x32x16_bf16(ka1_, qr[0], p1, 0, 0, 0); SBAR(); AT2_GLDS(vg_ + 0 * 128 + voff_, L + (b) * SHM_V + (4 * wid + 0) * 1024); SBAR(); \
        ka0_ = AT2_LDK(kq2_); ka1_ = AT2_LDK(kq2_ + 8192); p0 = __builtin_amdgcn_mfma_f32_32x32x16_bf16(kc0_, qr[1], p0, 0, 0, 0); p1 = __builtin_amdgcn_mfma_f32_32x32x16_bf16(kc1_, qr[1], p1, 0, 0, 0); SBAR(); AT2_GLDS(vg_ + 1 * 128 + voff_, L + (b) * SHM_V + (4 * wid + 1) * 1024); SBAR(); \
        kc0_ = AT2_LDK(kq3_); kc1_ = AT2_LDK(kq3_ + 8192); p0 = __builtin_amdgcn_mfma_f32_32x32x16_bf16(ka0_, qr[2], p0, 0, 0, 0); p1 = __builtin_amdgcn_mfma_f32_32x32x16_bf16(ka1_, qr[2], p1, 0, 0, 0); SBAR(); AT2_GLDS(vg_ + 2 * 128 + voff_, L + (b) * SHM_V + (4 * wid + 2) * 1024); SBAR(); \
        ka0_ = AT2_LDK(kq0_ + 128); ka1_ = AT2_LDK(kq0_ + 128 + 8192); p0 = __builtin_amdgcn_mfma_f32_32x32x16_bf16(kc0_, qr[3], p0, 0, 0, 0); p1 = __builtin_amdgcn_mfma_f32_32x32x16_bf16(kc1_, qr[3], p1, 0, 0, 0); SBAR(); AT2_GLDS(vg_ + 3 * 128 + voff_, L + (b) * SHM_V + (4 * wid + 3) * 1024); SBAR(); \
        kc0_ = AT2_LDK(kq1_ + 128); kc1_ = AT2_LDK(kq1_ + 128 + 8192); p0 = __builtin_amdgcn_mfma_f32_32x32x16_bf16(ka0_, qr[4], p0, 0, 0, 0); p1 = __builtin_amdgcn_mfma_f32_32x32x16_bf16(ka1_, qr[4], p1, 0, 0, 0); SBAR(); if (hk_) AT2_GLDS(kg_ + koff0_, L + 2 * SHM_V + (1 - (b)) * SHM_K + (2 * wid) * 1024); SBAR(); \
        ka0_ = AT2_LDK(kq2_ + 128); ka1_ = AT2_LDK(kq2_ + 128 + 8192); p0 = __builtin_amdgcn_mfma_f32_32x32x16_bf16(kc0_, qr[5], p0, 0, 0, 0); p1 = __builtin_amdgcn_mfma_f32_32x32x16_bf16(kc1_, qr[5], p1, 0, 0, 0); SBAR(); if (hk_) AT2_GLDS(kg_ + koff1_, L + 2 * SHM_V + (1 - (b)) * SHM_K + (2 * wid + 1) * 1024); SBAR(); \
        kc0_ = AT2_LDK(kq3_ + 128); kc1_ = AT2_LDK(kq3_ + 128 + 8192); p0 = __builtin_amdgcn_mfma_f32_32x32x16_bf16(ka0_, qr[6], p0, 0, 0, 0); p1 = __builtin_amdgcn_mfma_f32_32x32x16_bf16(ka1_, qr[6], p1, 0, 0, 0); SBAR(); \
        p0 = __builtin_amdgcn_mfma_f32_32x32x16_bf16(kc0_, qr[7], p0, 0, 0, 0); p1 = __builtin_amdgcn_mfma_f32_32x32x16_bf16(kc1_, qr[7], p1, 0, 0, 0); SBAR(); \
        } while (0)
#define AT2_STEP(t, b, HASPV) do { \
        asm volatile("s_waitcnt vmcnt(0)" ::: "memory"); __builtin_amdgcn_s_barrier(); asm volatile("" ::: "memory");     \
        SBAR(); AT2_QKT_DMA((t), (b)); \
        { const int kb_ = (t) * KVBLK; if (kb_ + KVBLK - 1 > qlo) { const int lm_ = fresh_lane(); mask_tile(p0, p1, qlo + (lm_ & 31) - 4 * (lm_ >> 5) - kb_, 0x7fffffffu); } } \
        SBAR(); \
        if (HASPV) { AT2_PV_SM(1 - (b)); } else { softmax_main(p0, p1, m_reg, al, ps); } \
        SBAR(); \
        RESC(al); l_reg = l_reg * al + ps; if (!(HASPV)) pack_p(p0, p1, pa0, pa1, pa2, pa3); } while (0)
    AT2_STEP(0, 0, false);
    for (int t = 1; t + 1 < NT; t += 2) { AT2_STEP(t, 1, true); AT2_STEP(t + 1, 0, true); }
    AT2_STEP(NT - 1, 1, true);
    asm volatile("s_waitcnt vmcnt(0)" ::: "memory"); __builtin_amdgcn_s_barrier(); asm volatile("" ::: "memory");
    pv_tile8<1>(o, (const AT2_LAS char*)L + v_rd_base(fresh_lane()), pa0, pa1, pa2, pa3);
    const int l2_ = fresh_lane(), he_ = l2_ >> 5;
    if (he_ == 0) li_l[l2_ & 31] = l_reg; asm volatile("s_waitcnt lgkmcnt(0)" ::: "memory");
    float rli[16];
#pragma unroll
    for (int r = 0; r < 16; ++r) rli[r] = __builtin_amdgcn_rcpf(li_l[crow(r, he_)]);
    const int loff = 4 * (l2_ >> 5) * DV + (l2_ & 31);
    unsigned short* Ow = cur.O + (size_t)(wid * QBLK) * DV + loff;
    const bool even_ = (l2_ & 1) == 0;
#pragma unroll
    for (int r = 0; r < 16; ++r) { const int orow = (r & 3) + 8 * (r >> 2);
#pragma unroll
        for (int d0 = 0; d0 < 8; ++d0) { const float v = o[d0][r] * rli[r]; const float vn = __shfl_xor(v, 1);
            if (even_) *(unsigned*)(Ow + orow * DV + d0 * 32) = cvtpk(v, vn); } }
    __syncthreads();
#undef RESC
#undef AT2_PV_SM
#undef AT2_PK4
#undef MX3
#undef AT2_TRR
#undef AT2_STEP
#undef AT2_QKT_DMA
#undef AT2_LDK
#undef AT2_DMA_K
#undef AT2_DMA_V
#undef AT2_GLDS
}
}

#ifndef MK_N_LAUNCHES
#define MK_N_LAUNCHES 1
#endif
constexpr int N_LAUNCHES = MK_N_LAUNCHES, N_PHASES = 16;
constexpr int NWAVES = 8;

constexpr int S_ = 16384, DM = 2048, FF = 5632, DE = 7168, NE = 8, NHEAD = 8;
constexpr float NORM_EPS = 1e-6f, SUBLN_EPS = 1e-5f;
constexpr float LAMBDA_INIT = 0.35550906759096934f;
constexpr float SA_X = 16.f, SW_GU = 1024.f, SA_H = 16.f, SW_D = 2048.f, SA_HD = 16.f, SW_DD = 2048.f, SA_XD = 16.f, SW_GUD = 1024.f;
constexpr int CAP_ROWS = 2 * S_ + NE * 256;

constexpr size_t MiB = 1u << 20;
constexpr size_t WS_CTL = 0, CTL_ZERO_BYTES = 1 * MiB;
constexpr size_t WS_SS1 = 1 * MiB, WS_SS2 = WS_SS1 + 524288;
constexpr size_t WS_RS0 = 1 * MiB;
constexpr size_t WS_RS1 = 2 * MiB;
constexpr size_t WS_TOKI = WS_RS1 + 65536;
constexpr size_t WS_TOKG = WS_TOKI + 262144;
constexpr size_t WS_ROPE = 3 * MiB;
constexpr size_t WS_WPOOL = 11 * MiB;
constexpr size_t WS_WKVQ = 13 * MiB;
constexpr size_t WS_WO = 37 * MiB;
constexpr size_t WS_WGU = 45 * MiB;
constexpr size_t WS_WD = 89 * MiB;
constexpr size_t WS_WEGU = 111 * MiB;
constexpr size_t WS_WED = 559 * MiB;
constexpr size_t WS_X1 = 783 * MiB;
constexpr size_t WS_H = 911 * MiB;
constexpr size_t WS_SCR = 975 * MiB;
constexpr size_t WS_HID = WS_SCR, WS_MG = WS_SCR + 176 * MiB;
constexpr size_t WS_H2 = WS_SCR, WS_K16 = WS_SCR + 64 * MiB, WS_V16 = WS_SCR + 128 * MiB, WS_Q16 = WS_SCR + 192 * MiB, WS_O32 = WS_SCR + 256 * MiB, WS_ON = WS_SCR + 512 * MiB;
constexpr size_t WS_HIDE = WS_SCR, WS_XG = WS_SCR + 476 * MiB, WS_Y = WS_SCR + 476 * MiB;
constexpr size_t WS_YPART = WS_SCR + 300 * MiB;
constexpr size_t WS_END = WS_SCR + 748 * MiB;
static_assert((size_t)CAP_ROWS * DE * 2 == 476 * MiB && (size_t)CAP_ROWS * DM * 4 == 272 * MiB, "expert buffers");
constexpr int CW_TMO = 0, CW_BAR = 4096, CW_CNT = 8192, CW_AQ = 9216, CW_KS = 12288, CW_BC = 16384;

constexpr int RING_BYTES = 131072, LDSCTL_OFF = 151552, MISC_OFF = LDSCTL_OFF + 320, LDS_BYTES = 155648;


#define GAS __attribute__((address_space(1)))
#define LAS __attribute__((address_space(3)))
typedef unsigned short bf16;
typedef unsigned v4u __attribute__((ext_vector_type(4)));
typedef unsigned v2u __attribute__((ext_vector_type(2)));
typedef float f32x4 __attribute__((ext_vector_type(4)));
typedef float f32x2 __attribute__((ext_vector_type(2)));
typedef int i32x4 __attribute__((ext_vector_type(4)));
typedef GAS unsigned gu32;
#define RLX_AGENT __ATOMIC_RELAXED, __HIP_MEMORY_SCOPE_AGENT
#define LDS_WAIT() asm volatile("s_waitcnt lgkmcnt(0)" ::: "memory")
#define VM_WAIT() asm volatile("s_waitcnt vmcnt(0)" ::: "memory")
__device__ __forceinline__ unsigned pk2(float lo, float hi) { return pg8::cvt_pk_bf16(lo, hi); }

#define XB_TMO      128
#define XB_XCNT(j)  (256  + 64 * (j))
#define XB_XSUB(j)  (1280 + 64 * (j))
#define XB_XGEN(j)  (2304 + 64 * (j))
#define XB_TOP      3328
#define XB_TOPGEN   3392
#define XCD_BAR_WORDS 3456
#define XB_SPIN_CAP (1u << 18)

__device__ __forceinline__ unsigned xb_ld(unsigned* p)              { return __hip_atomic_load(p, __ATOMIC_RELAXED, __HIP_MEMORY_SCOPE_AGENT); }
__device__ __forceinline__ unsigned xb_add(unsigned* p, unsigned v) { return __hip_atomic_fetch_add(p, v, __ATOMIC_RELAXED, __HIP_MEMORY_SCOPE_AGENT); }
__device__ __forceinline__ unsigned xb_xcc_id() { return (unsigned)__builtin_amdgcn_s_getreg((3 << 11) | 20) & 0xFu; }
#define XB_SPIN(cond, bar) do { unsigned _sp = 0; while (cond) { __builtin_amdgcn_s_sleep(1); \
    if ((++_sp & 255u) == 0u) { if (xb_ld(&(bar)[XB_TMO])) break; if (_sp > XB_SPIN_CAP) { atomicAdd(&(bar)[XB_TMO], 1u); break; } } } } while (0)

struct XcdBarrier {
    unsigned* bar; unsigned x; int w;
    volatile LAS unsigned* st;
};

__device__ __forceinline__ XcdBarrier xcd_barrier_post(unsigned* bar, volatile LAS unsigned* st, int wave_id) {
    XcdBarrier b; b.bar = bar; b.x = xb_xcc_id(); b.st = st; b.w = wave_id;
    if (threadIdx.x == 0) (void)xb_add(&bar[XB_XCNT(b.x)], 1u);
    return b;
}
__device__ __forceinline__ void xcd_barrier_complete(unsigned* bar, unsigned x, unsigned& nloc, unsigned& nx) {
    const unsigned G = gridDim.x * gridDim.y * gridDim.z;
    unsigned sum, cnt, mine, sp = 0u;
    for (;;) {
        sum = 0u; cnt = 0u; mine = 0u;
#pragma unroll
        for (unsigned j = 0; j < 16; ++j) { const unsigned c = xb_ld(&bar[XB_XCNT(j)]); sum += c; cnt += (c > 0u) ? 1u : 0u; mine = (j == x) ? c : mine; }
        if (sum == G) break;
        __builtin_amdgcn_s_sleep(1);
        if ((++sp & 255u) == 0u) { if (xb_ld(&bar[XB_TMO])) break; if (sp > XB_SPIN_CAP) { atomicAdd(&bar[XB_TMO], 1u); break; } }
    }
    nloc = mine > 0u ? mine : 1u; nx = cnt > 0u ? cnt : 1u;
}

__device__ __forceinline__ void xcd_barrier(const XcdBarrier& b) {
    asm volatile("s_waitcnt vmcnt(0)" ::: "memory");
    __syncthreads();
    if (b.w == 0 && fresh_lane() == 0) {
        unsigned* bar = b.bar;
        __builtin_amdgcn_s_waitcnt(0);
        unsigned nloc = b.st[0], nx = b.st[1];
        if (nloc == 0u) { xcd_barrier_complete(bar, b.x, nloc, nx); b.st[0] = nloc; b.st[1] = nx; }
        const unsigned old = xb_add(&bar[XB_XSUB(b.x)], 1u);
        const unsigned gen = old / nloc;
        if (old + 1u == (gen + 1u) * nloc) {
            __builtin_amdgcn_fence(__ATOMIC_RELEASE, "agent");
            asm volatile("s_waitcnt vmcnt(0)" ::: "memory");
            const unsigned og = xb_add(&bar[XB_TOP], 1u);
            const unsigned tg = og / nx;
            if (og + 1u == (tg + 1u) * nx) xb_add(&bar[XB_TOPGEN], 1u);
            else XB_SPIN(xb_ld(&bar[XB_TOPGEN]) == tg, bar);
            __builtin_amdgcn_fence(__ATOMIC_ACQUIRE, "agent");
            xb_add(&bar[XB_XGEN(b.x)], 1u);
            asm volatile("s_waitcnt vmcnt(0)" ::: "memory");
        } else {
            XB_SPIN(xb_ld(&bar[XB_XGEN(b.x)]) == gen, bar);
            __builtin_amdgcn_fence(__ATOMIC_ACQUIRE, "agent");
            asm volatile("s_waitcnt vmcnt(0)" ::: "memory");
        }
    }
    __syncthreads();
}

__device__ __forceinline__ float wave_sum(float v) {
#pragma unroll
    for (int o = 1; o < 64; o <<= 1) v += __shfl_xor(v, o);
    return v;
}
__device__ __forceinline__ float dot4(f32x4 a, f32x4 b) { return (a.x * b.x + a.y * b.y) + (a.z * b.z + a.w * b.w); }

__device__ __forceinline__ void tr_item(const float* W, int N, int k0, int n0, bf16* dst, int ldd, LAS float* scr, int lane) {
    const float* src = W + (size_t)(k0 + (lane >> 4)) * N + n0 + 4 * (lane & 15);
    f32x4 v[16];
#pragma unroll
    for (int i = 0; i < 16; ++i) v[i] = *(const f32x4*)(src + (size_t)(4 * i) * N);
#pragma unroll
    for (int i = 0; i < 16; ++i) { LAS float* p = scr + (4 * i + (lane >> 4)) * 65 + 4 * (lane & 15); p[0] = v[i].x; p[1] = v[i].y; p[2] = v[i].z; p[3] = v[i].w; }
    LDS_WAIT(); asm volatile("" ::: "memory");
    const int c = lane & 7;
#pragma unroll
    for (int q = 0; q < 8; ++q) { const int n = (lane >> 3) + 8 * q; const LAS float* s = scr + (8 * c) * 65 + n;
        v4u o; o.x = pk2(s[0 * 65], s[1 * 65]); o.y = pk2(s[2 * 65], s[3 * 65]); o.z = pk2(s[4 * 65], s[5 * 65]); o.w = pk2(s[6 * 65], s[7 * 65]);
        *(v4u*)(dst + (size_t)n * ldd + 8 * c) = o; }
    LDS_WAIT(); asm volatile("" ::: "memory");
}
__device__ __forceinline__ void tr_item8(const float* W, int N, int k0, int n0, unsigned char* dst, int ldd, float scale, LAS float* scr, int lane) {
    const float* src = W + (size_t)(k0 + (lane >> 4)) * N + n0 + 4 * (lane & 15);
    f32x4 v[16];
#pragma unroll
    for (int i = 0; i < 16; ++i) v[i] = *(const f32x4*)(src + (size_t)(4 * i) * N);
#pragma unroll
    for (int i = 0; i < 16; ++i) { LAS float* p = scr + (4 * i + (lane >> 4)) * 65 + 4 * (lane & 15); p[0] = v[i].x * scale; p[1] = v[i].y * scale; p[2] = v[i].z * scale; p[3] = v[i].w * scale; }
    LDS_WAIT(); asm volatile("" ::: "memory");
    const int c = lane & 3;
#pragma unroll
    for (int q = 0; q < 4; ++q) { const int n = (lane >> 2) + 16 * q; const LAS float* s = scr + (16 * c) * 65 + n;
        v4u o; o.x = pg8::pk4_fp8(s[0 * 65], s[1 * 65], s[2 * 65], s[3 * 65]); o.y = pg8::pk4_fp8(s[4 * 65], s[5 * 65], s[6 * 65], s[7 * 65]);
        o.z = pg8::pk4_fp8(s[8 * 65], s[9 * 65], s[10 * 65], s[11 * 65]); o.w = pg8::pk4_fp8(s[12 * 65], s[13 * 65], s[14 * 65], s[15 * 65]);
        *(v4u*)(dst + (size_t)n * ldd + 16 * c) = o; }
    LDS_WAIT(); asm volatile("" ::: "memory");
}
template <int MODE> __device__ __forceinline__ void tr_matrix_item8(const float* W, int K, int N, unsigned char* dstbase, float scale, int r, LAS float* scr, int lane) {
    const int nblk = N / 64, kb = r / nblk, nb = r % nblk, k0 = 64 * kb, n0 = 64 * nb;
    int row;
    if (MODE == 0) row = n0;
    else if (MODE == 1) row = 256 * (n0 >> 7) + (n0 & 127);
    else row = 256 * (n0 >> 7) + 128 + (n0 & 127);
    tr_item8(W, N, k0, n0, dstbase + (size_t)row * K + k0, K, scale, scr, lane);
}
template <int MODE> __device__ __forceinline__ void tr_matrix_item(const float* W, int K, int N, bf16* dstbase, int r, LAS float* scr, int lane) {
    const int nblk = N / 64, kb = r / nblk, nb = r % nblk, k0 = 64 * kb, n0 = 64 * nb;
    int row;
    if (MODE == 0) row = n0;
    else if (MODE == 1) row = 256 * (n0 >> 7) + (n0 & 127);
    else if (MODE == 2) row = 256 * (n0 >> 7) + 128 + (n0 & 127);
    else { const int h = n0 >> 8, rr = n0 & 255, map = rr >> 7, d = rr & 127; row = 256 * h + (d < 64 ? map * 64 : 128 + map * 64); }
    tr_item(W, N, k0, n0, dstbase + (size_t)row * K + k0, K, scr, lane);
}
struct TrDesc { const float* src; unsigned char* dst; const float* gain; int N, pitch, f8; float scale; };
__device__ __forceinline__ void tr_load(const TrDesc& d, f32x4 (&v)[16], int lane) {
    const float* s = d.src + (size_t)(lane >> 4) * d.N + 4 * (lane & 15);
#pragma unroll
    for (int i = 0; i < 16; ++i) v[i] = __builtin_nontemporal_load((const f32x4*)(s + (size_t)(4 * i) * d.N));
}
__device__ __forceinline__ void tr_store(const TrDesc& d, const f32x4 (&v)[16], LAS float* scr, int lane) {
    if (d.gain) {
#pragma unroll
        for (int i = 0; i < 16; ++i) { const float gk = d.gain[4 * i + (lane >> 4)] * d.scale; LAS float* p = scr + (4 * i + (lane >> 4)) * 65 + 4 * (lane & 15); p[0] = v[i].x * gk; p[1] = v[i].y * gk; p[2] = v[i].z * gk; p[3] = v[i].w * gk; }
    } else {
#pragma unroll
        for (int i = 0; i < 16; ++i) { LAS float* p = scr + (4 * i + (lane >> 4)) * 65 + 4 * (lane & 15); p[0] = v[i].x * d.scale; p[1] = v[i].y * d.scale; p[2] = v[i].z * d.scale; p[3] = v[i].w * d.scale; }
    }
    LDS_WAIT(); asm volatile("" ::: "memory");
    if (d.f8) {
        const int c = lane & 3;
#pragma unroll
        for (int q = 0; q < 4; ++q) { const int n = (lane >> 2) + 16 * q; const LAS float* s = scr + (16 * c) * 65 + n;
            v4u o; o.x = pg8::pk4_fp8(s[0 * 65], s[1 * 65], s[2 * 65], s[3 * 65]); o.y = pg8::pk4_fp8(s[4 * 65], s[5 * 65], s[6 * 65], s[7 * 65]);
            o.z = pg8::pk4_fp8(s[8 * 65], s[9 * 65], s[10 * 65], s[11 * 65]); o.w = pg8::pk4_fp8(s[12 * 65], s[13 * 65], s[14 * 65], s[15 * 65]);
            __builtin_nontemporal_store(o, (v4u*)(d.dst + (size_t)n * d.pitch + 16 * c)); }
    } else {
        const int c = lane & 7;
#pragma unroll
        for (int q = 0; q < 8; ++q) { const int n = (lane >> 3) + 8 * q; const LAS float* s = scr + (8 * c) * 65 + n;
            v4u o; o.x = pk2(s[0 * 65], s[1 * 65]); o.y = pk2(s[2 * 65], s[3 * 65]); o.z = pk2(s[4 * 65], s[5 * 65]); o.w = pk2(s[6 * 65], s[7 * 65]);
            __builtin_nontemporal_store(o, (v4u*)(d.dst + (size_t)n * d.pitch + 16 * c)); }
    }
    LDS_WAIT(); asm volatile("" ::: "memory");
}
__device__ __forceinline__ void tr_load_w(const TrDesc& d, f32x4 (&v)[16], int lane) {
    const float* s = d.src + (size_t)(lane >> 3) * d.N + 4 * (lane & 7);
#pragma unroll
    for (int i = 0; i < 16; ++i) v[i] = __builtin_nontemporal_load((const f32x4*)(s + (size_t)(8 * i) * d.N));
}
__device__ __forceinline__ void tr_store_w(const TrDesc& d, const f32x4 (&v)[16], LAS float* scr, int lane) {
#pragma unroll
    for (int i = 0; i < 16; ++i) { LAS float* p = scr + (8 * i + (lane >> 3)) * 33 + 4 * (lane & 7); p[0] = v[i].x * d.scale; p[1] = v[i].y * d.scale; p[2] = v[i].z * d.scale; p[3] = v[i].w * d.scale; }
    LDS_WAIT(); asm volatile("" ::: "memory");
    const int c = lane & 7;
#pragma unroll
    for (int q = 0; q < 4; ++q) { const int n = (lane >> 3) + 8 * q; const LAS float* s = scr + (16 * c) * 33 + n;
        v4u o; o.x = pg8::pk4_fp8(s[0 * 33], s[1 * 33], s[2 * 33], s[3 * 33]); o.y = pg8::pk4_fp8(s[4 * 33], s[5 * 33], s[6 * 33], s[7 * 33]);
        o.z = pg8::pk4_fp8(s[8 * 33], s[9 * 33], s[10 * 33], s[11 * 33]); o.w = pg8::pk4_fp8(s[12 * 33], s[13 * 33], s[14 * 33], s[15 * 33]);
        __builtin_nontemporal_store(o, (v4u*)(d.dst + (size_t)n * d.pitch + 16 * c)); }
    LDS_WAIT(); asm volatile("" ::: "memory");
}
__device__ __forceinline__ int tr_row(int mode, int n0) {
    if (mode == 0) return n0;
    if (mode == 1) return 256 * (n0 >> 7) + (n0 & 127);
    if (mode == 2) return 256 * (n0 >> 7) + 128 + (n0 & 127);
    const int h = n0 >> 8, rr = n0 & 255, map = rr >> 7, dd = rr & 127; return 256 * h + (dd < 64 ? map * 64 : 128 + map * 64);
}
__device__ __forceinline__ void sincos_pi(double r, double& s, double& c) {
    const double x2 = r * r;
    double ps = -1.0 / 25852016738884976640000.0;
    ps = ps * x2 + 1.0 / 51090942171709440000.0;  ps = ps * x2 - 1.0 / 121645100408832000.0; ps = ps * x2 + 1.0 / 355687428096000.0; ps = ps * x2 - 1.0 / 1307674368000.0;
    ps = ps * x2 + 1.0 / 6227020800.0; ps = ps * x2 - 1.0 / 39916800.0; ps = ps * x2 + 1.0 / 362880.0; ps = ps * x2 - 1.0 / 5040.0; ps = ps * x2 + 1.0 / 120.0; ps = ps * x2 - 1.0 / 6.0; ps = ps * x2 + 1.0;
    s = ps * r;
    double pc = 1.0 / 1124000727777607680000.0;
    pc = pc * x2 - 1.0 / 2432902008176640000.0; pc = pc * x2 + 1.0 / 6402373705728000.0; pc = pc * x2 - 1.0 / 20922789888000.0; pc = pc * x2 + 1.0 / 87178291200.0;
    pc = pc * x2 - 1.0 / 479001600.0; pc = pc * x2 + 1.0 / 3628800.0; pc = pc * x2 - 1.0 / 40320.0; pc = pc * x2 + 1.0 / 720.0; pc = pc * x2 - 1.0 / 24.0; pc = pc * x2 + 0.5; pc = pc * x2 - 1.0;
    c = -pc;
}
__device__ __forceinline__ void rms_row_bf16(const float* xrow, const float* ga, bf16* oa, const float* gb, bf16* ob, int lane) {
    const f32x4* xr = (const f32x4*)xrow + lane; f32x4 v[8]; float s = 0.f;
#pragma unroll
    for (int j = 0; j < 8; ++j) { v[j] = xr[64 * j]; s += dot4(v[j], v[j]); }
    const float rstd = 1.0f / sqrtf(wave_sum(s) * (1.0f / DM) + NORM_EPS);
#pragma unroll
    for (int j = 0; j < 8; ++j) { const f32x4 g = ((const f32x4*)ga)[lane + 64 * j]; const f32x4 y = v[j] * rstd * g; v2u o; o.x = pk2(y.x, y.y); o.y = pk2(y.z, y.w); ((v2u*)oa)[lane + 64 * j] = o; }
    if (ob) {
#pragma unroll
        for (int j = 0; j < 8; ++j) { const f32x4 g = ((const f32x4*)gb)[lane + 64 * j]; const f32x4 y = v[j] * rstd * g; v2u o; o.x = pk2(y.x, y.y); o.y = pk2(y.z, y.w); ((v2u*)ob)[lane + 64 * j] = o; }
    }
}

template <int W> __device__ __forceinline__ void pool_rows(const float* xc  , const LAS float* rs, const f32x4 gn, const int t0, bf16* mg) {
    f32x4 prev[16];
#pragma unroll
    for (int i = 0; i < 16; ++i) { const int tt = t0 - 16 + i; const bool need = i >= 16 - (W - 1);
        prev[i] = (need && tt >= 0) ? *(const f32x4*)(xc + (size_t)tt * DM) * rs[i - 1 < 0 ? 0 : i - 1] * gn : (f32x4){0.f, 0.f, 0.f, 0.f}; }
    f32x4 sum = {0.f, 0.f, 0.f, 0.f};
#pragma unroll
    for (int i = 16 - (W - 1); i < 16; ++i) sum += prev[i];
    for (int blk = 0; blk < 4; ++blk) {
        f32x4 cur[16];
#pragma unroll
        for (int i = 0; i < 16; ++i) cur[i] = *(const f32x4*)(xc + (size_t)(t0 + 16 * blk + i) * DM) * rs[15 + 16 * blk + i] * gn;
#pragma unroll
        for (int i = 0; i < 16; ++i) { const int t = t0 + 16 * blk + i; sum += cur[i];
            const float inv = 1.0f / (float)((t + 1 < W) ? t + 1 : W); const f32x4 m = sum * inv - cur[i];
            v2u o; o.x = pk2(m.x, m.y); o.y = pk2(m.z, m.w); *(v2u*)(mg + (size_t)(16 * blk + i) * 512) = o;
            sum -= (i - (W - 1) >= 0) ? cur[i - (W - 1) >= 0 ? i - (W - 1) : 0] : prev[(16 + i - (W - 1)) & 15]; }
#pragma unroll
        for (int i = 0; i < 16; ++i) prev[i] = cur[i];
    }
}

struct Args { const void* in[25]; float* out; unsigned char* ws; int ph_lo, ph_hi, li, pad; };
__global__ void __launch_bounds__(NWAVES * 64, 2) yoco_fwd(Args args) {
    extern __shared__ __attribute__((aligned(16))) unsigned char lds[];
    LAS unsigned char* const L = (LAS unsigned char*)lds;
    volatile LAS unsigned* const MISC = (volatile LAS unsigned*)(L + MISC_OFF);
    const int wave = __builtin_amdgcn_readfirstlane((int)threadIdx.x >> 6);
    const int G = gridDim.x, gw = blockIdx.x * NWAVES + wave, NGW = G * NWAVES;
    unsigned char* const ws = args.ws;
    gu32* const ctl = (gu32*)(ws + WS_CTL);
    const float* x = (const float*)args.in[0]; const int* positions = (const int*)args.in[1]; const float* norm_mix_a = (const float*)args.in[2]; const float* pool_w = (const float*)args.in[3];
    const float* pool_scale = (const float*)args.in[4]; const float* norm_kv = (const float*)args.in[5]; const float* w_k = (const float*)args.in[6]; const float* w_v = (const float*)args.in[7];
    const float* norm_mix_b = (const float*)args.in[8]; const float* w_q = (const float*)args.in[9]; const float* lq1 = (const float*)args.in[10]; const float* lk1 = (const float*)args.in[11];
    const float* lq2 = (const float*)args.in[12]; const float* lk2 = (const float*)args.in[13]; const float* subln_w = (const float*)args.in[14]; const float* w_o = (const float*)args.in[15];
    const float* norm_ffn = (const float*)args.in[16]; const float* d_gate = (const float*)args.in[17]; const float* d_up = (const float*)args.in[18]; const float* d_down = (const float*)args.in[19];
    const float* router_w = (const float*)args.in[20]; const float* m_gate = (const float*)args.in[21]; const float* m_up = (const float*)args.in[22]; const float* m_down = (const float*)args.in[23];
    const float* norm_final = (const float*)args.in[24];
    float* SS1 = (float*)(ws + WS_SS1); float* SS2 = (float*)(ws + WS_SS2); float* RS1 = (float*)(ws + WS_RS1); i32x4* TOKI = (i32x4*)(ws + WS_TOKI); f32x2* TOKG = (f32x2*)(ws + WS_TOKG); float* ROPE = (float*)(ws + WS_ROPE);
    bf16* WPOOL = (bf16*)(ws + WS_WPOOL); bf16* WKVQ = (bf16*)(ws + WS_WKVQ); bf16* WO = (bf16*)(ws + WS_WO); bf16* WGU = (bf16*)(ws + WS_WGU); bf16* WD = (bf16*)(ws + WS_WD);
    unsigned char* WEGU8 = ws + WS_WEGU; unsigned char* WED8 = ws + WS_WED; float* X1 = (float*)(ws + WS_X1); bf16* HB = (bf16*)(ws + WS_H);
    bf16* HID = (bf16*)(ws + WS_HID); bf16* MG = (bf16*)(ws + WS_MG); bf16* H2 = (bf16*)(ws + WS_H2); bf16* K16 = (bf16*)(ws + WS_K16); bf16* V16 = (bf16*)(ws + WS_V16); bf16* Q16 = (bf16*)(ws + WS_Q16);
    bf16* O16 = (bf16*)(ws + WS_O32); bf16* ON = (bf16*)(ws + WS_ON); unsigned char* HIDE8 = ws + WS_HIDE; unsigned char* XG8 = ws + WS_XG; bf16* YB = (bf16*)(ws + WS_Y); float* YPART = (float*)(ws + WS_YPART);

    for (int u = threadIdx.x; u < (LDS_BYTES - LDSCTL_OFF) / 4; u += NWAVES * 64) ((LAS unsigned*)(L + LDSCTL_OFF))[u] = 0u;
    __syncthreads();
    XcdBarrier bar; bar.bar = (unsigned*)(ctl + CW_BAR); bar.x = 0; bar.st = nullptr; bar.w = wave;
    if (N_LAUNCHES == 1) bar = xcd_barrier_post((unsigned*)(ctl + CW_BAR), MISC + 8, wave);
#define GRID_BAR(seam) do { if (N_LAUNCHES != 1) { if (wave == 0 && fresh_lane() == 0) __hip_atomic_store(ctl + CW_TMO, 0xBADBA0u | (unsigned)(seam), RLX_AGENT); } else { xcd_barrier(bar); } } while (0)
    const int lo = args.ph_lo, hi = args.ph_hi;
#define FRESH_TID() const int lane = fresh_lane(), tid = wave * 64 + lane; (void)tid; (void)lane
#define IN(k) (lo <= (k) && (k) < hi)
#define BOTH(k) (IN(k) && IN((k) + 1))
#ifndef PROBE_REP_PHASE
#define PROBE_REP_PHASE -1
#endif
#define REPN(k) ((k) == PROBE_REP_PHASE ? 2 : 1)
#define SMALLREP_N(id_) for (int rep_ = 0; rep_ < ((PROBE_REP_PHASE == 100 || PROBE_REP_PHASE == (id_)) ? 2 : 1); ++rep_)

    constexpr int I_POOL = 64, I_SQ = 32 * 32, I_DG = 32 * 88, I_DD = 88 * 32, I_EG = 32 * 112, I_ED = 112 * 32;
    constexpr int N_EARLY = 4 * I_POOL + 4 * I_SQ + 2 * I_DG + I_DD, N_MOE = 16 * I_EG + 8 * I_ED, NITEMS = N_EARLY + N_MOE;
#define TR_SET(W_, K_, N_, DST_, MODE_, F8_, SC_, GAIN_, R_) do { const int nblk_ = (N_) / 64, kb_ = (R_) / nblk_, nb_ = (R_) % nblk_, k0_ = 64 * kb_, n0_ = 64 * nb_; const int es_ = (F8_) ? 1 : 2; \
        d_.src = (W_) + (size_t)k0_ * (N_) + n0_; d_.N = (N_); d_.pitch = (K_) * es_; d_.f8 = (F8_); d_.scale = (SC_); d_.gain = (GAIN_) ? (const float*)(GAIN_) + k0_ : nullptr; d_.dst = (unsigned char*)(DST_) + ((size_t)tr_row(MODE_, n0_) * (K_) + k0_) * es_; } while (0)
#define TR_DECODE(it_) do { int r = (it_) % NITEMS; \
        if (r < 4 * I_POOL) { const int g = r / I_POOL; TR_SET(pool_w + (size_t)g * 512 * 512, 512, 512, WPOOL + (size_t)g * 512 * 512, 0, 0, 1.0f, (const float*)nullptr, r % I_POOL); break; } r -= 4 * I_POOL; \
        if (r < I_SQ) { TR_SET(w_k, DM, DM, WKVQ, 3, 0, 1.0f, norm_kv, r); break; } r -= I_SQ; \
        if (r < I_SQ) { TR_SET(w_v, DM, DM, WKVQ + (size_t)2048 * DM, 0, 0, 1.0f, norm_kv, r); break; } r -= I_SQ; \
        if (r < I_SQ) { TR_SET(w_q, DM, DM, WKVQ + (size_t)4096 * DM, 3, 0, 1.0f, norm_mix_b, r); break; } r -= I_SQ; \
        if (r < I_SQ) { TR_SET(w_o, DM, DM, WO, 0, 0, 1.0f, (const float*)nullptr, r); break; } r -= I_SQ; \
        if (r < I_DG) { TR_SET(d_gate, DM, FF, WGU, 1, 1, SW_GUD, norm_ffn, r); break; } r -= I_DG; \
        if (r < I_DG) { TR_SET(d_up, DM, FF, WGU, 2, 1, SW_GUD, norm_ffn, r); break; } r -= I_DG; \
        if (r < I_DD) { TR_SET(d_down, FF, DM, WD, 0, 0, 1.0f, (const float*)nullptr, r); break; } r -= I_DD; \
        if (r < 8 * I_EG) { const int e = r / I_EG; TR_SET(m_gate + (size_t)e * DM * DE, DM, DE, WEGU8 + (size_t)e * 2 * DE * DM, 1, 1, SW_GU, (const float*)nullptr, r % I_EG); break; } r -= 8 * I_EG; \
        if (r < 8 * I_EG) { const int e = r / I_EG; TR_SET(m_up + (size_t)e * DM * DE, DM, DE, WEGU8 + (size_t)e * 2 * DE * DM, 2, 1, SW_GU, (const float*)nullptr, r % I_EG); break; } r -= 8 * I_EG; \
        { const int e = r / I_ED; TR_SET(m_down + (size_t)e * DE * DM, DE, DM, WED8 + (size_t)e * DM * DE, 0, 1, SW_D, (const float*)nullptr, r % I_ED); } } while (0)
#define TR_RUN_XG(DEC_, LD_, ST_, SCRB_, first_, end_, stride_) do { const int ln_ = fresh_lane(); LAS float* scr = (LAS float*)(L + wave * (SCRB_)); const int NIT_ = (end_), st_ = (stride_); TrDesc dA, dB; f32x4 vA[16], vB[16]; int it = (first_); \
        if (it < NIT_) { { TrDesc& d_ = dA; DEC_(it); } LD_(dA, vA, ln_); \
            for (;;) { int nx = it + st_; bool has = nx < NIT_; \
                { TrDesc& d_ = dB; DEC_(has ? nx : it); } LD_(dB, vB, ln_); \
                ST_(dA, vA, scr, ln_); \
                if (!has) break; \
                it = nx; nx = it + st_; has = nx < NIT_; \
                { TrDesc& d_ = dA; DEC_(has ? nx : it); } LD_(dA, vA, ln_); \
                ST_(dB, vB, scr, ln_); \
                if (!has) break; \
                it = nx; } } } while (0)
#define TR_RUN_X(DEC_, first_, end_, stride_) TR_RUN_XG(DEC_, tr_load, tr_store, 16640, first_, end_, stride_)
#define TR_RUN(first_, end_, stride_) TR_RUN_X(TR_DECODE, first_, end_, stride_)
#define TR_SET_W(W_, K_, N_, DST_, MODE_, SC_, R_) do { const int nblk_ = (N_) / 32, kb_ = (R_) / nblk_, nb_ = (R_) % nblk_, k0_ = 128 * kb_, n0_ = 32 * nb_; \
        const int row_ = tr_row(MODE_, n0_);     \
        d_.src = (W_) + (size_t)k0_ * (N_) + n0_; d_.N = (N_); d_.pitch = 128; d_.f8 = 1; d_.scale = (SC_); d_.gain = nullptr; d_.dst = (unsigned char*)(DST_) + ((size_t)((row_ >> 8) * ((K_) / 128) + kb_) * 256 + (row_ & 255)) * 128; } while (0)
#define TR_DECODE_MOE(it_) do { int r = ((it_) - N_EARLY) % N_MOE; \
        if (r < 8 * I_EG) { const int e = r / I_EG; TR_SET_W(m_gate + (size_t)e * DM * DE, DM, DE, WEGU8 + (size_t)e * 2 * DE * DM, 1, SW_GU, r % I_EG); break; } r -= 8 * I_EG; \
        if (r < 8 * I_EG) { const int e = r / I_EG; TR_SET_W(m_up + (size_t)e * DM * DE, DM, DE, WEGU8 + (size_t)e * 2 * DE * DM, 2, SW_GU, r % I_EG); break; } r -= 8 * I_EG; \
        { const int e = r / I_ED; TR_SET_W(m_down + (size_t)e * DE * DM, DE, DM, WED8 + (size_t)e * DM * DE, 0, SW_D, r % I_ED); } } while (0)
    if (IN(1)) { FRESH_TID();
        SMALLREP_N(101) for (int rc = blockIdx.x; rc < S_ / 64; rc += G) {
            const int t0 = rc * 64;
            LAS float* rs = (LAS float*)(L + 135168);
            for (int jr = wave; jr < 79; jr += NWAVES) { const int tt = t0 - 15 + jr;
                if (tt >= 0) { const f32x4* xr = (const f32x4*)(x + (size_t)tt * DM) + lane; float s = 0.f;
#pragma unroll
                    for (int j = 0; j < 8; ++j) { const f32x4 v = xr[64 * j]; s += dot4(v, v); }
                    s = wave_sum(s); if (lane == 0) rs[jr] = 1.0f / sqrtf(s * (1.0f / DM) + NORM_EPS); } }
            __syncthreads();
            const int c = 4 * tid, g = c >> 9;
            const f32x4 gn = *(const f32x4*)(norm_mix_a + c);
            bf16* mg = MG + ((size_t)g * S_ + t0) * 512 + (c & 511);
            if (g == 0) pool_rows<2>(x + c, rs, gn, t0, mg); else if (g == 1) pool_rows<4>(x + c, rs, gn, t0, mg); else if (g == 2) pool_rows<8>(x + c, rs, gn, t0, mg); else pool_rows<16>(x + c, rs, gn, t0, mg);
            __syncthreads();
        }
        SMALLREP_N(102) for (int idx = blockIdx.x * 512 + tid; idx < S_ * 64; idx += G * 512) {
            const int t = idx >> 6, i = idx & 63;
            double f = 1.0; for (int k = 0; k < i; ++k) f *= 0.8659643233600653;
            const float ang = (float)positions[t] * (float)f;
            const double a = (double)ang, kk = __builtin_rint(a * 0.15915494309189535), r = __builtin_fma(-kk, 6.283185307179586, a);
            double sn, cs; sincos_pi(r, sn, cs);
            f32x2 o; o.x = (float)cs; o.y = (float)sn; ((f32x2*)ROPE)[idx] = o;
        }
        TR_RUN(gw, N_EARLY * REPN(1), NGW);
        if (BOTH(1)) GRID_BAR(1);
    }
    if (IN(2)) { FRESH_TID();
        pg8::GemmOrder S; S.init(S_ / 256, 8, G, (int)blockIdx.x, MG, WPOOL, 512, 1, (size_t)S_ * 512 * 2);
        pg8::EpiResF32N E{x, X1, DM, pool_scale, nullptr, SS1, (LAS float*)(L + RING_BYTES), 1.0f, (unsigned char*)HB, SA_XD};
        pg8::gemm_phase<pg8::EpiResF32N, pg8::GemmOrder, true, true>(L, 512 * 2, S, E, wave);
        if (BOTH(2)) GRID_BAR(2);
    }
    if (IN(4)) { FRESH_TID();
        pg8::GemmOrder S; S.init(S_ / 256, 2 * FF / 256, G, (int)blockIdx.x, HB, WGU, DM / 2, 30, 0); S.rep = REPN(4);
        pg8::EpiSwiGLU E{HID, FF, SS1, 1.0f / DM, NORM_EPS, 1.0f / (SA_XD * SW_GUD)};
        pg8::gemm_phase<pg8::EpiSwiGLU, pg8::GemmOrder, true, true, true>(L, DM, S, E, wave);
        if (BOTH(4)) GRID_BAR(4);
    }
    if (IN(5)) { FRESH_TID();
        pg8::GemmOrder S; S.init(S_ / 256, DM / 256, G, (int)blockIdx.x, HID, WD, FF, 30, 0);
        pg8::EpiResF32N E{X1, X1, DM, nullptr, HB, SS2, (LAS float*)(L + RING_BYTES), 1.0f, nullptr, 0.f};
        pg8::gemm_phase<pg8::EpiResF32N, pg8::GemmOrder, true, true>(L, FF * 2, S, E, wave);
        if (BOTH(5)) GRID_BAR(5);
    }
    if (IN(7)) { FRESH_TID();
        pg8::GemmOrder S; S.init(S_ / 256, 24, G, (int)blockIdx.x, HB, WKVQ, DM, 30, 0); S.rep = REPN(7);
        pg8::EpiKVQ E{K16, V16, Q16, ROPE, S_, SS2, 1.0f / DM, NORM_EPS};
        pg8::gemm_phase<pg8::EpiKVQ, pg8::GemmOrder, true, true>(L, DM * 2, S, E, wave);
#ifdef PAD_NOPS
        asm volatile(".rept " PAD_NOPS "\n\ts_nop 0\n\t.endr" ::: "memory");
#endif
        if (BOTH(7)) GRID_BAR(7);
    }
    if (IN(8)) { FRESH_TID();
        constexpr int NIT = 512 * REPN(8);
        int moe_chunk = 0;
        for (int Li = blockIdx.x; Li < NIT; Li += G) {
            const int vh = (Li & 7) + 8 * ((Li >> 8) & 1), xp = (Li >> 3) & 31;
            for (int pass = 0; pass < 2; ++pass) {
                const int qb = pass ? xp : 63 - xp;
                attn::Block2 cur;
                cur.Q = (const attn::bf16*)Q16 + ((size_t)vh * S_ + (size_t)qb * 256) * 128; cur.K = (const attn::bf16*)K16 + (size_t)vh * S_ * 128;
                cur.V = (const attn::bf16*)V16 + (size_t)(vh >> 1) * S_ * 256; cur.O = O16 + ((size_t)vh * S_ + (size_t)qb * 256) * 256; cur.P0 = qb * 256;
                attn::attn_block2(cur, (char*)lds, L, wave);
                if (pass == 0 && moe_chunk < 2) {
                    const int per_ = (N_MOE + NGW - 1) / NGW, half_ = (per_ + 1) / 2, end_ = N_EARLY + NGW * half_ * (moe_chunk + 1);
                    TR_RUN_XG(TR_DECODE_MOE, tr_load_w, tr_store_w, 17408, N_EARLY + gw + NGW * half_ * moe_chunk, end_ < NITEMS ? end_ : NITEMS, NGW);
                    ++moe_chunk; __syncthreads();
                }
            }
        }
        for (; moe_chunk < 2; ++moe_chunk) {
            const int per_ = (N_MOE + NGW - 1) / NGW, half_ = (per_ + 1) / 2, end_ = N_EARLY + NGW * half_ * (moe_chunk + 1);
            TR_RUN_XG(TR_DECODE_MOE, tr_load_w, tr_store_w, 17408, N_EARLY + gw + NGW * half_ * moe_chunk, end_ < NITEMS ? end_ : NITEMS, NGW); __syncthreads();
        }
        if (BOTH(8)) GRID_BAR(8);
    }
    if (IN(9)) { FRESH_TID();
        const float s1 = wave_sum(lq1[lane] * lk1[lane] + lq1[lane + 64] * lk1[lane + 64]), s2 = wave_sum(lq2[lane] * lk2[lane] + lq2[lane + 64] * lk2[lane + 64]);
        const float lam = expf(s1) - expf(s2) + LAMBDA_INIT;
        const f32x4 sw = *(const f32x4*)(subln_w + 4 * lane) * (1.0f - LAMBDA_INIT);
#define P9_LOAD(m_) do { _Pragma("unroll") for (int h = 0; h < NHEAD; ++h) { \
            u1[h] = __builtin_nontemporal_load((const v2u*)(O16 + ((size_t)(h * 2) * S_ + (m_)) * 256 + 4 * lane)); u2[h] = __builtin_nontemporal_load((const v2u*)(O16 + ((size_t)(h * 2 + 1) * S_ + (m_)) * 256 + 4 * lane)); } } while (0)
        SMALLREP_N(103) { v2u u1[NHEAD], u2[NHEAD];
            if (gw < S_) P9_LOAD(gw);
            for (int m = gw; m < S_; m += NGW) {
                f32x4 o[NHEAD]; float ss[NHEAD];
#pragma unroll
                for (int h = 0; h < NHEAD; ++h) {
                    const f32x4 o1 = {__uint_as_float(u1[h].x << 16), __uint_as_float(u1[h].x & 0xffff0000u), __uint_as_float(u1[h].y << 16), __uint_as_float(u1[h].y & 0xffff0000u)};
                    const f32x4 o2 = {__uint_as_float(u2[h].x << 16), __uint_as_float(u2[h].x & 0xffff0000u), __uint_as_float(u2[h].y << 16), __uint_as_float(u2[h].y & 0xffff0000u)};
                    o[h] = o1 - lam * o2; ss[h] = dot4(o[h], o[h]); }
                { const int mn = m + NGW; const int ml = mn < S_ ? mn : m; P9_LOAD(ml); }
#pragma unroll
                for (int off = 1; off < 64; off <<= 1) { float t[NHEAD];
#pragma unroll
                    for (int h = 0; h < NHEAD; ++h) t[h] = __shfl_xor(ss[h], off);
#pragma unroll
                    for (int h = 0; h < NHEAD; ++h) ss[h] += t[h]; }
#pragma unroll
                for (int h = 0; h < NHEAD; ++h) {
                    const float r = 1.0f / sqrtf(ss[h] * (1.0f / 256.0f) + SUBLN_EPS);
                    const f32x4 y = o[h] * r * sw; v2u w; w.x = pk2(y.x, y.y); w.y = pk2(y.z, y.w);
                    *(v2u*)(ON + (size_t)m * DM + h * 256 + 4 * lane) = w; }
            }
        }
#undef P9_LOAD
        if (BOTH(9)) GRID_BAR(9);
    }
    if (IN(10)) { FRESH_TID();
        pg8::GemmOrder S; S.init(S_ / 256, DM / 256, G, (int)blockIdx.x, ON, WO, DM, 30, 0);
        pg8::EpiResF32 E{X1, X1, DM, nullptr};
        pg8::gemm_phase<pg8::EpiResF32, pg8::GemmOrder, true, true>(L, DM * 2, S, E, wave);
        if (BOTH(10)) GRID_BAR(10);
    }
    if (IN(11)) { FRESH_TID();
        LAS float* rw = (LAS float*)L;
        LAS int* lcnt = (LAS int*)(L + 65536); LAS int* gbase = lcnt + 8; LAS int* rinfo = lcnt + 16;
        LAS float* rgate = (LAS float*)(L + 65536 + 64 + 1024);
        LAS float* rsd = rgate + 128;
        LAS int* part = (LAS int*)(L + 65536 + 4096);
        gu32* bcnt = ctl + CW_BC;
        for (int i = tid; i < DM * NE / 4; i += NWAVES * 64) ((LAS f32x4*)rw)[i] = ((const f32x4*)router_w)[i];
        __syncthreads();
        const float* gn = norm_ffn + DM;
        for (int rb = blockIdx.x; rb < S_ / 64; rb += G) {
            float xv[32];
            { const float* xr0 = X1 + (size_t)(rb * 64 + wave * 8) * DM + lane;
#pragma unroll
              for (int i = 0; i < 32; ++i) xv[i] = xr0[64 * i]; }
            for (int rr = 0; rr < 8; ++rr) {
                const int row = rb * 64 + wave * 8 + rr;
                float xn[32];
                { const float* xr1 = X1 + (size_t)(rr < 7 ? row + 1 : row) * DM + lane;
#pragma unroll
                  for (int i = 0; i < 32; ++i) xn[i] = xr1[64 * i]; }
                float red[9] = {0.f, 0.f, 0.f, 0.f, 0.f, 0.f, 0.f, 0.f, 0.f};
#pragma unroll
                for (int i = 0; i < 32; ++i) { red[8] += xv[i] * xv[i]; const float hv = xv[i] * gn[lane + 64 * i]; const LAS f32x4* wp = (const LAS f32x4*)(rw + (lane + 64 * i) * 8); const f32x4 w0 = wp[0], w1 = wp[1];
                    red[0] += hv * w0.x; red[1] += hv * w0.y; red[2] += hv * w0.z; red[3] += hv * w0.w; red[4] += hv * w1.x; red[5] += hv * w1.y; red[6] += hv * w1.z; red[7] += hv * w1.w; }
#pragma unroll
                for (int off = 1; off < 64; off <<= 1) { float t[9];
#pragma unroll
                    for (int e = 0; e < 9; ++e) t[e] = __shfl_xor(red[e], off);
#pragma unroll
                    for (int e = 0; e < 9; ++e) red[e] += t[e]; }
                const float rstd = 1.0f / sqrtf(red[8] * (1.0f / DM) + NORM_EPS);
                float lg[8];
#pragma unroll
                for (int e = 0; e < 8; ++e) lg[e] = red[e] * rstd;
#pragma unroll
                for (int i = 0; i < 32; ++i) xv[i] = xn[i];
                int e1 = 0; float l1 = lg[0];
#pragma unroll
                for (int e = 1; e < 8; ++e) if (lg[e] > l1) { l1 = lg[e]; e1 = e; }
                int e2 = -1; float l2 = -__builtin_inff();
#pragma unroll
                for (int e = 0; e < 8; ++e) if (e != e1 && lg[e] > l2) { l2 = lg[e]; e2 = e; }
                const float ex = expf(l2 - l1), g1 = 1.0f / (1.0f + ex), g2 = ex / (1.0f + ex);
                if (lane == 0) { const int q = wave * 8 + rr; rinfo[q * 4 + 0] = e1; rinfo[q * 4 + 2] = e2; rgate[q * 2] = g1; rgate[q * 2 + 1] = g2; rsd[q] = rstd; }
            }
            __syncthreads();
            if (tid < 8) { int c = 0; for (int q = 0; q < 64; ++q) c += (rinfo[q * 4] == tid ? 1 : 0) + (rinfo[q * 4 + 2] == tid ? 1 : 0); __hip_atomic_store(bcnt + rb * 8 + tid, (unsigned)c, RLX_AGENT); }
            if (tid < 64) { const int row = rb * 64 + tid; int r1 = 0, r2 = 0; const int e1 = rinfo[tid * 4], e2 = rinfo[tid * 4 + 2];
                for (int q = 0; q < tid; ++q) { const int a1 = rinfo[q * 4], a2 = rinfo[q * 4 + 2]; r1 += (a1 == e1 ? 1 : 0) + (a2 == e1 ? 1 : 0); r2 += (a1 == e2 ? 1 : 0) + (a2 == e2 ? 1 : 0); }
                i32x4 ti; ti.x = e1; ti.y = r1; ti.z = e2; ti.w = r2; TOKI[row] = ti; f32x2 tg; tg.x = rgate[tid * 2]; tg.y = rgate[tid * 2 + 1]; TOKG[row] = tg; RS1[row] = rsd[tid]; }
            __syncthreads();
        }
        if (N_LAUNCHES == 1) xcd_barrier(bar);
        for (int rb = blockIdx.x; rb < S_ / 64; rb += G) {
            { const int e = tid & 7, ch = tid >> 3; int c = 0;
              for (int j = 0; j < 4; ++j) { const int rb2 = ch * 4 + j; if (rb2 < rb) c += (int)__hip_atomic_load(bcnt + rb2 * 8 + e, RLX_AGENT); }
              part[ch * 8 + e] = c; }
            __syncthreads();
            if (tid < 8) { int c = 0; for (int ch = 0; ch < 64; ++ch) c += part[ch * 8 + tid]; gbase[tid] = c;
                if (rb == S_ / 64 - 1) __hip_atomic_store(ctl + CW_CNT + 64 * tid, (unsigned)(c + (int)__hip_atomic_load(bcnt + rb * 8 + tid, RLX_AGENT)), RLX_AGENT); }
            __syncthreads();
            if (tid < 64) { const int row = rb * 64 + tid; i32x4 ti = TOKI[row]; ti.y += gbase[ti.x]; ti.w += gbase[ti.z]; TOKI[row] = ti; rinfo[tid * 4] = ti.x; rinfo[tid * 4 + 1] = ti.y; rinfo[tid * 4 + 2] = ti.z; rinfo[tid * 4 + 3] = ti.w; rsd[tid] = RS1[row]; }
            __syncthreads();
            f32x4 xc[8];
            { const f32x4* x0 = (const f32x4*)(X1 + (size_t)(rb * 64 + wave * 8) * DM) + lane;
#pragma unroll
              for (int j = 0; j < 8; ++j) xc[j] = x0[64 * j]; }
            for (int rr = 0; rr < 8; ++rr) {
                const int q = wave * 8 + rr, row = rb * 64 + q; const int e1 = rinfo[q * 4], e2 = rinfo[q * 4 + 2]; const int sl1 = rinfo[q * 4 + 1], sl2 = rinfo[q * 4 + 3]; const float rstd = rsd[q];
                f32x4 xnx[8];
                { const f32x4* x1p = (const f32x4*)(X1 + (size_t)(rr < 7 ? row + 1 : row) * DM) + lane;
#pragma unroll
                  for (int j = 0; j < 8; ++j) xnx[j] = x1p[64 * j]; }
                unsigned* o1 = (unsigned*)(XG8 + ((size_t)e1 * S_ + sl1) * DM) + lane; unsigned* o2 = (unsigned*)(XG8 + ((size_t)e2 * S_ + sl2) * DM) + lane;
#pragma unroll
                for (int j = 0; j < 8; ++j) { const f32x4 y = xc[j] * (rstd * SA_X) * ((const f32x4*)gn)[lane + 64 * j]; const unsigned o = pg8::pk4_fp8(y.x, y.y, y.z, y.w); o1[64 * j] = o; o2[64 * j] = o; }
#pragma unroll
                for (int j = 0; j < 8; ++j) xc[j] = xnx[j];
            }
            __syncthreads();
        }
        if (BOTH(11)) GRID_BAR(11);
    }
#define MOE_TS(ts_) do { int tot_ = 0; _Pragma("unroll") for (int e_ = 0; e_ < 8; ++e_) { const int c_ = __builtin_amdgcn_readfirstlane((int)__hip_atomic_load(ctl + CW_CNT + 64 * e_, RLX_AGENT)); (ts_)[e_] = tot_; tot_ += (c_ + 255) >> 8; } (ts_)[8] = tot_; } while (0)
    if (IN(13)) { FRESH_TID();
        pg8::MoeOrder S; MOE_TS(S.ts); S.rep = REPN(13); S.nM = S.ts[8]; S.nN = 2 * DE / 256; S.nwg = S.nM * S.nN; S.G = G; S.c = (int)blockIdx.x;
#ifdef PROBE_P13_CUS
        S.G = PROBE_P13_CUS; if ((int)blockIdx.x >= PROBE_P13_CUS) S.nwg = 0;
#endif
        S.A = (const char*)XG8; S.B = (const char*)WEGU8; S.tstepA = (size_t)256 * DM; S.tstepB = (size_t)256 * DM; S.estride = (size_t)2 * DE * DM; S.ecapA = (size_t)S_ * DM;
        pg8::EpiSwiGLU8 E{HIDE8, DE, 1.0f / (SA_X * SW_GU), SA_H, nullptr, 0.f, 0.f};
        pg8::gemm_phase<pg8::EpiSwiGLU8, pg8::MoeOrder, true, true, true>(L, DM, S, E, wave, 0, 1);
        if (BOTH(13)) GRID_BAR(13);
    }
#define MOE_SK(R_) 4
    if (IN(14)) { FRESH_TID();
#ifndef PROBE_NMAIN
#define PROBE_NMAIN 128
#endif
        pg8::MoeOrder S; MOE_TS(S.ts); const int nT = S.ts[8]; const int nMain = PROBE_NMAIN; const bool split = (G == 256) && nT > nMain && REPN(14) == 1;
        S.rep = REPN(14); S.nM = split ? nMain : nT; S.nN = DM / 256; S.nwg = S.nM * S.nN; S.G = G; S.c = (int)blockIdx.x;
        S.A = (const char*)HIDE8; S.B = (const char*)WED8; S.tstepA = (size_t)256 * DE; S.tstepB = (size_t)256 * DE; S.estride = (size_t)DM * DE; S.ecapA = 0;
        pg8::EpiBf16S E{YB, DM, 1.0f / (SA_H * SW_D)};
        pg8::gemm_phase<pg8::EpiBf16S, pg8::MoeOrder, true, true, true>(L, DE, S, E, wave, 0, 1);
        if (split) {
            const int R = nT - nMain, SK = MOE_SK(R);
            pg8::SplitOrder S2; S2.base = nMain; S2.R = R; S2.SK = SK; S2.nsub = 8 * R * SK; S2.G = G; S2.c = (int)blockIdx.x; S2.klen = DE / SK; S2.klenB = (size_t)(S2.klen / 128) * 32768;
#pragma unroll
            for (int e_ = 0; e_ < 9; ++e_) S2.ts[e_] = S.ts[e_];
            S2.A = S.A; S2.B = S.B; S2.tstepA = S.tstepA; S2.tstepB = S.tstepB; S2.estride = S.estride;
            pg8::EpiBf16S E2{(bf16*)YPART, DM, 1.0f / (SA_H * SW_D)};
            pg8::gemm_phase<pg8::EpiBf16S, pg8::SplitOrder, true, true, true>(L, DE, S2, E2, wave, S2.klen, 1);
            if ((int)blockIdx.x < S2.nsub) {
                const int sk = (int)blockIdx.x % SK, unit = (int)blockIdx.x / SK, rtl = unit >> 3, pn = unit & 7;
                __syncthreads();
                if (threadIdx.x == 0) {
                    __hip_atomic_fetch_add(ctl + CW_KS + unit, 1u, __ATOMIC_RELEASE, __HIP_MEMORY_SCOPE_AGENT);
                    while (__hip_atomic_load(ctl + CW_KS + unit, __ATOMIC_ACQUIRE, __HIP_MEMORY_SCOPE_AGENT) < (unsigned)SK) __builtin_amdgcn_s_sleep(2);
                }
                __syncthreads();
                const int RS = (256 + SK - 1) / SK, rbeg = sk * RS, rend = rbeg + RS < 256 ? rbeg + RS : 256;
                const int cc = fresh_lane() * 4;
                for (int r = rbeg + wave; r < rend; r += NWAVES) {
                    f32x4 acc = {0.f, 0.f, 0.f, 0.f};
                    for (int k2 = 0; k2 < SK; ++k2) { const v2u u = *(const v2u*)((const bf16*)YPART + ((size_t)(k2 * R + rtl) * 256 + r) * DM + pn * 256 + cc);
                        acc.x += __uint_as_float(u.x << 16); acc.y += __uint_as_float(u.x & 0xffff0000u); acc.z += __uint_as_float(u.y << 16); acc.w += __uint_as_float(u.y & 0xffff0000u); }
                    v2u w; w.x = pk2(acc.x, acc.y); w.y = pk2(acc.z, acc.w);
                    *(v2u*)(YB + ((size_t)(nMain + rtl) * 256 + r) * DM + pn * 256 + cc) = w;
                }
            }
        }
        if (BOTH(14)) GRID_BAR(14);
    }
    if (IN(15)) { FRESH_TID();
        int ts[9]; MOE_TS(ts);
        unsigned poison = __hip_atomic_load(ctl + CW_TMO, RLX_AGENT) | __hip_atomic_load(ctl + CW_BAR + XB_TMO, RLX_AGENT);
#define P15_LOAD(UA, UB, XV, I_) do { const int mc_ = mi_[I_] < S_ ? mi_[I_] : S_ - 1; int t1 = 0, t2 = 0; \
            _Pragma("unroll") for (int e = 0; e < 8; ++e) { t1 = (tis_[I_].x == e) ? ts[e] : t1; t2 = (tis_[I_].z == e) ? ts[e] : t2; } \
            const v2u* y1 = (const v2u*)(YB + (size_t)(256 * t1 + tis_[I_].y) * DM) + lane; const v2u* y2 = (const v2u*)(YB + (size_t)(256 * t2 + tis_[I_].w) * DM) + lane; \
            const f32x4* xr = (const f32x4*)(X1 + (size_t)mc_ * DM) + lane; \
            _Pragma("unroll") for (int j = 0; j < 8; ++j) { UA[j] = __builtin_nontemporal_load(y1 + 64 * j); UB[j] = __builtin_nontemporal_load(y2 + 64 * j); XV[j] = __builtin_nontemporal_load(xr + 64 * j); } } while (0)
#define P15_FIN(UA, UB, XV, I_) do { const bool first_lo = tis_[I_].x < tis_[I_].z; f32x4 v[8]; float s = 0.f; \
            _Pragma("unroll") for (int j = 0; j < 8; ++j) { const v2u ua = UA[j], ub = UB[j]; \
                const f32x4 a = (f32x4){__uint_as_float(ua.x << 16), __uint_as_float(ua.x & 0xffff0000u), __uint_as_float(ua.y << 16), __uint_as_float(ua.y & 0xffff0000u)} * tgs_[I_].x; \
                const f32x4 b = (f32x4){__uint_as_float(ub.x << 16), __uint_as_float(ub.x & 0xffff0000u), __uint_as_float(ub.y << 16), __uint_as_float(ub.y & 0xffff0000u)} * tgs_[I_].y; \
                v[j] = XV[j] + (first_lo ? (a + b) : (b + a)); s += dot4(v[j], v[j]); } \
            float rstd = 1.0f / sqrtf(wave_sum(s) * (1.0f / DM) + NORM_EPS); \
            if (poison) rstd = __builtin_nanf(""); \
            if (mi_[I_] < S_) { f32x4* o = (f32x4*)(args.out + (size_t)mi_[I_] * DM) + lane; \
                _Pragma("unroll") for (int j = 0; j < 8; ++j) __builtin_nontemporal_store(v[j] * rstd * ((const f32x4*)norm_final)[lane + 64 * j], o + 64 * j); } } while (0)
        SMALLREP_N(104) for (int mb = gw; mb < S_; mb += 8 * NGW) {
            int mi_[8]; i32x4 tis_[8]; f32x2 tgs_[8];
#pragma unroll
            for (int i = 0; i < 8; ++i) { mi_[i] = mb + i * NGW; const int mc_ = mi_[i] < S_ ? mi_[i] : S_ - 1; tis_[i] = TOKI[mc_]; tgs_[i] = TOKG[mc_]; }
            v2u ua0[8], ub0[8], ua1[8], ub1[8]; f32x4 xv0[8], xv1[8];
            P15_LOAD(ua0, ub0, xv0, 0);
            P15_LOAD(ua1, ub1, xv1, 1); P15_FIN(ua0, ub0, xv0, 0);
            P15_LOAD(ua0, ub0, xv0, 2); P15_FIN(ua1, ub1, xv1, 1);
            P15_LOAD(ua1, ub1, xv1, 3); P15_FIN(ua0, ub0, xv0, 2);
            P15_LOAD(ua0, ub0, xv0, 4); P15_FIN(ua1, ub1, xv1, 3);
            P15_LOAD(ua1, ub1, xv1, 5); P15_FIN(ua0, ub0, xv0, 4);
            P15_LOAD(ua0, ub0, xv0, 6); P15_FIN(ua1, ub1, xv1, 5);
            P15_LOAD(ua1, ub1, xv1, 7); P15_FIN(ua0, ub0, xv0, 6);
            P15_FIN(ua1, ub1, xv1, 7);
        }
#undef P15_LOAD
#undef P15_FIN
    }
#undef TR_RUN
#undef TR_RUN_X
#undef TR_RUN_XG
#undef TR_SET_W
#undef TR_DECODE_MOE
#undef TR_DECODE
#undef TR_SET
#undef IN
#undef BOTH
#undef GRID_BAR
#undef MOE_TS
}

extern "C" void kernel_launch(void* const* d_in, const int* in_sizes, int n_in, void* d_out, int out_size, void* d_ws, size_t ws_size, hipStream_t stream) {
    static int grid = 0;
    if (grid == 0) {
        if (n_in != 25 || in_sizes[0] != S_ * DM || out_size != S_ * DM || ws_size < WS_END) { fprintf(stderr, "kernel_launch: shape / workspace mismatch (n_in %d, in0 %d, out %d, ws %zu, need %zu); nothing launched\n", n_in, n_in > 0 ? in_sizes[0] : -1, out_size, ws_size, (size_t)WS_END); grid = -1; return; }
        int dev = 0, cus = 0;
        if (hipGetDevice(&dev) != hipSuccess || hipDeviceGetAttribute(&cus, hipDeviceAttributeMultiprocessorCount, dev) != hipSuccess) { fprintf(stderr, "kernel_launch: device query failed\n"); grid = -1; return; }
        if (hipFuncSetAttribute((const void*)yoco_fwd, hipFuncAttributeMaxDynamicSharedMemorySize, LDS_BYTES) != hipSuccess) { fprintf(stderr, "kernel_launch: hipFuncSetAttribute failed\n"); grid = -1; return; }
        int per_cu = 0;
        if (hipOccupancyMaxActiveBlocksPerMultiprocessor(&per_cu, (const void*)yoco_fwd, NWAVES * 64, LDS_BYTES) != hipSuccess || per_cu < 1) { fprintf(stderr, "kernel_launch: occupancy query reports %d workgroups per CU\n", per_cu); }
        (void)hipGetLastError();
        grid = cus;
    }
    if (grid < 0) return;
    if (hipMemsetAsync((char*)d_ws + WS_CTL, 0, CTL_ZERO_BYTES, stream) != hipSuccess) { fprintf(stderr, "kernel_launch: memset failed\n"); return; }
    Args a{};
    for (int i = 0; i < 25; ++i) a.in[i] = d_in[i];
    a.out = (float*)d_out; a.ws = (unsigned char*)d_ws; a.pad = 0;
    if (N_LAUNCHES == 1) { a.ph_lo = 0; a.ph_hi = N_PHASES; a.li = 0; hipLaunchKernelGGL(yoco_fwd, dim3(grid), dim3(NWAVES * 64), LDS_BYTES, stream, a); }
    else { for (int li = 0; li < N_PHASES; ++li) { a.ph_lo = li; a.ph_hi = li + 1; a.li = li; hipLaunchKernelGGL(yoco_fwd, dim3(grid), dim3(NWAVES * 64), LDS_BYTES, stream, a); } }
    const hipError_t le = hipPeekAtLastError();
    if (le != hipSuccess) fprintf(stderr, "kernel_launch: launch failed: %s\n", hipGetErrorName(le));
}
```

```cpp
#include <hip/hip_runtime.h>
#include <hip/hip_bf16.h>
#include <cstdio>
#include <cstdint>

__device__ __forceinline__ int fresh_lane() { int l; asm volatile("v_mbcnt_lo_u32_b32 %0, -1, 0\n\tv_mbcnt_hi_u32_b32 %0, -1, %0" : "=v"(l)); return l; }

namespace pg8 {
#define PG8_LAS __attribute__((address_space(3)))
typedef unsigned short bf16_t;
typedef short bf16x8 __attribute__((ext_vector_type(8)));
typedef float f32x4 __attribute__((ext_vector_type(4)));
typedef unsigned u32x4 __attribute__((ext_vector_type(4)));
typedef int i32x4 __attribute__((ext_vector_type(4)));
typedef int i32x8 __attribute__((ext_vector_type(8)));
typedef unsigned u32x2 __attribute__((ext_vector_type(2)));
constexpr int BM = 256, BK = 64, HALF = 128, HTB = HALF * BK * 2  , STAGE_BYTES = 8 * HTB, NXCD = 8, WGM = 8;

__host__ __device__ __forceinline__ int lds_byte(int r, int c) { const int st = (r >> 4) * 2 + (c >> 5), rr = r & 15, cc = c & 31, ob = rr * 64 + cc * 2; return st * 1024 + (ob ^ (((ob >> 9) & 1) << 5)); }
__host__ __device__ __forceinline__ void stage_rc(int b, int& R, int& C) { const int st = b / 1024, sb = b % 1024, swz = sb ^ (((sb >> 9) & 1) << 5); R = (st >> 1) * 16 + swz / 64; C = (st & 1) * 32 + (swz % 64) / 2; }
__host__ __device__ __forceinline__ int perm32(int rho) { const int n = rho >> 4, i = rho & 15; return 8 * (i >> 2) + 4 * n + (i & 3); }

struct Unit { int pm, pn, aux; const char* A; const char* B; };

struct GemmOrder {
    int nM, nN, nwg, G, c, ashift, rep; const char* A; const char* B; size_t tstepA, tstepB, astride;
    __device__ __forceinline__ void init(int nM_, int nN_, int G_, int c_, const void* A_, const void* B_, int K, int ashift_, size_t astride_) {
        nM = nM_; nN = nN_; nwg = nM * nN; G = G_; c = c_; A = (const char*)A_; B = (const char*)B_; tstepA = (size_t)BM * K * 2;     tstepB = tstepA; ashift = ashift_; astride = astride_; rep = 1; }
    __device__ __forceinline__ bool next(int i, Unit& u) const {
        const long L = (long)i * G + c; if (L >= (long)nwg * rep) return false;
        int wgid = (int)(L % nwg); { const int q = nwg / NXCD, r = nwg % NXCD, xcd = wgid % NXCD, off = wgid / NXCD; wgid = (xcd < r ? xcd * (q + 1) : r * (q + 1) + (xcd - r) * q) + off; }
        const int nig = WGM * nN, gid = wgid / nig, fm = gid * WGM, gsz = (nM - fm) < WGM ? (nM - fm) : WGM;
        u.pm = fm + ((wgid % nig) % gsz); u.pn = (wgid % nig) / gsz; u.aux = 0;
        u.A = A + (size_t)(u.pn >> ashift) * astride + (size_t)u.pm * tstepA; u.B = B + (size_t)u.pn * tstepB; return true;
    }
    __device__ __forceinline__ void a_ready(const Unit&) const {}
    __device__ __forceinline__ void done(const Unit&) const {}
};
struct MoeOrder {
    int nM, nN, nwg, G, c, rep; int ts[9]; const char* A; const char* B; size_t tstepA, tstepB, estride, ecapA;
    __device__ __forceinline__ bool next(int i, Unit& u) const {
        const long L = (long)i * G + c; if (L >= (long)nwg * rep) return false;
        int wgid = (int)(L % nwg); { const int q = nwg / NXCD, r = nwg % NXCD, xcd = wgid % NXCD, off = wgid / NXCD; wgid = (xcd < r ? xcd * (q + 1) : r * (q + 1) + (xcd - r) * q) + off; }
        const int nig = WGM * nN, gid = wgid / nig, fm = gid * WGM, gsz = (nM - fm) < WGM ? (nM - fm) : WGM;
        u.pm = fm + ((wgid % nig) % gsz); u.pn = (wgid % nig) / gsz;
        int e = 0, t0 = 0;
#pragma unroll
        for (int j = 1; j < 8; ++j) { const bool ge = u.pm >= ts[j]; e += ge ? 1 : 0; t0 = ge ? ts[j] : t0; }
        u.aux = e;
        u.A = ecapA ? A + (size_t)e * ecapA + (size_t)(u.pm - t0) * tstepA : A + (size_t)u.pm * tstepA; u.B = B + (size_t)e * estride + (size_t)u.pn * tstepB; return true;
    }
    __device__ __forceinline__ void a_ready(const Unit&) const {}
    __device__ __forceinline__ void done(const Unit&) const {}
};

struct SplitOrder {
    int R, SK, nsub, G, c, klen, base; int ts[9]; const char* A; const char* B; size_t tstepA, tstepB, estride, klenB, klenA;
    __device__ __forceinline__ bool next(int i, Unit& u) const {
        const long L = (long)i * G + c; if (L >= nsub) return false;
        const int sk = (int)(L % SK), unit = (int)(L / SK), rtl = unit >> 3, pm = base + rtl;
        int e = 0;
#pragma unroll
        for (int j = 1; j < 8; ++j) e += (pm >= ts[j]) ? 1 : 0;
        u.pm = sk * R + rtl; u.pn = unit & 7; u.aux = e;
        u.A = A + (size_t)pm * tstepA + (size_t)sk * klenA; u.B = B + (size_t)e * estride + (size_t)u.pn * tstepB + (size_t)sk * klenB; return true;
    }
    __device__ __forceinline__ void a_ready(const Unit&) const {}
    __device__ __forceinline__ void done(const Unit&) const {}
};

__device__ __forceinline__ unsigned cvt_pk_bf16(float lo, float hi) { unsigned r; asm volatile("v_cvt_pk_bf16_f32 %0, %1, %2" : "=v"(r) : "v"(lo), "v"(hi)); return r; }

struct EpiResF32 {
    static constexpr bool PERM = false, AFTER_DRAIN = false;
    const float* base; float* out; int ldc; const float* scale;
    __device__ __forceinline__ void operator()(const f32x4 (&acc)[2][2][4][2], const Unit& u, int wr, int wc, int fr, int fq) const {
        const int row0 = u.pm * BM + wr * 64 + fr, col0 = u.pn * BM + wc * 32 + 4 * fq;
        f32x4 sv[2][2];
#pragma unroll
        for (int bj = 0; bj < 2; ++bj)
#pragma unroll
            for (int n = 0; n < 2; ++n) sv[bj][n] = scale ? *(const f32x4*)(scale + col0 + bj * HALF + n * 16) : (f32x4){1.f, 1.f, 1.f, 1.f};
#pragma unroll
        for (int ai = 0; ai < 2; ++ai) { f32x4 bs[4][2][2];
#pragma unroll
            for (int m = 0; m < 4; ++m) { const size_t off = (size_t)(row0 + ai * HALF + m * 16) * ldc + col0;
#pragma unroll
                for (int bj = 0; bj < 2; ++bj)
#pragma unroll
                    for (int n = 0; n < 2; ++n) bs[m][bj][n] = *(const f32x4*)(base + off + bj * HALF + n * 16); }
            asm volatile("" ::: "memory");
#pragma unroll
            for (int m = 0; m < 4; ++m) { const size_t off = (size_t)(row0 + ai * HALF + m * 16) * ldc + col0;
#pragma unroll
                for (int bj = 0; bj < 2; ++bj)
#pragma unroll
                    for (int n = 0; n < 2; ++n) *(f32x4*)(out + off + bj * HALF + n * 16) = bs[m][bj][n] + acc[ai][bj][m][n] * sv[bj][n]; }
            asm volatile("" ::: "memory"); }
    }
};
__device__ __forceinline__ unsigned pk4_fp8(float a, float b, float c, float d) {
    a = __builtin_amdgcn_fmed3f(a, -448.f, 448.f); b = __builtin_amdgcn_fmed3f(b, -448.f, 448.f); c = __builtin_amdgcn_fmed3f(c, -448.f, 448.f); d = __builtin_amdgcn_fmed3f(d, -448.f, 448.f);
    int r = __builtin_amdgcn_cvt_pk_fp8_f32(a, b, 0, false); r = __builtin_amdgcn_cvt_pk_fp8_f32(c, d, r, true); return (unsigned)r; }
struct EpiResF32N {
    static constexpr bool PERM = false, AFTER_DRAIN = false;
    const float* base; float* out; int ldc; const float* scale; bf16_t* xb; float* ssp; PG8_LAS float* tab; float osc; unsigned char* x8; float s8;
    __device__ __forceinline__ void operator()(const f32x4 (&acc)[2][2][4][2], const Unit& u, int wr, int wc, int fr, int fq) const {
        const int row0 = u.pm * BM + wr * 64 + fr, col0 = u.pn * BM + wc * 32 + 4 * fq;
        f32x4 sv[2][2];
#pragma unroll
        for (int bj = 0; bj < 2; ++bj)
#pragma unroll
            for (int n = 0; n < 2; ++n) sv[bj][n] = scale ? *(const f32x4*)(scale + col0 + bj * HALF + n * 16) : (f32x4){1.f, 1.f, 1.f, 1.f};
#pragma unroll
        for (int ai = 0; ai < 2; ++ai) { f32x4 bsv[4][2][2];
#pragma unroll
            for (int m = 0; m < 4; ++m) { const size_t off = (size_t)(row0 + ai * HALF + m * 16) * ldc + col0;
#pragma unroll
                for (int bj = 0; bj < 2; ++bj)
#pragma unroll
                    for (int n = 0; n < 2; ++n) bsv[m][bj][n] = *(const f32x4*)(base + off + bj * HALF + n * 16); }
            asm volatile("" ::: "memory");
#pragma unroll
            for (int m = 0; m < 4; ++m) { const int row = row0 + ai * HALF + m * 16; const size_t off = (size_t)row * ldc + col0; float q = 0.f;
#pragma unroll
                for (int bj = 0; bj < 2; ++bj)
#pragma unroll
                    for (int n = 0; n < 2; ++n) { const f32x4 bs = bsv[m][bj][n]; const f32x4 v = bs + acc[ai][bj][m][n] * (sv[bj][n] * osc);
                        *(f32x4*)(out + off + bj * HALF + n * 16) = v; q += (v[0] * v[0] + v[1] * v[1]) + (v[2] * v[2] + v[3] * v[3]);
                        if (xb) { u32x2 w; w.x = cvt_pk_bf16(v[0], v[1]); w.y = cvt_pk_bf16(v[2], v[3]); *(u32x2*)(xb + off + bj * HALF + n * 16) = w; }
                        if (x8) *(unsigned*)(x8 + off + bj * HALF + n * 16) = pk4_fp8(v[0] * s8, v[1] * s8, v[2] * s8, v[3] * s8); }
                q += __shfl_xor(q, 16); q += __shfl_xor(q, 32);
                if (fq == 0) tab[(ai * HALF + wr * 64 + m * 16 + fr) * 4 + wc] = q;
                asm volatile("" ::: "memory"); } }
        asm volatile("s_waitcnt lgkmcnt(0)" ::: "memory"); __builtin_amdgcn_s_barrier(); asm volatile("" ::: "memory");
        const int t = (wr * 4 + wc) * 64 + fq * 16 + fr;
        if (t < BM) { const PG8_LAS f32x4* p = (const PG8_LAS f32x4*)(tab + t * 4); const f32x4 s = *p; ssp[(size_t)(u.pm * BM + t) * 8 + u.pn] = ((s[0] + s[1]) + s[2]) + s[3]; }
    }
};
struct EpiBf16S {
    static constexpr bool PERM = true, AFTER_DRAIN = false;
    bf16_t* O; int ldc; float sc;
    __device__ __forceinline__ void operator()(const f32x4 (&acc)[2][2][4][2], const Unit& u, int wr, int wc, int fr, int fq) const {
        const int row0 = u.pm * BM + wr * 64 + fr, col0 = u.pn * BM + wc * 32 + 8 * fq;
#pragma unroll
        for (int ai = 0; ai < 2; ++ai)
#pragma unroll
            for (int m = 0; m < 4; ++m) { bf16_t* rowp = O + (size_t)(row0 + ai * HALF + m * 16) * ldc + col0;
#pragma unroll
                for (int bj = 0; bj < 2; ++bj) { const f32x4 v0 = acc[ai][bj][m][0] * sc, v1 = acc[ai][bj][m][1] * sc;
                    u32x4 w; w.x = cvt_pk_bf16(v0[0], v0[1]); w.y = cvt_pk_bf16(v0[2], v0[3]); w.z = cvt_pk_bf16(v1[0], v1[1]); w.w = cvt_pk_bf16(v1[2], v1[3]);
                    *(u32x4*)(rowp + bj * HALF) = w; } }
    }
};
struct EpiF32 {
    static constexpr bool PERM = false, AFTER_DRAIN = false;
    float* out; int ldc; float sc;
    __device__ __forceinline__ void operator()(const f32x4 (&acc)[2][2][4][2], const Unit& u, int wr, int wc, int fr, int fq) const {
        const int row0 = u.pm * BM + wr * 64 + fr, col0 = u.pn * BM + wc * 32 + 4 * fq;
#pragma unroll
        for (int ai = 0; ai < 2; ++ai)
#pragma unroll
            for (int m = 0; m < 4; ++m) { float* rowp = out + (size_t)(row0 + ai * HALF + m * 16) * ldc + col0;
#pragma unroll
                for (int bj = 0; bj < 2; ++bj)
#pragma unroll
                    for (int n = 0; n < 2; ++n) *(f32x4*)(rowp + bj * HALF + n * 16) = acc[ai][bj][m][n] * sc; }
    }
};
__device__ __forceinline__ float row_rstd(const float* ssp, int row, float inv_n, float eps) { const f32x4 a = *(const f32x4*)(ssp + (size_t)row * 8), b = *(const f32x4*)(ssp + (size_t)row * 8 + 4);
    return 1.0f / sqrtf((((a[0] + a[1]) + (a[2] + a[3])) + ((b[0] + b[1]) + (b[2] + b[3]))) * inv_n + eps); }
__device__ __forceinline__ float silu_mul(float g, float u) { return g * u * __builtin_amdgcn_rcpf(1.0f + __builtin_amdgcn_exp2f(-1.4426950408889634f * g)); }
struct EpiSwiGLU {
    static constexpr bool PERM = true, AFTER_DRAIN = false;
    bf16_t* O; int ldc; const float* ssp; float inv_n, eps, sin;
    __device__ __forceinline__ void operator()(const f32x4 (&acc)[2][2][4][2], const Unit& u, int wr, int wc, int fr, int fq) const {
        const int row0 = u.pm * BM + wr * 64 + fr, col0 = u.pn * HALF + wc * 32 + 8 * fq;
        float rs8[2][4];
#pragma unroll
        for (int ai = 0; ai < 2; ++ai)
#pragma unroll
            for (int m = 0; m < 4; ++m) rs8[ai][m] = sin * row_rstd(ssp, row0 + ai * HALF + m * 16, inv_n, eps);
        asm volatile("" ::: "memory");
#pragma unroll
        for (int ai = 0; ai < 2; ++ai)
#pragma unroll
            for (int m = 0; m < 4; ++m) { const int row = row0 + ai * HALF + m * 16; bf16_t* rowp = O + (size_t)row * ldc + col0; const float rs = rs8[ai][m];
                const f32x4 g0 = acc[ai][0][m][0] * rs, g1 = acc[ai][0][m][1] * rs, u0 = acc[ai][1][m][0] * rs, u1 = acc[ai][1][m][1] * rs;
                u32x4 w; w.x = cvt_pk_bf16(silu_mul(g0[0], u0[0]), silu_mul(g0[1], u0[1])); w.y = cvt_pk_bf16(silu_mul(g0[2], u0[2]), silu_mul(g0[3], u0[3]));
                w.z = cvt_pk_bf16(silu_mul(g1[0], u1[0]), silu_mul(g1[1], u1[1])); w.w = cvt_pk_bf16(silu_mul(g1[2], u1[2]), silu_mul(g1[3], u1[3]));
                *(u32x4*)rowp = w; }
    }
};
struct EpiSwiGLU8 {
    static constexpr bool PERM = true, AFTER_DRAIN = false;
    unsigned char* O; int ldc; float sin, sout; const float* ssp; float inv_n, eps;
    __device__ __forceinline__ void operator()(const f32x4 (&acc)[2][2][4][2], const Unit& u, int wr, int wc, int fr, int fq) const {
        const int row0 = u.pm * BM + wr * 64 + fr, col0 = u.pn * HALF + wc * 32 + 8 * fq;
        float kg8[2][4];
#pragma unroll
        for (int ai = 0; ai < 2; ++ai)
#pragma unroll
            for (int m = 0; m < 4; ++m) kg8[ai][m] = ssp ? sin * row_rstd(ssp, row0 + ai * HALF + m * 16, inv_n, eps) : sin;
        asm volatile("" ::: "memory");
#pragma unroll
        for (int ai = 0; ai < 2; ++ai)
#pragma unroll
            for (int m = 0; m < 4; ++m) { const int row = row0 + ai * HALF + m * 16;
                unsigned char* rowp = O + ((size_t)(u.pm * (ldc / 128) + u.pn) * BM + (row - u.pm * BM)) * 128 + (col0 - u.pn * HALF); const float kg = kg8[ai][m];
                const f32x4 g0 = acc[ai][0][m][0] * kg, g1 = acc[ai][0][m][1] * kg, u0 = acc[ai][1][m][0] * (kg * sout), u1 = acc[ai][1][m][1] * (kg * sout);
                u32x2 w; w.x = pk4_fp8(silu_mul(g0[0], u0[0]), silu_mul(g0[1], u0[1]), silu_mul(g0[2], u0[2]), silu_mul(g0[3], u0[3]));
                w.y = pk4_fp8(silu_mul(g1[0], u1[0]), silu_mul(g1[1], u1[1]), silu_mul(g1[2], u1[2]), silu_mul(g1[3], u1[3]));
                *(u32x2*)rowp = w; }
    }
};
struct EpiKVQ {
    static constexpr bool PERM = true, AFTER_DRAIN = false;
    bf16_t* K16; bf16_t* V16; bf16_t* Q16; const float* rope; int S; const float* ssp; float inv_n, eps;
    __device__ __forceinline__ void operator()(const f32x4 (&acc)[2][2][4][2], const Unit& u, int wr, int wc, int fr, int fq) const {
        const int row0 = u.pm * BM + wr * 64 + fr;
        const int kind = u.pn >> 3, head = u.pn & 7;
        float rs8[2][4];
#pragma unroll
        for (int ai = 0; ai < 2; ++ai)
#pragma unroll
            for (int m = 0; m < 4; ++m) rs8[ai][m] = row_rstd(ssp, row0 + ai * HALF + m * 16, inv_n, eps);
        asm volatile("" ::: "memory");
        if (kind == 1) {
#pragma unroll
            for (int ai = 0; ai < 2; ++ai)
#pragma unroll
                for (int m = 0; m < 4; ++m) { const int row = row0 + ai * HALF + m * 16; const float rs = rs8[ai][m];
#pragma unroll
                    for (int bj = 0; bj < 2; ++bj) { const f32x4 v0 = acc[ai][bj][m][0] * rs, v1 = acc[ai][bj][m][1] * rs;
                        u32x4 w; w.x = cvt_pk_bf16(v0[0], v0[1]); w.y = cvt_pk_bf16(v0[2], v0[3]); w.z = cvt_pk_bf16(v1[0], v1[1]); w.w = cvt_pk_bf16(v1[2], v1[3]);
                        *(u32x4*)(V16 + ((size_t)head * S + row) * 256 + bj * 128 + wc * 32 + 8 * fq) = w; } }
        } else {
            bf16_t* dst = (kind == 0 ? K16 : Q16) + (size_t)(head * 2 + (wc >> 1)) * S * 128;
            const int d0 = (wc & 1) * 32 + 8 * fq;
            f32x4 cn[4];
            { const f32x4* cs0 = (const f32x4*)(rope + ((size_t)row0 * 64 + d0) * 2); cn[0] = cs0[0]; cn[1] = cs0[1]; cn[2] = cs0[2]; cn[3] = cs0[3]; }
#pragma unroll
            for (int ai = 0; ai < 2; ++ai)
#pragma unroll
                for (int m = 0; m < 4; ++m) { const int row = row0 + ai * HALF + m * 16; const float rs = rs8[ai][m];
                    const f32x4 c01 = cn[0], c23 = cn[1], c45 = cn[2], c67 = cn[3];
                    { const int ix = ai * 4 + m + 1, rown = row0 + ((ix >> 2) & 1) * HALF + (ix & 3) * 16; const f32x4* cs = (const f32x4*)(rope + ((size_t)(ix < 8 ? rown : row) * 64 + d0) * 2);
                      cn[0] = cs[0]; cn[1] = cs[1]; cn[2] = cs[2]; cn[3] = cs[3]; }
                    asm volatile("" ::: "memory");
                    const f32x4 a0 = acc[ai][0][m][0] * rs, a1 = acc[ai][0][m][1] * rs, b0 = acc[ai][1][m][0] * rs, b1 = acc[ai][1][m][1] * rs;
                    float o1[8], o2[8];
                    o1[0] = a0[0] * c01[0] - b0[0] * c01[1]; o2[0] = b0[0] * c01[0] + a0[0] * c01[1];
                    o1[1] = a0[1] * c01[2] - b0[1] * c01[3]; o2[1] = b0[1] * c01[2] + a0[1] * c01[3];
                    o1[2] = a0[2] * c23[0] - b0[2] * c23[1]; o2[2] = b0[2] * c23[0] + a0[2] * c23[1];
                    o1[3] = a0[3] * c23[2] - b0[3] * c23[3]; o2[3] = b0[3] * c23[2] + a0[3] * c23[3];
                    o1[4] = a1[0] * c45[0] - b1[0] * c45[1]; o2[4] = b1[0] * c45[0] + a1[0] * c45[1];
                    o1[5] = a1[1] * c45[2] - b1[1] * c45[3]; o2[5] = b1[1] * c45[2] + a1[1] * c45[3];
                    o1[6] = a1[2] * c67[0] - b1[2] * c67[1]; o2[6] = b1[2] * c67[0] + a1[2] * c67[1];
                    o1[7] = a1[3] * c67[2] - b1[3] * c67[3]; o2[7] = b1[3] * c67[2] + a1[3] * c67[3];
                    u32x4 w1, w2; w1.x = cvt_pk_bf16(o1[0], o1[1]); w1.y = cvt_pk_bf16(o1[2], o1[3]); w1.z = cvt_pk_bf16(o1[4], o1[5]); w1.w = cvt_pk_bf16(o1[6], o1[7]);
                    w2.x = cvt_pk_bf16(o2[0], o2[1]); w2.y = cvt_pk_bf16(o2[2], o2[3]); w2.z = cvt_pk_bf16(o2[4], o2[5]); w2.w = cvt_pk_bf16(o2[6], o2[7]);
                    bf16_t* rp = dst + (size_t)row * 128 + d0;
                    *(u32x4*)rp = w1; *(u32x4*)(rp + 64) = w2; }
        }
    }
};

template <class Epi, class Sched, bool ALIGN_EPI = false, bool SP2 = false, bool F8 = false>
__device__ __forceinline__ void gemm_phase(PG8_LAS unsigned char* lds, const int rowbytes  , const Sched& S, const Epi& E, const int wave_id, const int kbytes = 0  , const int tmB = 0  , const int tmA = 0  ) {
    const int lane = fresh_lane(), wid = wave_id, tid = wid * 64 + lane, wr = wid >> 2, wc = wid & 3, fr = lane & 15, fq = lane >> 4;
    const int nt = (kbytes ? kbytes : rowbytes) / (BK * 2);
    const int rowbytesB = tmB ? BK * 2 : rowbytes, rowbytesA = tmA ? BK * 2 : rowbytes;
    unsigned voffA[2], voffB[2];
#pragma unroll
    for (int i = 0; i < 2; ++i) { int R, C; stage_rc(tid * 16 + i * 8192, R, C); const int Rb = Epi::PERM ? ((R & ~31) + perm32(R & 31)) : R;
        voffA[i] = (unsigned)(R * rowbytesA + C * 2); voffB[i] = (unsigned)(Rb * rowbytesB + C * 2); }
    const size_t kstep = (size_t)(BK * 2);
    const size_t kstepB = tmB ? (size_t)BM * (BK * 2) : kstep, hstepB = (size_t)HALF * rowbytesB;
    const size_t kstepA = tmA ? (size_t)BM * (BK * 2) : kstep;
    const size_t hstep = (size_t)HALF * rowbytesA;
    const unsigned ldsw = (unsigned)wid * 1024u;
    const int aoff = lds_byte(wr * 64 + fr, fq * 8), boff = lds_byte(wc * 32 + fr, fq * 8);
#define PG8_SA(b, h) (((b) * 2 + (h)) * HTB)
#define PG8_SB(b, h) ((4 + (b) * 2 + (h)) * HTB)
#define PG8_STAGE(bufoff, gbase, voff) do { _Pragma("unroll") for (int _i = 0; _i < 2; ++_i) \
        __builtin_amdgcn_global_load_lds((const unsigned*)((const char*)(gbase) + (voff)[_i]), (PG8_LAS unsigned*)(lds + (bufoff) + ldsw + _i * 8192), 16, 0, 0); } while (0)
#define PG8_LDA(dst, b, h) do { _Pragma("unroll") for (int m = 0; m < 4; ++m) { if constexpr (F8) { dst##8[m] = __builtin_shufflevector(*(const PG8_LAS i32x4*)(lds + PG8_SA(b, h) + aoff + m * 2048), *(const PG8_LAS i32x4*)(lds + PG8_SA(b, h) + aoff + m * 2048 + 1024), 0, 1, 2, 3, 4, 5, 6, 7); } \
        else { _Pragma("unroll") for (int k = 0; k < 2; ++k) dst[m][k] = *(const PG8_LAS bf16x8*)(lds + PG8_SA(b, h) + aoff + m * 2048 + k * 1024); } } } while (0)
#define PG8_LDB(dst, b, h) do { _Pragma("unroll") for (int n = 0; n < 2; ++n) { if constexpr (F8) { dst##8[n] = __builtin_shufflevector(*(const PG8_LAS i32x4*)(lds + PG8_SB(b, h) + boff + n * 2048), *(const PG8_LAS i32x4*)(lds + PG8_SB(b, h) + boff + n * 2048 + 1024), 0, 1, 2, 3, 4, 5, 6, 7); } \
        else { _Pragma("unroll") for (int k = 0; k < 2; ++k) dst[n][k] = *(const PG8_LAS bf16x8*)(lds + PG8_SB(b, h) + boff + n * 2048 + k * 1024); } } } while (0)
#define PG8_MMA(ai, bj, At, Bt) do { __builtin_amdgcn_s_setprio(1); _Pragma("unroll") for (int m = 0; m < 4; ++m) _Pragma("unroll") for (int n = 0; n < 2; ++n) { \
        if constexpr (F8) { asm volatile("v_mfma_scale_f32_16x16x128_f8f6f4 %0, %1, %2, %0, %3, %3 op_sel_hi:[0,0,0]" : "+v"(acc[ai][bj][m][n]) : "v"(Bt##8[n]), "v"(At##8[m]), "v"(sc1)); }     \
        else { _Pragma("unroll") for (int k = 0; k < 2; ++k) acc[ai][bj][m][n] = __builtin_amdgcn_mfma_f32_16x16x32_bf16(Bt[n][k], At[m][k], acc[ai][bj][m][n], 0, 0, 0); } } \
        __builtin_amdgcn_s_setprio(0); } while (0)
#define PG8_WAIT_V(n) asm volatile("s_waitcnt vmcnt(" #n ")" ::: "memory")
#define PG8_WAIT_L(n) asm volatile("s_waitcnt lgkmcnt(" #n ")" ::: "memory")
#define PG8_BAR __builtin_amdgcn_s_barrier()
#define PG8_SCHED __builtin_amdgcn_sched_barrier(0)
    Unit cur, nxt; int ui = 0;
    if (!S.next(0, cur)) return;
    f32x4 acc[2][2][4][2];
#pragma unroll
    for (int a = 0; a < 2; ++a)
#pragma unroll
        for (int b = 0; b < 2; ++b)
#pragma unroll
            for (int m = 0; m < 4; ++m)
#pragma unroll
                for (int n = 0; n < 2; ++n) acc[a][b][m][n] = (f32x4){0.f, 0.f, 0.f, 0.f};
    const int sc1 = 0x7f7f7f7f;
    bf16x8 At[4][2], B0[2][2], B1[2][2]; i32x8 At8[4], B08[2], B18[2];
    const char* cA = cur.A; const char* cB = cur.B;
    S.a_ready(cur);
    if constexpr (SP2) {
        PG8_STAGE(PG8_SB(0, 0), cB, voffB); PG8_STAGE(PG8_SB(0, 1), cB + hstepB, voffB); PG8_STAGE(PG8_SA(0, 0), cA, voffA); PG8_STAGE(PG8_SA(0, 1), cA + hstep, voffA);
        if (wr == 1) PG8_BAR;
        PG8_WAIT_V(2); PG8_BAR;
        PG8_STAGE(PG8_SB(1, 0), cB + kstepB, voffB); PG8_STAGE(PG8_SA(1, 0), cA + kstepA, voffA); PG8_STAGE(PG8_SB(1, 1), cB + hstepB + kstepB, voffB);
        PG8_WAIT_V(6); PG8_BAR;
    } else {
        PG8_STAGE(PG8_SB(0, 0), cB, voffB); PG8_STAGE(PG8_SA(0, 0), cA, voffA); PG8_STAGE(PG8_SB(0, 1), cB + hstepB, voffB); PG8_STAGE(PG8_SA(0, 1), cA + hstep, voffA);
        if (wr == 1) PG8_BAR;
        PG8_WAIT_V(4); PG8_BAR;
        PG8_STAGE(PG8_SB(1, 0), cB + kstepB, voffB); PG8_STAGE(PG8_SA(1, 0), cA + kstepA, voffA); PG8_STAGE(PG8_SB(1, 1), cB + hstepB + kstepB, voffB);
        PG8_WAIT_V(6); PG8_BAR;
    }
    for (;;) {
        const bool has_next = S.next(ui + 1, nxt);
        const char* nA = has_next ? nxt.A : cA; const char* nB = has_next ? nxt.B : cB;
        for (int t = 0; t < nt; t += 2) {
            const bool last = (t == nt - 2);
            const char* a1 = cA + (size_t)(t + 1) * kstepA;
            const char* a2 = last ? nA : cA + (size_t)(t + 2) * kstepA; const char* b2 = last ? nB : cB + (size_t)(t + 2) * kstepB;
            const char* a3 = a2 + kstepA; const char* b3 = b2 + kstepB;
            if (last && has_next) S.a_ready(nxt);
            if constexpr (SP2) {
            PG8_LDB(B0, 0, 0); PG8_LDB(B1, 0, 1); PG8_SCHED; PG8_LDA(At, 0, 0); PG8_STAGE(PG8_SA(1, 1), a1 + hstep, voffA);
            PG8_WAIT_V(8); PG8_WAIT_L(0); PG8_BAR; PG8_MMA(0, 0, At, B0); PG8_MMA(0, 1, At, B1); PG8_BAR; PG8_SCHED;
            PG8_LDA(At, 0, 1); PG8_STAGE(PG8_SB(0, 0), b2, voffB); PG8_STAGE(PG8_SB(0, 1), b2 + hstepB, voffB); PG8_STAGE(PG8_SA(0, 0), a2, voffA);
            PG8_WAIT_V(8); PG8_WAIT_L(0); PG8_BAR; PG8_MMA(1, 0, At, B0); PG8_MMA(1, 1, At, B1); PG8_BAR; PG8_SCHED;
            PG8_LDB(B0, 1, 0); PG8_LDB(B1, 1, 1); PG8_SCHED; PG8_LDA(At, 1, 0); PG8_STAGE(PG8_SA(0, 1), a2 + hstep, voffA);
            PG8_WAIT_V(8); PG8_WAIT_L(0); PG8_BAR; PG8_MMA(0, 0, At, B0); PG8_MMA(0, 1, At, B1); PG8_BAR; PG8_SCHED;
            PG8_LDA(At, 1, 1); PG8_STAGE(PG8_SB(1, 0), b3, voffB); PG8_STAGE(PG8_SB(1, 1), b3 + hstepB, voffB); PG8_STAGE(PG8_SA(1, 0), a3, voffA);
            PG8_WAIT_V(8); PG8_WAIT_L(0); PG8_BAR; PG8_MMA(1, 0, At, B0); PG8_MMA(1, 1, At, B1); PG8_BAR; PG8_SCHED;
            } else {
            PG8_LDB(B0, 0, 0); PG8_SCHED; PG8_LDA(At, 0, 0); PG8_STAGE(PG8_SA(1, 1), a1 + hstep, voffA);
            PG8_WAIT_L(8); PG8_BAR; PG8_WAIT_L(0); PG8_MMA(0, 0, At, B0); PG8_BAR; PG8_SCHED;
            PG8_LDB(B1, 0, 1); PG8_STAGE(PG8_SB(0, 0), b2, voffB);
            PG8_BAR; PG8_WAIT_L(0); PG8_MMA(0, 1, At, B1); PG8_BAR;
            PG8_LDA(At, 0, 1); PG8_STAGE(PG8_SA(0, 0), a2, voffA);
            PG8_BAR; PG8_WAIT_L(0); PG8_MMA(1, 0, At, B0); PG8_BAR; PG8_SCHED;
            PG8_STAGE(PG8_SB(0, 1), b2 + hstepB, voffB);
            PG8_WAIT_V(6); PG8_BAR; PG8_MMA(1, 1, At, B1); PG8_BAR;
            PG8_LDB(B0, 1, 0); PG8_SCHED; PG8_LDA(At, 1, 0); PG8_STAGE(PG8_SA(0, 1), a2 + hstep, voffA);
            PG8_WAIT_L(8); PG8_BAR; PG8_WAIT_L(0); PG8_MMA(0, 0, At, B0); PG8_BAR; PG8_SCHED;
            PG8_LDB(B1, 1, 1); PG8_STAGE(PG8_SB(1, 0), b3, voffB);
            PG8_BAR; PG8_WAIT_L(0); PG8_MMA(0, 1, At, B1); PG8_BAR;
            PG8_LDA(At, 1, 1); PG8_STAGE(PG8_SA(1, 0), a3, voffA);
            PG8_BAR; PG8_WAIT_L(0); PG8_MMA(1, 0, At, B0); PG8_BAR; PG8_SCHED;
            PG8_STAGE(PG8_SB(1, 1), b3 + hstepB, voffB);
            PG8_WAIT_V(6); PG8_BAR; PG8_MMA(1, 1, At, B1); PG8_BAR;
            }
        }
        if constexpr (ALIGN_EPI) { if (wr == 0) PG8_BAR; }
        if constexpr (F8) { asm volatile("s_nop 15\n\ts_nop 15" ::: "memory"); }
        if constexpr (!Epi::AFTER_DRAIN) { const int le_ = fresh_lane(); E(acc, cur, wr, wc, le_ & 15, le_ >> 4); S.done(cur); }
        if (!has_next) break;
#pragma unroll
        for (int a = 0; a < 2; ++a)
#pragma unroll
            for (int b = 0; b < 2; ++b)
#pragma unroll
                for (int m = 0; m < 4; ++m)
#pragma unroll
                    for (int n = 0; n < 2; ++n) acc[a][b][m][n] = (f32x4){0.f, 0.f, 0.f, 0.f};
        if constexpr (F8) { asm volatile("s_nop 7" ::: "memory"); }
        cur = nxt; cA = nA; cB = nB; ++ui;
        if constexpr (ALIGN_EPI) { if (wr == 1) PG8_BAR; }
    }
    PG8_WAIT_V(0);
    if constexpr (!ALIGN_EPI) { if (wr == 0) PG8_BAR; }
    PG8_BAR;
    if constexpr (Epi::AFTER_DRAIN) { E.fused(acc, cur, wr, wc, fr, fq, lds, wid, lane); S.done(cur); }
#undef PG8_SA
#undef PG8_SB
#undef PG8_STAGE
#undef PG8_LDA
#undef PG8_LDB
#undef PG8_MMA
#undef PG8_WAIT_V
#undef PG8_WAIT_L
#undef PG8_BAR
#undef PG8_SCHED
}

}

namespace attn {
constexpr int D = 128; constexpr float THR = 8.f; constexpr bool WSKIP = false;
constexpr float SCALE = 0.08838834764831845f;
constexpr int NW = 8, QBLK = 32, KVBLK = 64, QB = NW * QBLK;
constexpr int DV = 256;
constexpr int SHM_V = KVBLK * DV * 2, SHM_K = KVBLK * D * 2;
constexpr int LDS_BYTES = 2 * SHM_V + 2 * SHM_K + NW * 64 * 4;

using bf16 = __hip_bfloat16;
typedef short bf16x8 __attribute__((ext_vector_type(8)));
typedef short s16x4 __attribute__((ext_vector_type(4)));
typedef float f32x16 __attribute__((ext_vector_type(16)));
typedef float f32x4 __attribute__((ext_vector_type(4)));
typedef unsigned u32x4 __attribute__((ext_vector_type(4)));
template <class A, class Bt> struct same_t { static constexpr bool v = false; };
template <class A> struct same_t<A, A> { static constexpr bool v = true; };

#define KSWZ(row, colB) ((row) * 256 + ((colB) ^ (((row) & 7) << 4)))
#define SBAR() __builtin_amdgcn_sched_barrier(0)
__device__ __forceinline__ int v_st(int k, int c) { const int kk = (k & ~0xC) | ((k & 4) << 1) | ((k & 8) >> 1); return ((kk >> 3) * 4 + (c >> 5)) * 512 + ((kk & 7) * 32 + (c & 31)) * 2; }
__device__ __forceinline__ int v_rd_base(int lane) { return ((lane & 3) << 3) | (((lane >> 2) & 3) << 6) | (((lane >> 4) & 1) << 5) | (((lane >> 5) & 1) << 8); }
constexpr int v_rd_off(int d0, int ks, int half) { return d0 * 512 + ks * 4096 + half * 2048; }
__device__ __forceinline__ int crow(int r, int hi) { return (r & 3) + 8 * (r >> 2) + 4 * hi; }
__device__ __forceinline__ unsigned cvtpk(float lo, float hi) {
    unsigned r; asm volatile("v_cvt_pk_bf16_f32 %0, %1, %2" : "=v"(r) : "v"(lo), "v"(hi)); return r;
}
__device__ __forceinline__ bf16x8 pack8(f32x4 a, f32x4 b) {
    u32x4 w = {cvtpk(a[0], a[1]), cvtpk(a[2], a[3]), cvtpk(b[0], b[1]), cvtpk(b[2], b[3])};
    return *reinterpret_cast<bf16x8*>(&w);
}
template <class T> __device__ __forceinline__ bf16x8 load8(const T* p) {
    if constexpr (same_t<T, float>::v) { return pack8(*(const f32x4*)p, *(const f32x4*)(p + 4)); }
    else { return *reinterpret_cast<const bf16x8*>(p); }
}
__device__ __forceinline__ void mask_tile(f32x16& p0, f32x16& p1, int dq, unsigned W) {
    const float NEG = -__builtin_inff();
#pragma unroll
    for (int r = 0; r < 16; ++r) {
        const int c = (r & 3) + 8 * (r >> 2);
        if ((unsigned)(dq - c) >= W) p0[r] = NEG;
        if ((unsigned)(dq - c - 32) >= W) p1[r] = NEG;
    }
}
__device__ __forceinline__ void partialSM(f32x16& p0, f32x16& p1, float& m_reg, float& mn, float& alpha) {
    float pmax = p0[0]; for (int r = 1; r < 16; ++r) pmax = fmaxf(pmax, p0[r]); for (int r = 0; r < 16; ++r) pmax = fmaxf(pmax, p1[r]);
    { auto rr = __builtin_amdgcn_permlane32_swap(__float_as_uint(pmax), __float_as_uint(pmax), false, false);
      pmax = fmaxf(__uint_as_float(rr[0]), __uint_as_float(rr[1])); }
    constexpr float C2 = 1.4426950408889634f * SCALE;
    if (__builtin_expect(__all((pmax - m_reg) * SCALE <= THR), 1)) { mn = m_reg; alpha = 1.f; }
    else { mn = fmaxf(m_reg, pmax); alpha = __builtin_amdgcn_exp2f((m_reg - mn) * C2); m_reg = mn; }
    const float mnL = -mn * C2;
    for (int r = 0; r < 16; ++r) p0[r] = fmaf(p0[r], C2, mnL); for (int r = 0; r < 16; ++r) p1[r] = fmaf(p1[r], C2, mnL);
    for (int r = 0; r < 16; ++r) p0[r] = __builtin_amdgcn_exp2f(p0[r]);
}
__device__ __forceinline__ void finishSM(f32x16& p0, f32x16& p1, float alpha, float& l_reg, bf16x8& pa0, bf16x8& pa1, bf16x8& pa2, bf16x8& pa3) {
    for (int r = 0; r < 16; ++r) p1[r] = __builtin_amdgcn_exp2f(p1[r]);
    float ps = 0; for (int r = 0; r < 16; ++r) ps += p0[r]; for (int r = 0; r < 16; ++r) ps += p1[r];
    { auto rr = __builtin_amdgcn_permlane32_swap(__float_as_uint(ps), __float_as_uint(ps), false, false);
      ps = __uint_as_float(rr[0]) + __uint_as_float(rr[1]); }
    l_reg = l_reg * alpha + ps;
#define PK4(P, B_, OUT) do { unsigned a0 = cvtpk(P[B_+0], P[B_+1]), a1 = cvtpk(P[B_+2], P[B_+3]);                          \
        unsigned b0 = cvtpk(P[B_+4], P[B_+5]), b1 = cvtpk(P[B_+6], P[B_+7]);                                             \
        auto r0 = __builtin_amdgcn_permlane32_swap(a0, b0, false, false); auto r1 = __builtin_amdgcn_permlane32_swap(a1, b1, false, false); \
        u32x4 w = {r0[0], r1[0], r0[1], r1[1]}; OUT = *reinterpret_cast<bf16x8*>(&w); } while (0)
    PK4(p0, 0, pa0); PK4(p0, 8, pa1); PK4(p1, 0, pa2); PK4(p1, 8, pa3);
#undef PK4
}
template <int KB, bool SK>
__device__ __forceinline__ void qkt(f32x16& p0, f32x16& p1, const char* K_lds, int r32, int hi, const bf16x8* qr, bool act) {
    if (SK && !act) { const float NEG = -__builtin_inff();
#pragma unroll
        for (int r = 0; r < 16; ++r) { p0[r] = NEG; p1[r] = NEG; } return; }
    p0 = f32x16{}; p1 = f32x16{};
    const char* kb[4];
#pragma unroll
    for (int dd = 0; dd < 4; ++dd) kb[dd] = K_lds + KB * SHM_K + KSWZ(r32, (dd * 16 + hi * 8) * 2);
#pragma unroll
    for (int d0 = 0; d0 < 8; ++d0) { const char* a = kb[d0 & 3] + (d0 >> 2) * 128;
        bf16x8 b0 = *reinterpret_cast<const bf16x8*>(a);
        bf16x8 b1 = *reinterpret_cast<const bf16x8*>(a + 32 * 256);
        p0 = __builtin_amdgcn_mfma_f32_32x32x16_bf16(b0, qr[d0], p0, 0, 0, 0);
        p1 = __builtin_amdgcn_mfma_f32_32x32x16_bf16(b1, qr[d0], p1, 0, 0, 0); }
}


#define AT2_LAS __attribute__((address_space(3)))
template <int VB>
__device__ __forceinline__ void pv_tile8(f32x16* o, const AT2_LAS char* vb, bf16x8 pa0, bf16x8 pa1, bf16x8 pa2, bf16x8 pa3) {
#define TRR(off) __builtin_amdgcn_ds_read_tr16_b64_v4i16((AT2_LAS s16x4*)(vb + (off)))
#pragma unroll
    for (int d0 = 0; d0 < 8; ++d0) { const int b_ = VB * SHM_V + d0 * 512;
        const s16x4 l0 = TRR(b_), h0 = TRR(b_ + 4096), l1 = TRR(b_ + 8192), h1 = TRR(b_ + 12288), l2 = TRR(b_ + 16384), h2 = TRR(b_ + 20480), l3 = TRR(b_ + 24576), h3 = TRR(b_ + 28672);
        o[d0] = __builtin_amdgcn_mfma_f32_32x32x16_bf16(pa0, (bf16x8){l0[0], l0[1], l0[2], l0[3], h0[0], h0[1], h0[2], h0[3]}, o[d0], 0, 0, 0);
        o[d0] = __builtin_amdgcn_mfma_f32_32x32x16_bf16(pa1, (bf16x8){l1[0], l1[1], l1[2], l1[3], h1[0], h1[1], h1[2], h1[3]}, o[d0], 0, 0, 0);
        o[d0] = __builtin_amdgcn_mfma_f32_32x32x16_bf16(pa2, (bf16x8){l2[0], l2[1], l2[2], l2[3], h2[0], h2[1], h2[2], h2[3]}, o[d0], 0, 0, 0);
        o[d0] = __builtin_amdgcn_mfma_f32_32x32x16_bf16(pa3, (bf16x8){l3[0], l3[1], l3[2], l3[3], h3[0], h3[1], h3[2], h3[3]}, o[d0], 0, 0, 0); }
#undef TRR
}
__device__ __forceinline__ void softmax_main(f32x16& p0, f32x16& p1, float& m_reg, float& alpha, float& ps) {
    float pmax = p0[0];
#pragma unroll
    for (int r = 1; r < 16; ++r) pmax = fmaxf(pmax, p0[r]);
#pragma unroll
    for (int r = 0; r < 16; ++r) pmax = fmaxf(pmax, p1[r]);
    { auto rr = __builtin_amdgcn_permlane32_swap(__float_as_uint(pmax), __float_as_uint(pmax), false, false);
      pmax = fmaxf(__uint_as_float(rr[0]), __uint_as_float(rr[1])); }
    constexpr float C2 = 1.4426950408889634f * SCALE;
    const bool keep = __all((pmax - m_reg) * SCALE <= THR);
    const float mn = keep ? m_reg : fmaxf(m_reg, pmax);
    alpha = __builtin_amdgcn_exp2f((m_reg - mn) * C2);
    m_reg = mn;
    const float mnL = -mn * C2;
#pragma unroll
    for (int r = 0; r < 16; ++r) { p0[r] = __builtin_amdgcn_exp2f(fmaf(p0[r], C2, mnL)); p1[r] = __builtin_amdgcn_exp2f(fmaf(p1[r], C2, mnL)); }
    float s = 0.f;
#pragma unroll
    for (int r = 0; r < 16; ++r) s += p0[r];
#pragma unroll
    for (int r = 0; r < 16; ++r) s += p1[r];
    { auto rr = __builtin_amdgcn_permlane32_swap(__float_as_uint(s), __float_as_uint(s), false, false);
      ps = __uint_as_float(rr[0]) + __uint_as_float(rr[1]); }
}
__device__ __forceinline__ void pack_p(const f32x16& p0, const f32x16& p1, bf16x8& pa0, bf16x8& pa1, bf16x8& pa2, bf16x8& pa3) {
#define PK4(P, B_, OUT) do { unsigned a0 = cvtpk(P[B_+0], P[B_+1]), a1 = cvtpk(P[B_+2], P[B_+3]);                          \
        unsigned b0 = cvtpk(P[B_+4], P[B_+5]), b1 = cvtpk(P[B_+6], P[B_+7]);                                             \
        auto r0 = __builtin_amdgcn_permlane32_swap(a0, b0, false, false); auto r1 = __builtin_amdgcn_permlane32_swap(a1, b1, false, false); \
        u32x4 w = {r0[0], r1[0], r0[1], r1[1]}; OUT = *reinterpret_cast<bf16x8*>(&w); } while (0)
    PK4(p0, 0, pa0); PK4(p0, 8, pa1); PK4(p1, 0, pa2); PK4(p1, 8, pa3);
#undef PK4
}
struct Block2 { const bf16* Q; const bf16* K; const bf16* V; unsigned short* O; int P0; };
__device__ __forceinline__ void attn_block2(const Block2& cur, char* lds, AT2_LAS unsigned char* L, const int wave_id) {
    const int lane = fresh_lane(), wid = wave_id, r32 = lane & 31, hi = lane >> 5;
    const int NT = (cur.P0 + QB - 1) / KVBLK + 1;
    const int qlo = cur.P0 + wid * QBLK;
    char* K_lds = lds + 2 * SHM_V;
    float* ws = (float*)(lds + 2 * SHM_V + 2 * SHM_K) + wid * 64; float* li_l = ws, * al_l = ws + 32;
#define AT2_GLDS(g, l) __builtin_amdgcn_global_load_lds((const unsigned*)(g), (AT2_LAS unsigned*)(l), 16, 0, 0)
#define AT2_DMA_K(t, b) do { const char* kg_ = (const char*)cur.K + (size_t)(t) * (KVBLK * D * 2); const unsigned ln_ = (unsigned)fresh_lane(), kr0 = 8u * wid + (ln_ >> 4), kr1 = kr0 + 4u; \
        const unsigned koff0 = kr0 * 256u + (((ln_ & 15u) ^ (kr0 & 7u)) << 4), koff1 = kr1 * 256u + (((ln_ & 15u) ^ (kr1 & 7u)) << 4); \
        AT2_GLDS(kg_ + koff0, L + 2 * SHM_V + (b) * SHM_K + (2 * wid) * 1024); AT2_GLDS(kg_ + koff1, L + 2 * SHM_V + (b) * SHM_K + (2 * wid + 1) * 1024); } while (0)
#define AT2_DMA_V(t, b) do { const char* vg_ = (const char*)cur.V + (size_t)(t) * (KVBLK * DV * 2); const unsigned ln_ = (unsigned)fresh_lane(), kkv = 8u * wid + ((ln_ & 31u) >> 2); \
        const unsigned keyv = (kkv & ~0xCu) | ((kkv & 4u) << 1) | ((kkv & 8u) >> 1), voff = keyv * 512u + (ln_ >> 5) * 64u + (ln_ & 3u) * 16u; \
        _Pragma("unroll") for (int i_ = 0; i_ < 4; ++i_) AT2_GLDS(vg_ + i_ * 128 + voff, L + (b) * SHM_V + (4 * wid + i_) * 1024); } while (0)
    bf16x8 qr[8];
#pragma unroll
    for (int d0 = 0; d0 < 8; ++d0) qr[d0] = load8<bf16>(cur.Q + (size_t)(wid * QBLK + r32) * D + d0 * 16 + hi * 8);
    AT2_DMA_K(0, 0);
    float m_reg = -1e30f, l_reg = 0; f32x16 o[8] = {};
    f32x16 p0, p1; float al, ps; bf16x8 pa0, pa1, pa2, pa3;
#define RESC(a) do { if (__any((a) < 1.f)) { const int lr_ = fresh_lane(), hr_ = lr_ >> 5; if (hr_ == 0) al_l[lr_ & 31] = (a); asm volatile("s_waitcnt lgkmcnt(0)" ::: "memory");              \
                     for (int d_ = 0; d_ < 8; ++d_) for (int r = 0; r < 16; ++r) o[d_][r] *= al_l[crow(r, hr_)]; } } while (0)
#define AT2_TRR(off) __builtin_amdgcn_ds_read_tr16_b64_v4i16((AT2_LAS s16x4*)(vb + (off)))
#define MX3(a_, b_, c_) fmaxf(fmaxf((a_), (b_)), (c_))
#define AT2_PK4(P, B_, OUT) do { unsigned a0_ = cvtpk(P[B_+0], P[B_+1]), a1_ = cvtpk(P[B_+2], P[B_+3]), b0_ = cvtpk(P[B_+4], P[B_+5]), b1_ = cvtpk(P[B_+6], P[B_+7]); \
        auto r0_ = __builtin_amdgcn_permlane32_swap(a0_, b0_, false, false); auto r1_ = __builtin_amdgcn_permlane32_swap(a1_, b1_, false, false); \
        u32x4 w_ = {r0_[0], r1_[0], r0_[1], r1_[1]}; OUT = *reinterpret_cast<bf16x8*>(&w_); } while (0)
#define AT2_PV_SM(VB) do { const AT2_LAS char* vb = (const AT2_LAS char*)L + v_rd_base(fresh_lane()); constexpr float C2_ = 1.4426950408889634f * SCALE; float mxa, mxb, mnL_; ps = 0.f; s16x4 fl0, fh0, fl1, fh1, fl2, fh2, fl3, fh3; \
        constexpr int vbo_ = (VB) * SHM_V; \
        fl0 = AT2_TRR(vbo_ + 0); fh0 = AT2_TRR(vbo_ + 4096); \
        fl1 = AT2_TRR(vbo_ + 8192); fh1 = AT2_TRR(vbo_ + 12288); \
        fl2 = AT2_TRR(vbo_ + 16384); fh2 = AT2_TRR(vbo_ + 20480); \
        fl3 = AT2_TRR(vbo_ + 24576); fh3 = AT2_TRR(vbo_ + 28672); \
        SBAR(); \
        o[0] = __builtin_amdgcn_mfma_f32_32x32x16_bf16(pa0, (bf16x8){fl0[0], fl0[1], fl0[2], fl0[3], fh0[0], fh0[1], fh0[2], fh0[3]}, o[0], 0, 0, 0); fl0 = AT2_TRR(vbo_ + 512); fh0 = AT2_TRR(vbo_ + 4608); mxa = MX3(p0[0], p0[1], p0[2]); mxb = MX3(p1[0], p1[1], p1[2]); mxa = MX3(mxa, p0[3], p0[4]); mxb = MX3(mxb, p1[3], p1[4]); SBAR(); \
        o[0] = __builtin_amdgcn_mfma_f32_32x32x16_bf16(pa1, (bf16x8){fl1[0], fl1[1], fl1[2], fl1[3], fh1[0], fh1[1], fh1[2], fh1[3]}, o[0], 0, 0, 0); fl1 = AT2_TRR(vbo_ + 8704); fh1 = AT2_TRR(vbo_ + 12800); mxa = MX3(mxa, p0[5], p0[6]); mxb = MX3(mxb, p1[5], p1[6]); mxa = MX3(mxa, p0[7], p0[8]); mxb = MX3(mxb, p1[7], p1[8]); SBAR(); \
        o[0] = __builtin_amdgcn_mfma_f32_32x32x16_bf16(pa2, (bf16x8){fl2[0], fl2[1], fl2[2], fl2[3], fh2[0], fh2[1], fh2[2], fh2[3]}, o[0], 0, 0, 0); fl2 = AT2_TRR(vbo_ + 16896); fh2 = AT2_TRR(vbo_ + 20992); mxa = MX3(mxa, p0[9], p0[10]); mxb = MX3(mxb, p1[9], p1[10]); mxa = MX3(mxa, p0[11], p0[12]); mxb = MX3(mxb, p1[11], p1[12]); SBAR(); \
        o[0] = __builtin_amdgcn_mfma_f32_32x32x16_bf16(pa3, (bf16x8){fl3[0], fl3[1], fl3[2], fl3[3], fh3[0], fh3[1], fh3[2], fh3[3]}, o[0], 0, 0, 0); fl3 = AT2_TRR(vbo_ + 25088); fh3 = AT2_TRR(vbo_ + 29184); mxa = MX3(mxa, p0[13], p0[14]); mxb = MX3(mxb, p1[13], p1[14]); mxa = fmaxf(mxa, p0[15]); mxb = fmaxf(mxb, p1[15]); SBAR(); \
        o[1] = __builtin_amdgcn_mfma_f32_32x32x16_bf16(pa0, (bf16x8){fl0[0], fl0[1], fl0[2], fl0[3], fh0[0], fh0[1], fh0[2], fh0[3]}, o[1], 0, 0, 0); fl0 = AT2_TRR(vbo_ + 1024); fh0 = AT2_TRR(vbo_ + 5120); mxa = fmaxf(mxa, mxb); { auto rr_ = __builtin_amdgcn_permlane32_swap(__float_as_uint(mxa), __float_as_uint(mxa), false, false); mxa = fmaxf(__uint_as_float(rr_[0]), __uint_as_float(rr_[1])); } SBAR(); \
        o[1] = __builtin_amdgcn_mfma_f32_32x32x16_bf16(pa1, (bf16x8){fl1[0], fl1[1], fl1[2], fl1[3], fh1[0], fh1[1], fh1[2], fh1[3]}, o[1], 0, 0, 0); fl1 = AT2_TRR(vbo_ + 9216); fh1 = AT2_TRR(vbo_ + 13312); { const bool keep_ = __all((mxa - m_reg) * SCALE <= THR); const float mn_ = keep_ ? m_reg : fmaxf(m_reg, mxa); al = __builtin_amdgcn_exp2f((m_reg - mn_) * C2_); m_reg = mn_; mnL_ = -mn_ * C2_; } SBAR(); \
        o[1] = __builtin_amdgcn_mfma_f32_32x32x16_bf16(pa2, (bf16x8){fl2[0], fl2[1], fl2[2], fl2[3], fh2[0], fh2[1], fh2[2], fh2[3]}, o[1], 0, 0, 0); fl2 = AT2_TRR(vbo_ + 17408); fh2 = AT2_TRR(vbo_ + 21504); p0[0] = __builtin_amdgcn_exp2f(fmaf(p0[0], C2_, mnL_)); p0[1] = __builtin_amdgcn_exp2f(fmaf(p0[1], C2_, mnL_)); SBAR(); \
        o[1] = __builtin_amdgcn_mfma_f32_32x32x16_bf16(pa3, (bf16x8){fl3[0], fl3[1], fl3[2], fl3[3], fh3[0], fh3[1], fh3[2], fh3[3]}, o[1], 0, 0, 0); fl3 = AT2_TRR(vbo_ + 25600); fh3 = AT2_TRR(vbo_ + 29696); ps += p0[0]; ps += p0[1]; p0[2] = __builtin_amdgcn_exp2f(fmaf(p0[2], C2_, mnL_)); SBAR(); \
        o[2] = __builtin_amdgcn_mfma_f32_32x32x16_bf16(pa0, (bf16x8){fl0[0], fl0[1], fl0[2], fl0[3], fh0[0], fh0[1], fh0[2], fh0[3]}, o[2], 0, 0, 0); fl0 = AT2_TRR(vbo_ + 1536); fh0 = AT2_TRR(vbo_ + 5632); ps += p0[2]; p0[3] = __builtin_amdgcn_exp2f(fmaf(p0[3], C2_, mnL_)); p0[4] = __builtin_amdgcn_exp2f(fmaf(p0[4], C2_, mnL_)); SBAR(); \
        o[2] = __builtin_amdgcn_mfma_f32_32x32x16_bf16(pa1, (bf16x8){fl1[0], fl1[1], fl1[2], fl1[3], fh1[0], fh1[1], fh1[2], fh1[3]}, o[2], 0, 0, 0); fl1 = AT2_TRR(vbo_ + 9728); fh1 = AT2_TRR(vbo_ + 13824); ps += p0[3]; ps += p0[4]; p0[5] = __builtin_amdgcn_exp2f(fmaf(p0[5], C2_, mnL_)); SBAR(); \
        o[2] = __builtin_amdgcn_mfma_f32_32x32x16_bf16(pa2, (bf16x8){fl2[0], fl2[1], fl2[2], fl2[3], fh2[0], fh2[1], fh2[2], fh2[3]}, o[2], 0, 0, 0); fl2 = AT2_TRR(vbo_ + 17920); fh2 = AT2_TRR(vbo_ + 22016); ps += p0[5]; p0[6] = __builtin_amdgcn_exp2f(fmaf(p0[6], C2_, mnL_)); p0[7] = __builtin_amdgcn_exp2f(fmaf(p0[7], C2_, mnL_)); SBAR(); \
        o[2] = __builtin_amdgcn_mfma_f32_32x32x16_bf16(pa3, (bf16x8){fl3[0], fl3[1], fl3[2], fl3[3], fh3[0], fh3[1], fh3[2], fh3[3]}, o[2], 0, 0, 0); fl3 = AT2_TRR(vbo_ + 26112); fh3 = AT2_TRR(vbo_ + 30208); ps += p0[6]; ps += p0[7]; p0[8] = __builtin_amdgcn_exp2f(fmaf(p0[8], C2_, mnL_)); SBAR(); \
        o[3] = __builtin_amdgcn_mfma_f32_32x32x16_bf16(pa0, (bf16x8){fl0[0], fl0[1], fl0[2], fl0[3], fh0[0], fh0[1], fh0[2], fh0[3]}, o[3], 0, 0, 0); fl0 = AT2_TRR(vbo_ + 2048); fh0 = AT2_TRR(vbo_ + 6144); ps += p0[8]; p0[9] = __builtin_amdgcn_exp2f(fmaf(p0[9], C2_, mnL_)); p0[10] = __builtin_amdgcn_exp2f(fmaf(p0[10], C2_, mnL_)); SBAR(); \
        o[3] = __builtin_amdgcn_mfma_f32_32x32x16_bf16(pa1, (bf16x8){fl1[0], fl1[1], fl1[2], fl1[3], fh1[0], fh1[1], fh1[2], fh1[3]}, o[3], 0, 0, 0); fl1 = AT2_TRR(vbo_ + 10240); fh1 = AT2_TRR(vbo_ + 14336); ps += p0[9]; ps += p0[10]; p0[11] = __builtin_amdgcn_exp2f(fmaf(p0[11], C2_, mnL_)); SBAR(); \
        o[3] = __builtin_amdgcn_mfma_f32_32x32x16_bf16(pa2, (bf16x8){fl2[0], fl2[1], fl2[2], fl2[3], fh2[0], fh2[1], fh2[2], fh2[3]}, o[3], 0, 0, 0); fl2 = AT2_TRR(vbo_ + 18432); fh2 = AT2_TRR(vbo_ + 22528); ps += p0[11]; p0[12] = __builtin_amdgcn_exp2f(fmaf(p0[12], C2_, mnL_)); p0[13] = __builtin_amdgcn_exp2f(fmaf(p0[13], C2_, mnL_)); SBAR(); \
        o[3] = __builtin_amdgcn_mfma_f32_32x32x16_bf16(pa3, (bf16x8){fl3[0], fl3[1], fl3[2], fl3[3], fh3[0], fh3[1], fh3[2], fh3[3]}, o[3], 0, 0, 0); fl3 = AT2_TRR(vbo_ + 26624); fh3 = AT2_TRR(vbo_ + 30720); ps += p0[12]; ps += p0[13]; p0[14] = __builtin_amdgcn_exp2f(fmaf(p0[14], C2_, mnL_)); SBAR(); \
        o[4] = __builtin_amdgcn_mfma_f32_32x32x16_bf16(pa0, (bf16x8){fl0[0], fl0[1], fl0[2], fl0[3], fh0[0], fh0[1], fh0[2], fh0[3]}, o[4], 0, 0, 0); fl0 = AT2_TRR(vbo_ + 2560); fh0 = AT2_TRR(vbo_ + 6656); ps += p0[14]; p0[15] = __builtin_amdgcn_exp2f(fmaf(p0[15], C2_, mnL_)); p1[0] = __builtin_amdgcn_exp2f(fmaf(p1[0], C2_, mnL_)); SBAR(); \
        o[4] = __builtin_amdgcn_mfma_f32_32x32x16_bf16(pa1, (bf16x8){fl1[0], fl1[1], fl1[2], fl1[3], fh1[0], fh1[1], fh1[2], fh1[3]}, o[4], 0, 0, 0); fl1 = AT2_TRR(vbo_ + 10752); fh1 = AT2_TRR(vbo_ + 14848); ps += p0[15]; ps += p1[0]; p1[1] = __builtin_amdgcn_exp2f(fmaf(p1[1], C2_, mnL_)); SBAR(); \
        o[4] = __builtin_amdgcn_mfma_f32_32x32x16_bf16(pa2, (bf16x8){fl2[0], fl2[1], fl2[2], fl2[3], fh2[0], fh2[1], fh2[2], fh2[3]}, o[4], 0, 0, 0); fl2 = AT2_TRR(vbo_ + 18944); fh2 = AT2_TRR(vbo_ + 23040); ps += p1[1]; p1[2] = __builtin_amdgcn_exp2f(fmaf(p1[2], C2_, mnL_)); p1[3] = __builtin_amdgcn_exp2f(fmaf(p1[3], C2_, mnL_)); SBAR(); \
        o[4] = __builtin_amdgcn_mfma_f32_32x32x16_bf16(pa3, (bf16x8){fl3[0], fl3[1], fl3[2], fl3[3], fh3[0], fh3[1], fh3[2], fh3[3]}, o[4], 0, 0, 0); fl3 = AT2_TRR(vbo_ + 27136); fh3 = AT2_TRR(vbo_ + 31232); ps += p1[2]; ps += p1[3]; p1[4] = __builtin_amdgcn_exp2f(fmaf(p1[4], C2_, mnL_)); SBAR(); \
        o[5] = __builtin_amdgcn_mfma_f32_32x32x16_bf16(pa0, (bf16x8){fl0[0], fl0[1], fl0[2], fl0[3], fh0[0], fh0[1], fh0[2], fh0[3]}, o[5], 0, 0, 0); fl0 = AT2_TRR(vbo_ + 3072); fh0 = AT2_TRR(vbo_ + 7168); ps += p1[4]; p1[5] = __builtin_amdgcn_exp2f(fmaf(p1[5], C2_, mnL_)); p1[6] = __builtin_amdgcn_exp2f(fmaf(p1[6], C2_, mnL_)); SBAR(); \
        o[5] = __builtin_amdgcn_mfma_f32_32x32x16_bf16(pa1, (bf16x8){fl1[0], fl1[1], fl1[2], fl1[3], fh1[0], fh1[1], fh1[2], fh1[3]}, o[5], 0, 0, 0); fl1 = AT2_TRR(vbo_ + 11264); fh1 = AT2_TRR(vbo_ + 15360); ps += p1[5]; ps += p1[6]; p1[7] = __builtin_amdgcn_exp2f(fmaf(p1[7], C2_, mnL_)); SBAR(); \
        o[5] = __builtin_amdgcn_mfma_f32_32x32x16_bf16(pa2, (bf16x8){fl2[0], fl2[1], fl2[2], fl2[3], fh2[0], fh2[1], fh2[2], fh2[3]}, o[5], 0, 0, 0); fl2 = AT2_TRR(vbo_ + 19456); fh2 = AT2_TRR(vbo_ + 23552); ps += p1[7]; p1[8] = __builtin_amdgcn_exp2f(fmaf(p1[8], C2_, mnL_)); p1[9] = __builtin_amdgcn_exp2f(fmaf(p1[9], C2_, mnL_)); SBAR(); \
        o[5] = __builtin_amdgcn_mfma_f32_32x32x16_bf16(pa3, (bf16x8){fl3[0], fl3[1], fl3[2], fl3[3], fh3[0], fh3[1], fh3[2], fh3[3]}, o[5], 0, 0, 0); fl3 = AT2_TRR(vbo_ + 27648); fh3 = AT2_TRR(vbo_ + 31744); ps += p1[8]; ps += p1[9]; p1[10] = __builtin_amdgcn_exp2f(fmaf(p1[10], C2_, mnL_)); SBAR(); \
        o[6] = __builtin_amdgcn_mfma_f32_32x32x16_bf16(pa0, (bf16x8){fl0[0], fl0[1], fl0[2], fl0[3], fh0[0], fh0[1], fh0[2], fh0[3]}, o[6], 0, 0, 0); fl0 = AT2_TRR(vbo_ + 3584); fh0 = AT2_TRR(vbo_ + 7680); ps += p1[10]; p1[11] = __builtin_amdgcn_exp2f(fmaf(p1[11], C2_, mnL_)); p1[12] = __builtin_amdgcn_exp2f(fmaf(p1[12], C2_, mnL_)); SBAR(); \
        o[6] = __builtin_amdgcn_mfma_f32_32x32x16_bf16(pa1, (bf16x8){fl1[0], fl1[1], fl1[2], fl1[3], fh1[0], fh1[1], fh1[2], fh1[3]}, o[6], 0, 0, 0); fl1 = AT2_TRR(vbo_ + 11776); fh1 = AT2_TRR(vbo_ + 15872); ps += p1[11]; ps += p1[12]; p1[13] = __builtin_amdgcn_exp2f(fmaf(p1[13], C2_, mnL_)); SBAR(); \
        o[6] = __builtin_amdgcn_mfma_f32_32x32x16_bf16(pa2, (bf16x8){fl2[0], fl2[1], fl2[2], fl2[3], fh2[0], fh2[1], fh2[2], fh2[3]}, o[6], 0, 0, 0); fl2 = AT2_TRR(vbo_ + 19968); fh2 = AT2_TRR(vbo_ + 24064); ps += p1[13]; p1[14] = __builtin_amdgcn_exp2f(fmaf(p1[14], C2_, mnL_)); p1[15] = __builtin_amdgcn_exp2f(fmaf(p1[15], C2_, mnL_)); SBAR(); \
        o[6] = __builtin_amdgcn_mfma_f32_32x32x16_bf16(pa3, (bf16x8){fl3[0], fl3[1], fl3[2], fl3[3], fh3[0], fh3[1], fh3[2], fh3[3]}, o[6], 0, 0, 0); fl3 = AT2_TRR(vbo_ + 28160); fh3 = AT2_TRR(vbo_ + 32256); ps += p1[14]; ps += p1[15]; { auto rr_ = __builtin_amdgcn_permlane32_swap(__float_as_uint(ps), __float_as_uint(ps), false, false); ps = __uint_as_float(rr_[0]) + __uint_as_float(rr_[1]); } SBAR(); \
        o[7] = __builtin_amdgcn_mfma_f32_32x32x16_bf16(pa0, (bf16x8){fl0[0], fl0[1], fl0[2], fl0[3], fh0[0], fh0[1], fh0[2], fh0[3]}, o[7], 0, 0, 0); AT2_PK4(p0, 0, pa0); SBAR(); \
        o[7] = __builtin_amdgcn_mfma_f32_32x32x16_bf16(pa1, (bf16x8){fl1[0], fl1[1], fl1[2], fl1[3], fh1[0], fh1[1], fh1[2], fh1[3]}, o[7], 0, 0, 0); AT2_PK4(p0, 8, pa1); SBAR(); \
        o[7] = __builtin_amdgcn_mfma_f32_32x32x16_bf16(pa2, (bf16x8){fl2[0], fl2[1], fl2[2], fl2[3], fh2[0], fh2[1], fh2[2], fh2[3]}, o[7], 0, 0, 0); AT2_PK4(p1, 0, pa2); SBAR(); \
        o[7] = __builtin_amdgcn_mfma_f32_32x32x16_bf16(pa3, (bf16x8){fl3[0], fl3[1], fl3[2], fl3[3], fh3[0], fh3[1], fh3[2], fh3[3]}, o[7], 0, 0, 0); AT2_PK4(p1, 8, pa3); SBAR(); \
        } while (0)
#define AT2_LDK(p_) (*reinterpret_cast<const bf16x8*>(p_))
#define AT2_QKT_DMA(t, b) do { \
        const unsigned lq_ = (unsigned)fresh_lane(); const int r32_ = (int)(lq_ & 31u), hi_ = (int)(lq_ >> 5); \
        const char* vg_ = (const char*)cur.V + (size_t)(t) * (KVBLK * DV * 2); \
        const unsigned kkv_ = 8u * wid + ((lq_ & 31u) >> 2), keyv_ = (kkv_ & ~0xCu) | ((kkv_ & 4u) << 1) | ((kkv_ & 8u) >> 1), voff_ = keyv_ * 512u + (lq_ >> 5) * 64u + (lq_ & 3u) * 16u; \
        const bool hk_ = (t) + 1 < NT; const char* kg_ = (const char*)cur.K + (size_t)((t) + 1) * (KVBLK * D * 2); \
        const unsigned kr0_ = 8u * wid + (lq_ >> 4), koff0_ = kr0_ * 256u + (((lq_ & 15u) ^ (kr0_ & 7u)) << 4), koff1_ = (koff0_ + 1024u) ^ 64u; \
        const char* kq0_ = K_lds + (b) * SHM_K + KSWZ(r32_, (0 * 16 + hi_ * 8) * 2); const char* kq1_ = K_lds + (b) * SHM_K + KSWZ(r32_, (1 * 16 + hi_ * 8) * 2); \
        const char* kq2_ = K_lds + (b) * SHM_K + KSWZ(r32_, (2 * 16 + hi_ * 8) * 2); const char* kq3_ = K_lds + (b) * SHM_K + KSWZ(r32_, (3 * 16 + hi_ * 8) * 2); \
        p0 = f32x16{}; p1 = f32x16{}; bf16x8 ka0_, ka1_, kc0_, kc1_; \
        ka0_ = AT2_LDK(kq0_); ka1_ = AT2_LDK(kq0_ + 8192); \
        kc0_ = AT2_LDK(kq1_); kc1_ = AT2_LDK(kq1_ + 8192); p0 = __builtin_amdgcn_mfma_f32_32x32x16_bf16(ka0_, qr[0], p0, 0, 0, 0); p1 = __builtin_amdgcn_mfma_f32_32x32x16_bf16(ka1_, qr[0], p1, 0, 0, 0); SBAR(); AT2_GLDS(vg_ + 0 * 128 + voff_, L + (b) * SHM_V + (4 * wid + 0) * 1024); SBAR(); \
        ka0_ = AT2_LDK(kq2_); ka1_ = AT2_LDK(kq2_ + 8192); p0 = __builtin_amdgcn_mfma_f32_32x32x16_bf16(kc0_, qr[1], p0, 0, 0, 0); p1 = __builtin_amdgcn_mfma_f32_32x32x16_bf16(kc1_, qr[1], p1, 0, 0, 0); SBAR(); AT2_GLDS(vg_ + 1 * 128 + voff_, L + (b) * SHM_V + (4 * wid + 1) * 1024); SBAR(); \
        kc0_ = AT2_LDK(kq3_); kc1_ = AT2_LDK(kq3_ + 8192); p0 = __builtin_amdgcn_mfma_f32_32x32x16_bf16(ka0_, qr[2], p0, 0, 0, 0); p1 = __builtin_amdgcn_mfma_f32_32x32x16_bf16(ka1_, qr[2], p1, 0, 0, 0); SBAR(); AT2_GLDS(vg_ + 2 * 128 + voff_, L + (b) * SHM_V + (4 * wid + 2) * 1024); SBAR(); \
        ka0_ = AT2_LDK(kq0_ + 128); ka1_ = AT2_LDK(kq0_ + 128 + 8192); p0 = __builtin_amdgcn_mfma_f32_32x32x16_bf16(kc0_, qr[3], p0, 0, 0, 0); p1 = __builtin_amdgcn_mfma_f32_32x32x16_bf16(kc1_, qr[3], p1, 0, 0, 0); SBAR(); AT2_GLDS(vg_ + 3 * 128 + voff_, L + (b) * SHM_V + (4 * wid + 3) * 1024); SBAR(); \
        kc0_ = AT2_LDK(kq1_ + 128); kc1_ = AT2_LDK(kq1_ + 128 + 8192); p0 = __builtin_amdgcn_mfma_f32_32x32x16_bf16(ka0_, qr[4], p0, 0, 0, 0); p1 = __builtin_amdgcn_mfma_f32_32x32x16_bf16(ka1_, qr[4], p1, 0, 0, 0); SBAR(); if (hk_) AT2_GLDS(kg_ + koff0_, L + 2 * SHM_V + (1 - (b)) * SHM_K + (2 * wid) * 1024); SBAR(); \
        ka0_ = AT2_LDK(kq2_ + 128); ka1_ = AT2_LDK(kq2_ + 128 + 8192); p0 = __builtin_amdgcn_mfma_f32_32x32x16_bf16(kc0_, qr[5], p0, 0, 0, 0); p1 = __builtin_amdgcn_mfma_f32_32x32x16_bf16(kc1_, qr[5], p1, 0, 0, 0); SBAR(); if (hk_) AT2_GLDS(kg_ + koff1_, L + 2 * SHM_V + (1 - (b)) * SHM_K + (2 * wid + 1) * 1024); SBAR(); \
        kc0_ = AT2_LDK(kq3_ + 128); kc1_ = AT2_LDK(kq3_ + 128 + 8192); p0 = __builtin_amdgcn_mfma_f32_32x32x16_bf16(ka0_, qr[6], p0, 0, 0, 0); p1 = __builtin_amdgcn_mfma_f32_32x32x16_bf16(ka1_, qr[6], p1, 0, 0, 0); SBAR(); \
        p0 = __builtin_amdgcn_mfma_f32_32x32x16_bf16(kc0_, qr[7], p0, 0, 0, 0); p1 = __builtin_amdgcn_mfma_f32_32x32x16_bf16(kc1_, qr[7], p1, 0, 0, 0); SBAR(); \
        } while (0)
#define AT2_STEP(t, b, HASPV) do { \
        asm volatile("s_waitcnt vmcnt(0)" ::: "memory"); __builtin_amdgcn_s_barrier(); asm volatile("" ::: "memory");     \
        SBAR(); AT2_QKT_DMA((t), (b)); \
        { const int kb_ = (t) * KVBLK; if (kb_ + KVBLK - 1 > qlo) { const int lm_ = fresh_lane(); mask_tile(p0, p1, qlo + (lm_ & 31) - 4 * (lm_ >> 5) - kb_, 0x7fffffffu); } } \
        SBAR(); \
        if (HASPV) { AT2_PV_SM(1 - (b)); } else { softmax_main(p0, p1, m_reg, al, ps); } \
        SBAR(); \
        RESC(al); l_reg = l_reg * al + ps; if (!(HASPV)) pack_p(p0, p1, pa0, pa1, pa2, pa3); } while (0)
    AT2_STEP(0, 0, false);
    for (int t = 1; t + 1 < NT; t += 2) { AT2_STEP(t, 1, true); AT2_STEP(t + 1, 0, true); }
    AT2_STEP(NT - 1, 1, true);
    asm volatile("s_waitcnt vmcnt(0)" ::: "memory"); __builtin_amdgcn_s_barrier(); asm volatile("" ::: "memory");
    pv_tile8<1>(o, (const AT2_LAS char*)L + v_rd_base(fresh_lane()), pa0, pa1, pa2, pa3);
    const int l2_ = fresh_lane(), he_ = l2_ >> 5;
    if (he_ == 0) li_l[l2_ & 31] = l_reg; asm volatile("s_waitcnt lgkmcnt(0)" ::: "memory");
    float rli[16];
#pragma unroll
    for (int r = 0; r < 16; ++r) rli[r] = __builtin_amdgcn_rcpf(li_l[crow(r, he_)]);
    const int loff = 4 * (l2_ >> 5) * DV + (l2_ & 31);
    unsigned short* Ow = cur.O + (size_t)(wid * QBLK) * DV + loff;
    const bool even_ = (l2_ & 1) == 0;
#pragma unroll
    for (int r = 0; r < 16; ++r) { const int orow = (r & 3) + 8 * (r >> 2);
#pragma unroll
        for (int d0 = 0; d0 < 8; ++d0) { const float v = o[d0][r] * rli[r]; const float vn = __shfl_xor(v, 1);
            if (even_) *(unsigned*)(Ow + orow * DV + d0 * 32) = cvtpk(v, vn); } }
    __syncthreads();
#undef RESC
#undef AT2_PV_SM
#undef AT2_PK4
#undef MX3
#undef AT2_TRR
#undef AT2_STEP
#undef AT2_QKT_DMA
#undef AT2_LDK
#undef AT2_DMA_K
#undef AT2_DMA_V
#undef AT2_GLDS
}
}

#ifndef MK_N_LAUNCHES
#define MK_N_LAUNCHES 1
#endif
constexpr int N_LAUNCHES = MK_N_LAUNCHES, N_PHASES = 16;
constexpr int NWAVES = 8;

constexpr int S_ = 16384, DM = 2048, FF = 5632, DE = 7168, NE = 8, NHEAD = 8;
constexpr float NORM_EPS = 1e-6f, SUBLN_EPS = 1e-5f;
constexpr float LAMBDA_INIT = 0.35550906759096934f;
constexpr float SA_X = 16.f, SW_GU = 1024.f, SA_H = 16.f, SW_D = 2048.f, SA_HD = 16.f, SW_DD = 2048.f, SA_XD = 16.f, SW_GUD = 1024.f;
constexpr int CAP_ROWS = 2 * S_ + NE * 256;

constexpr size_t MiB = 1u << 20;
constexpr size_t WS_CTL = 0, CTL_ZERO_BYTES = 1 * MiB;
constexpr size_t WS_SS1 = 1 * MiB, WS_SS2 = WS_SS1 + 524288;
constexpr size_t WS_RS0 = 1 * MiB;
constexpr size_t WS_RS1 = 2 * MiB;
constexpr size_t WS_TOKI = WS_RS1 + 65536;
constexpr size_t WS_TOKG = WS_TOKI + 262144;
constexpr size_t WS_ROPE = 3 * MiB;
constexpr size_t WS_WPOOL = 11 * MiB;
constexpr size_t WS_WKVQ = 13 * MiB;
constexpr size_t WS_WO = 37 * MiB;
constexpr size_t WS_WGU = 45 * MiB;
constexpr size_t WS_WD = 89 * MiB;
constexpr size_t WS_WEGU = 111 * MiB;
constexpr size_t WS_WED = 559 * MiB;
constexpr size_t WS_X1 = 783 * MiB;
constexpr size_t WS_H = 911 * MiB;
constexpr size_t WS_SCR = 975 * MiB;
constexpr size_t WS_HID = WS_SCR, WS_MG = WS_SCR + 176 * MiB;
constexpr size_t WS_H2 = WS_SCR, WS_K16 = WS_SCR + 64 * MiB, WS_V16 = WS_SCR + 128 * MiB, WS_Q16 = WS_SCR + 192 * MiB, WS_O32 = WS_SCR + 256 * MiB, WS_ON = WS_SCR + 512 * MiB;
constexpr size_t WS_HIDE = WS_SCR, WS_XG = WS_SCR + 476 * MiB, WS_Y = WS_SCR + 476 * MiB;
constexpr size_t WS_YPART = WS_SCR + 300 * MiB;
constexpr size_t WS_END = WS_SCR + 748 * MiB;
static_assert((size_t)CAP_ROWS * DE * 2 == 476 * MiB && (size_t)CAP_ROWS * DM * 4 == 272 * MiB, "expert buffers");
constexpr int CW_TMO = 0, CW_BAR = 4096, CW_CNT = 8192, CW_AQ = 9216, CW_KS = 12288, CW_BC = 16384;

constexpr int RING_BYTES = 131072, LDSCTL_OFF = 151552, MISC_OFF = LDSCTL_OFF + 320, LDS_BYTES = 155648;


#define GAS __attribute__((address_space(1)))
#define LAS __attribute__((address_space(3)))
typedef unsigned short bf16;
typedef unsigned v4u __attribute__((ext_vector_type(4)));
typedef unsigned v2u __attribute__((ext_vector_type(2)));
typedef float f32x4 __attribute__((ext_vector_type(4)));
typedef float f32x2 __attribute__((ext_vector_type(2)));
typedef int i32x4 __attribute__((ext_vector_type(4)));
typedef GAS unsigned gu32;
#define RLX_AGENT __ATOMIC_RELAXED, __HIP_MEMORY_SCOPE_AGENT
#define LDS_WAIT() asm volatile("s_waitcnt lgkmcnt(0)" ::: "memory")
#define VM_WAIT() asm volatile("s_waitcnt vmcnt(0)" ::: "memory")
__device__ __forceinline__ unsigned pk2(float lo, float hi) { return pg8::cvt_pk_bf16(lo, hi); }

#define XB_TMO      128
#define XB_XCNT(j)  (256  + 64 * (j))
#define XB_XSUB(j)  (1280 + 64 * (j))
#define XB_XGEN(j)  (2304 + 64 * (j))
#define XB_TOP      3328
#define XB_TOPGEN   3392
#define XCD_BAR_WORDS 3456
#define XB_SPIN_CAP (1u << 18)

__device__ __forceinline__ unsigned xb_ld(unsigned* p)              { return __hip_atomic_load(p, __ATOMIC_RELAXED, __HIP_MEMORY_SCOPE_AGENT); }
__device__ __forceinline__ unsigned xb_add(unsigned* p, unsigned v) { return __hip_atomic_fetch_add(p, v, __ATOMIC_RELAXED, __HIP_MEMORY_SCOPE_AGENT); }
__device__ __forceinline__ unsigned xb_xcc_id() { return (unsigned)__builtin_amdgcn_s_getreg((3 << 11) | 20) & 0xFu; }
#define XB_SPIN(cond, bar) do { unsigned _sp = 0; while (cond) { __builtin_amdgcn_s_sleep(1); \
    if ((++_sp & 255u) == 0u) { if (xb_ld(&(bar)[XB_TMO])) break; if (_sp > XB_SPIN_CAP) { atomicAdd(&(bar)[XB_TMO], 1u); break; } } } } while (0)

struct XcdBarrier {
    unsigned* bar; unsigned x; int w;
    volatile LAS unsigned* st;
};

__device__ __forceinline__ XcdBarrier xcd_barrier_post(unsigned* bar, volatile LAS unsigned* st, int wave_id) {
    XcdBarrier b; b.bar = bar; b.x = xb_xcc_id(); b.st = st; b.w = wave_id;
    if (threadIdx.x == 0) (void)xb_add(&bar[XB_XCNT(b.x)], 1u);
    return b;
}
__device__ __forceinline__ void xcd_barrier_complete(unsigned* bar, unsigned x, unsigned& nloc, unsigned& nx) {
    const unsigned G = gridDim.x * gridDim.y * gridDim.z;
    unsigned sum, cnt, mine, sp = 0u;
    for (;;) {
        sum = 0u; cnt = 0u; mine = 0u;
#pragma unroll
        for (unsigned j = 0; j < 16; ++j) { const unsigned c = xb_ld(&bar[XB_XCNT(j)]); sum += c; cnt += (c > 0u) ? 1u : 0u; mine = (j == x) ? c : mine; }
        if (sum == G) break;
        __builtin_amdgcn_s_sleep(1);
        if ((++sp & 255u) == 0u) { if (xb_ld(&bar[XB_TMO])) break; if (sp > XB_SPIN_CAP) { atomicAdd(&bar[XB_TMO], 1u); break; } }
    }
    nloc = mine > 0u ? mine : 1u; nx = cnt > 0u ? cnt : 1u;
}

__device__ __forceinline__ void xcd_barrier(const XcdBarrier& b) {
    asm volatile("s_waitcnt vmcnt(0)" ::: "memory");
    __syncthreads();
    if (b.w == 0 && fresh_lane() == 0) {
        unsigned* bar = b.bar;
        __builtin_amdgcn_s_waitcnt(0);
        unsigned nloc = b.st[0], nx = b.st[1];
        if (nloc == 0u) { xcd_barrier_complete(bar, b.x, nloc, nx); b.st[0] = nloc; b.st[1] = nx; }
        const unsigned old = xb_add(&bar[XB_XSUB(b.x)], 1u);
        const unsigned gen = old / nloc;
        if (old + 1u == (gen + 1u) * nloc) {
            __builtin_amdgcn_fence(__ATOMIC_RELEASE, "agent");
            asm volatile("s_waitcnt vmcnt(0)" ::: "memory");
            const unsigned og = xb_add(&bar[XB_TOP], 1u);
            const unsigned tg = og / nx;
            if (og + 1u == (tg + 1u) * nx) xb_add(&bar[XB_TOPGEN], 1u);
            else XB_SPIN(xb_ld(&bar[XB_TOPGEN]) == tg, bar);
            __builtin_amdgcn_fence(__ATOMIC_ACQUIRE, "agent");
            xb_add(&bar[XB_XGEN(b.x)], 1u);
            asm volatile("s_waitcnt vmcnt(0)" ::: "memory");
        } else {
            XB_SPIN(xb_ld(&bar[XB_XGEN(b.x)]) == gen, bar);
            __builtin_amdgcn_fence(__ATOMIC_ACQUIRE, "agent");
            asm volatile("s_waitcnt vmcnt(0)" ::: "memory");
        }
    }
    __syncthreads();
}

__device__ __forceinline__ float wave_sum(float v) {
#pragma unroll
    for (int o = 1; o < 64; o <<= 1) v += __shfl_xor(v, o);
    return v;
}
__device__ __forceinline__ float dot4(f32x4 a, f32x4 b) { return (a.x * b.x + a.y * b.y) + (a.z * b.z + a.w * b.w); }

__device__ __forceinline__ void tr_item(const float* W, int N, int k0, int n0, bf16* dst, int ldd, LAS float* scr, int lane) {
    const float* src = W + (size_t)(k0 + (lane >> 4)) * N + n0 + 4 * (lane & 15);
    f32x4 v[16];
#pragma unroll
    for (int i = 0; i < 16; ++i) v[i] = *(const f32x4*)(src + (size_t)(4 * i) * N);
#pragma unroll
    for (int i = 0; i < 16; ++i) { LAS float* p = scr + (4 * i + (lane >> 4)) * 65 + 4 * (lane & 15); p[0] = v[i].x; p[1] = v[i].y; p[2] = v[i].z; p[3] = v[i].w; }
    LDS_WAIT(); asm volatile("" ::: "memory");
    const int c = lane & 7;
#pragma unroll
    for (int q = 0; q < 8; ++q) { const int n = (lane >> 3) + 8 * q; const LAS float* s = scr + (8 * c) * 65 + n;
        v4u o; o.x = pk2(s[0 * 65], s[1 * 65]); o.y = pk2(s[2 * 65], s[3 * 65]); o.z = pk2(s[4 * 65], s[5 * 65]); o.w = pk2(s[6 * 65], s[7 * 65]);
        *(v4u*)(dst + (size_t)n * ldd + 8 * c) = o; }
    LDS_WAIT(); asm volatile("" ::: "memory");
}
__device__ __forceinline__ void tr_item8(const float* W, int N, int k0, int n0, unsigned char* dst, int ldd, float scale, LAS float* scr, int lane) {
    const float* src = W + (size_t)(k0 + (lane >> 4)) * N + n0 + 4 * (lane & 15);
    f32x4 v[16];
#pragma unroll
    for (int i = 0; i < 16; ++i) v[i] = *(const f32x4*)(src + (size_t)(4 * i) * N);
#pragma unroll
    for (int i = 0; i < 16; ++i) { LAS float* p = scr + (4 * i + (lane >> 4)) * 65 + 4 * (lane & 15); p[0] = v[i].x * scale; p[1] = v[i].y * scale; p[2] = v[i].z * scale; p[3] = v[i].w * scale; }
    LDS_WAIT(); asm volatile("" ::: "memory");
    const int c = lane & 3;
#pragma unroll
    for (int q = 0; q < 4; ++q) { const int n = (lane >> 2) + 16 * q; const LAS float* s = scr + (16 * c) * 65 + n;
        v4u o; o.x = pg8::pk4_fp8(s[0 * 65], s[1 * 65], s[2 * 65], s[3 * 65]); o.y = pg8::pk4_fp8(s[4 * 65], s[5 * 65], s[6 * 65], s[7 * 65]);
        o.z = pg8::pk4_fp8(s[8 * 65], s[9 * 65], s[10 * 65], s[11 * 65]); o.w = pg8::pk4_fp8(s[12 * 65], s[13 * 65], s[14 * 65], s[15 * 65]);
        *(v4u*)(dst + (size_t)n * ldd + 16 * c) = o; }
    LDS_WAIT(); asm volatile("" ::: "memory");
}
template <int MODE> __device__ __forceinline__ void tr_matrix_item8(const float* W, int K, int N, unsigned char* dstbase, float scale, int r, LAS float* scr, int lane) {
    const int nblk = N / 64, kb = r / nblk, nb = r % nblk, k0 = 64 * kb, n0 = 64 * nb;
    int row;
    if (MODE == 0) row = n0;
    else if (MODE == 1) row = 256 * (n0 >> 7) + (n0 & 127);
    else row = 256 * (n0 >> 7) + 128 + (n0 & 127);
    tr_item8(W, N, k0, n0, dstbase + (size_t)row * K + k0, K, scale, scr, lane);
}
template <int MODE> __device__ __forceinline__ void tr_matrix_item(const float* W, int K, int N, bf16* dstbase, int r, LAS float* scr, int lane) {
    const int nblk = N / 64, kb = r / nblk, nb = r % nblk, k0 = 64 * kb, n0 = 64 * nb;
    int row;
    if (MODE == 0) row = n0;
    else if (MODE == 1) row = 256 * (n0 >> 7) + (n0 & 127);
    else if (MODE == 2) row = 256 * (n0 >> 7) + 128 + (n0 & 127);
    else { const int h = n0 >> 8, rr = n0 & 255, map = rr >> 7, d = rr & 127; row = 256 * h + (d < 64 ? map * 64 : 128 + map * 64); }
    tr_item(W, N, k0, n0, dstbase + (size_t)row * K + k0, K, scr, lane);
}
struct TrDesc { const float* src; unsigned char* dst; const float* gain; int N, pitch, f8; float scale; };
__device__ __forceinline__ void tr_load(const TrDesc& d, f32x4 (&v)[16], int lane) {
    const float* s = d.src + (size_t)(lane >> 4) * d.N + 4 * (lane & 15);
#pragma unroll
    for (int i = 0; i < 16; ++i) v[i] = __builtin_nontemporal_load((const f32x4*)(s + (size_t)(4 * i) * d.N));
}
__device__ __forceinline__ void tr_store(const TrDesc& d, const f32x4 (&v)[16], LAS float* scr, int lane) {
    if (d.gain) {
#pragma unroll
        for (int i = 0; i < 16; ++i) { const float gk = d.gain[4 * i + (lane >> 4)] * d.scale; LAS float* p = scr + (4 * i + (lane >> 4)) * 65 + 4 * (lane & 15); p[0] = v[i].x * gk; p[1] = v[i].y * gk; p[2] = v[i].z * gk; p[3] = v[i].w * gk; }
    } else {
#pragma unroll
        for (int i = 0; i < 16; ++i) { LAS float* p = scr + (4 * i + (lane >> 4)) * 65 + 4 * (lane & 15); p[0] = v[i].x * d.scale; p[1] = v[i].y * d.scale; p[2] = v[i].z * d.scale; p[3] = v[i].w * d.scale; }
    }
    LDS_WAIT(); asm volatile("" ::: "memory");
    if (d.f8) {
        const int c = lane & 3;
#pragma unroll
        for (int q = 0; q < 4; ++q) { const int n = (lane >> 2) + 16 * q; const LAS float* s = scr + (16 * c) * 65 + n;
            v4u o; o.x = pg8::pk4_fp8(s[0 * 65], s[1 * 65], s[2 * 65], s[3 * 65]); o.y = pg8::pk4_fp8(s[4 * 65], s[5 * 65], s[6 * 65], s[7 * 65]);
            o.z = pg8::pk4_fp8(s[8 * 65], s[9 * 65], s[10 * 65], s[11 * 65]); o.w = pg8::pk4_fp8(s[12 * 65], s[13 * 65], s[14 * 65], s[15 * 65]);
            __builtin_nontemporal_store(o, (v4u*)(d.dst + (size_t)n * d.pitch + 16 * c)); }
    } else {
        const int c = lane & 7;
#pragma unroll
        for (int q = 0; q < 8; ++q) { const int n = (lane >> 3) + 8 * q; const LAS float* s = scr + (8 * c) * 65 + n;
            v4u o; o.x = pk2(s[0 * 65], s[1 * 65]); o.y = pk2(s[2 * 65], s[3 * 65]); o.z = pk2(s[4 * 65], s[5 * 65]); o.w = pk2(s[6 * 65], s[7 * 65]);
            __builtin_nontemporal_store(o, (v4u*)(d.dst + (size_t)n * d.pitch + 16 * c)); }
    }
    LDS_WAIT(); asm volatile("" ::: "memory");
}
__device__ __forceinline__ void tr_load_w(const TrDesc& d, f32x4 (&v)[16], int lane) {
    const float* s = d.src + (size_t)(lane >> 3) * d.N + 4 * (lane & 7);
#pragma unroll
    for (int i = 0; i < 16; ++i) v[i] = __builtin_nontemporal_load((const f32x4*)(s + (size_t)(8 * i) * d.N));
}
__device__ __forceinline__ void tr_store_w(const TrDesc& d, const f32x4 (&v)[16], LAS float* scr, int lane) {
#pragma unroll
    for (int i = 0; i < 16; ++i) { LAS float* p = scr + (8 * i + (lane >> 3)) * 33 + 4 * (lane & 7); p[0] = v[i].x * d.scale; p[1] = v[i].y * d.scale; p[2] = v[i].z * d.scale; p[3] = v[i].w * d.scale; }
    LDS_WAIT(); asm volatile("" ::: "memory");
    const int c = lane & 7;
#pragma unroll
    for (int q = 0; q < 4; ++q) { const int n = (lane >> 3) + 8 * q; const LAS float* s = scr + (16 * c) * 33 + n;
        v4u o; o.x = pg8::pk4_fp8(s[0 * 33], s[1 * 33], s[2 * 33], s[3 * 33]); o.y = pg8::pk4_fp8(s[4 * 33], s[5 * 33], s[6 * 33], s[7 * 33]);
        o.z = pg8::pk4_fp8(s[8 * 33], s[9 * 33], s[10 * 33], s[11 * 33]); o.w = pg8::pk4_fp8(s[12 * 33], s[13 * 33], s[14 * 33], s[15 * 33]);
        __builtin_nontemporal_store(o, (v4u*)(d.dst + (size_t)n * d.pitch + 16 * c)); }
    LDS_WAIT(); asm volatile("" ::: "memory");
}
__device__ __forceinline__ int tr_row(int mode, int n0) {
    if (mode == 0) return n0;
    if (mode == 1) return 256 * (n0 >> 7) + (n0 & 127);
    if (mode == 2) return 256 * (n0 >> 7) + 128 + (n0 & 127);
    const int h = n0 >> 8, rr = n0 & 255, map = rr >> 7, dd = rr & 127; return 256 * h + (dd < 64 ? map * 64 : 128 + map * 64);
}
__device__ __forceinline__ void sincos_pi(double r, double& s, double& c) {
    const double x2 = r * r;
    double ps = -1.0 / 25852016738884976640000.0;
    ps = ps * x2 + 1.0 / 51090942171709440000.0;  ps = ps * x2 - 1.0 / 121645100408832000.0; ps = ps * x2 + 1.0 / 355687428096000.0; ps = ps * x2 - 1.0 / 1307674368000.0;
    ps = ps * x2 + 1.0 / 6227020800.0; ps = ps * x2 - 1.0 / 39916800.0; ps = ps * x2 + 1.0 / 362880.0; ps = ps * x2 - 1.0 / 5040.0; ps = ps * x2 + 1.0 / 120.0; ps = ps * x2 - 1.0 / 6.0; ps = ps * x2 + 1.0;
    s = ps * r;
    double pc = 1.0 / 1124000727777607680000.0;
    pc = pc * x2 - 1.0 / 2432902008176640000.0; pc = pc * x2 + 1.0 / 6402373705728000.0; pc = pc * x2 - 1.0 / 20922789888000.0; pc = pc * x2 + 1.0 / 87178291200.0;
    pc = pc * x2 - 1.0 / 479001600.0; pc = pc * x2 + 1.0 / 3628800.0; pc = pc * x2 - 1.0 / 40320.0; pc = pc * x2 + 1.0 / 720.0; pc = pc * x2 - 1.0 / 24.0; pc = pc * x2 + 0.5; pc = pc * x2 - 1.0;
    c = -pc;
}
__device__ __forceinline__ void rms_row_bf16(const float* xrow, const float* ga, bf16* oa, const float* gb, bf16* ob, int lane) {
    const f32x4* xr = (const f32x4*)xrow + lane; f32x4 v[8]; float s = 0.f;
#pragma unroll
    for (int j = 0; j < 8; ++j) { v[j] = xr[64 * j]; s += dot4(v[j], v[j]); }
    const float rstd = 1.0f / sqrtf(wave_sum(s) * (1.0f / DM) + NORM_EPS);
#pragma unroll
    for (int j = 0; j < 8; ++j) { const f32x4 g = ((const f32x4*)ga)[lane + 64 * j]; const f32x4 y = v[j] * rstd * g; v2u o; o.x = pk2(y.x, y.y); o.y = pk2(y.z, y.w); ((v2u*)oa)[lane + 64 * j] = o; }
    if (ob) {
#pragma unroll
        for (int j = 0; j < 8; ++j) { const f32x4 g = ((const f32x4*)gb)[lane + 64 * j]; const f32x4 y = v[j] * rstd * g; v2u o; o.x = pk2(y.x, y.y); o.y = pk2(y.z, y.w); ((v2u*)ob)[lane + 64 * j] = o; }
    }
}

template <int W> __device__ __forceinline__ void pool_rows(const float* xc  , const LAS float* rs, const f32x4 gn, const int t0, bf16* mg) {
    f32x4 prev[16];
#pragma unroll
    for (int i = 0; i < 16; ++i) { const int tt = t0 - 16 + i; const bool need = i >= 16 - (W - 1);
        prev[i] = (need && tt >= 0) ? *(const f32x4*)(xc + (size_t)tt * DM) * rs[i - 1 < 0 ? 0 : i - 1] * gn : (f32x4){0.f, 0.f, 0.f, 0.f}; }
    f32x4 sum = {0.f, 0.f, 0.f, 0.f};
#pragma unroll
    for (int i = 16 - (W - 1); i < 16; ++i) sum += prev[i];
    for (int blk = 0; blk < 4; ++blk) {
        f32x4 cur[16];
#pragma unroll
        for (int i = 0; i < 16; ++i) cur[i] = *(const f32x4*)(xc + (size_t)(t0 + 16 * blk + i) * DM) * rs[15 + 16 * blk + i] * gn;
#pragma unroll
        for (int i = 0; i < 16; ++i) { const int t = t0 + 16 * blk + i; sum += cur[i];
            const float inv = 1.0f / (float)((t + 1 < W) ? t + 1 : W); const f32x4 m = sum * inv - cur[i];
            v2u o; o.x = pk2(m.x, m.y); o.y = pk2(m.z, m.w); *(v2u*)(mg + (size_t)(16 * blk + i) * 512) = o;
            sum -= (i - (W - 1) >= 0) ? cur[i - (W - 1) >= 0 ? i - (W - 1) : 0] : prev[(16 + i - (W - 1)) & 15]; }
#pragma unroll
        for (int i = 0; i < 16; ++i) prev[i] = cur[i];
    }
}

struct Args { const void* in[25]; float* out; unsigned char* ws; int ph_lo, ph_hi, li, pad; };
__global__ void __launch_bounds__(NWAVES * 64, 2) yoco_fwd(Args args) {
    extern __shared__ __attribute__((aligned(16))) unsigned char lds[];
    LAS unsigned char* const L = (LAS unsigned char*)lds;
    volatile LAS unsigned* const MISC = (volatile LAS unsigned*)(L + MISC_OFF);
    const int wave = __builtin_amdgcn_readfirstlane((int)threadIdx.x >> 6);
    const int G = gridDim.x, gw = blockIdx.x * NWAVES + wave, NGW = G * NWAVES;
    unsigned char* const ws = args.ws;
    gu32* const ctl = (gu32*)(ws + WS_CTL);
    const float* x = (const float*)args.in[0]; const int* positions = (const int*)args.in[1]; const float* norm_mix_a = (const float*)args.in[2]; const float* pool_w = (const float*)args.in[3];
    const float* pool_scale = (const float*)args.in[4]; const float* norm_kv = (const float*)args.in[5]; const float* w_k = (const float*)args.in[6]; const float* w_v = (const float*)args.in[7];
    const float* norm_mix_b = (const float*)args.in[8]; const float* w_q = (const float*)args.in[9]; const float* lq1 = (const float*)args.in[10]; const float* lk1 = (const float*)args.in[11];
    const float* lq2 = (const float*)args.in[12]; const float* lk2 = (const float*)args.in[13]; const float* subln_w = (const float*)args.in[14]; const float* w_o = (const float*)args.in[15];
    const float* norm_ffn = (const float*)args.in[16]; const float* d_gate = (const float*)args.in[17]; const float* d_up = (const float*)args.in[18]; const float* d_down = (const float*)args.in[19];
    const float* router_w = (const float*)args.in[20]; const float* m_gate = (const float*)args.in[21]; const float* m_up = (const float*)args.in[22]; const float* m_down = (const float*)args.in[23];
    const float* norm_final = (const float*)args.in[24];
    float* SS1 = (float*)(ws + WS_SS1); float* SS2 = (float*)(ws + WS_SS2); float* RS1 = (float*)(ws + WS_RS1); i32x4* TOKI = (i32x4*)(ws + WS_TOKI); f32x2* TOKG = (f32x2*)(ws + WS_TOKG); float* ROPE = (float*)(ws + WS_ROPE);
    bf16* WPOOL = (bf16*)(ws + WS_WPOOL); bf16* WKVQ = (bf16*)(ws + WS_WKVQ); bf16* WO = (bf16*)(ws + WS_WO); bf16* WGU = (bf16*)(ws + WS_WGU); bf16* WD = (bf16*)(ws + WS_WD);
    unsigned char* WEGU8 = ws + WS_WEGU; unsigned char* WED8 = ws + WS_WED; float* X1 = (float*)(ws + WS_X1); bf16* HB = (bf16*)(ws + WS_H);
    bf16* HID = (bf16*)(ws + WS_HID); bf16* MG = (bf16*)(ws + WS_MG); bf16* H2 = (bf16*)(ws + WS_H2); bf16* K16 = (bf16*)(ws + WS_K16); bf16* V16 = (bf16*)(ws + WS_V16); bf16* Q16 = (bf16*)(ws + WS_Q16);
    bf16* O16 = (bf16*)(ws + WS_O32); bf16* ON = (bf16*)(ws + WS_ON); unsigned char* HIDE8 = ws + WS_HIDE; unsigned char* XG8 = ws + WS_XG; bf16* YB = (bf16*)(ws + WS_Y); float* YPART = (float*)(ws + WS_YPART);

    for (int u = threadIdx.x; u < (LDS_BYTES - LDSCTL_OFF) / 4; u += NWAVES * 64) ((LAS unsigned*)(L + LDSCTL_OFF))[u] = 0u;
    __syncthreads();
    XcdBarrier bar; bar.bar = (unsigned*)(ctl + CW_BAR); bar.x = 0; bar.st = nullptr; bar.w = wave;
    if (N_LAUNCHES == 1) bar = xcd_barrier_post((unsigned*)(ctl + CW_BAR), MISC + 8, wave);
#define GRID_BAR(seam) do { if (N_LAUNCHES != 1) { if (wave == 0 && fresh_lane() == 0) __hip_atomic_store(ctl + CW_TMO, 0xBADBA0u | (unsigned)(seam), RLX_AGENT); } else { xcd_barrier(bar); } } while (0)
    const int lo = args.ph_lo, hi = args.ph_hi;
#define FRESH_TID() const int lane = fresh_lane(), tid = wave * 64 + lane; (void)tid; (void)lane
#define IN(k) (lo <= (k) && (k) < hi)
#define BOTH(k) (IN(k) && IN((k) + 1))
#ifndef PROBE_REP_PHASE
#define PROBE_REP_PHASE -1
#endif
#define REPN(k) ((k) == PROBE_REP_PHASE ? 2 : 1)
#define SMALLREP_N(id_) for (int rep_ = 0; rep_ < ((PROBE_REP_PHASE == 100 || PROBE_REP_PHASE == (id_)) ? 2 : 1); ++rep_)

    constexpr int I_POOL = 64, I_SQ = 32 * 32, I_DG = 32 * 88, I_DD = 88 * 32, I_EG = 32 * 112, I_ED = 112 * 32;
    constexpr int N_EARLY = 4 * I_POOL + 4 * I_SQ + 2 * I_DG + I_DD, N_MOE = 16 * I_EG + 8 * I_ED, NITEMS = N_EARLY + N_MOE;
#define TR_SET(W_, K_, N_, DST_, MODE_, F8_, SC_, GAIN_, R_) do { const int nblk_ = (N_) / 64, kb_ = (R_) / nblk_, nb_ = (R_) % nblk_, k0_ = 64 * kb_, n0_ = 64 * nb_; const int es_ = (F8_) ? 1 : 2; \
        d_.src = (W_) + (size_t)k0_ * (N_) + n0_; d_.N = (N_); d_.pitch = (K_) * es_; d_.f8 = (F8_); d_.scale = (SC_); d_.gain = (GAIN_) ? (const float*)(GAIN_) + k0_ : nullptr; d_.dst = (unsigned char*)(DST_) + ((size_t)tr_row(MODE_, n0_) * (K_) + k0_) * es_; } while (0)
#define TR_DECODE(it_) do { int r = (it_) % NITEMS; \
        if (r < 4 * I_POOL) { const int g = r / I_POOL; TR_SET(pool_w + (size_t)g * 512 * 512, 512, 512, WPOOL + (size_t)g * 512 * 512, 0, 0, 1.0f, (const float*)nullptr, r % I_POOL); break; } r -= 4 * I_POOL; \
        if (r < I_SQ) { TR_SET(w_k, DM, DM, WKVQ, 3, 0, 1.0f, norm_kv, r); break; } r -= I_SQ; \
        if (r < I_SQ) { TR_SET(w_v, DM, DM, WKVQ + (size_t)2048 * DM, 0, 0, 1.0f, norm_kv, r); break; } r -= I_SQ; \
        if (r < I_SQ) { TR_SET(w_q, DM, DM, WKVQ + (size_t)4096 * DM, 3, 0, 1.0f, norm_mix_b, r); break; } r -= I_SQ; \
        if (r < I_SQ) { TR_SET(w_o, DM, DM, WO, 0, 0, 1.0f, (const float*)nullptr, r); break; } r -= I_SQ; \
        if (r < I_DG) { TR_SET(d_gate, DM, FF, WGU, 1, 1, SW_GUD, norm_ffn, r); break; } r -= I_DG; \
        if (r < I_DG) { TR_SET(d_up, DM, FF, WGU, 2, 1, SW_GUD, norm_ffn, r); break; } r -= I_DG; \
        if (r < I_DD) { TR_SET(d_down, FF, DM, WD, 0, 0, 1.0f, (const float*)nullptr, r); break; } r -= I_DD; \
        if (r < 8 * I_EG) { const int e = r / I_EG; TR_SET(m_gate + (size_t)e * DM * DE, DM, DE, WEGU8 + (size_t)e * 2 * DE * DM, 1, 1, SW_GU, (const float*)nullptr, r % I_EG); break; } r -= 8 * I_EG; \
        if (r < 8 * I_EG) { const int e = r / I_EG; TR_SET(m_up + (size_t)e * DM * DE, DM, DE, WEGU8 + (size_t)e * 2 * DE * DM, 2, 1, SW_GU, (const float*)nullptr, r % I_EG); break; } r -= 8 * I_EG; \
        { const int e = r / I_ED; TR_SET(m_down + (size_t)e * DE * DM, DE, DM, WED8 + (size_t)e * DM * DE, 0, 1, SW_D, (const float*)nullptr, r % I_ED); } } while (0)
#define TR_RUN_XG(DEC_, LD_, ST_, SCRB_, first_, end_, stride_) do { const int ln_ = fresh_lane(); LAS float* scr = (LAS float*)(L + wave * (SCRB_)); const int NIT_ = (end_), st_ = (stride_); TrDesc dA, dB; f32x4 vA[16], vB[16]; int it = (first_); \
        if (it < NIT_) { { TrDesc& d_ = dA; DEC_(it); } LD_(dA, vA, ln_); \
            for (;;) { int nx = it + st_; bool has = nx < NIT_; \
                { TrDesc& d_ = dB; DEC_(has ? nx : it); } LD_(dB, vB, ln_); \
                ST_(dA, vA, scr, ln_); \
                if (!has) break; \
                it = nx; nx = it + st_; has = nx < NIT_; \
                { TrDesc& d_ = dA; DEC_(has ? nx : it); } LD_(dA, vA, ln_); \
                ST_(dB, vB, scr, ln_); \
                if (!has) break; \
                it = nx; } } } while (0)
#define TR_RUN_X(DEC_, first_, end_, stride_) TR_RUN_XG(DEC_, tr_load, tr_store, 16640, first_, end_, stride_)
#define TR_RUN(first_, end_, stride_) TR_RUN_X(TR_DECODE, first_, end_, stride_)
#define TR_SET_W(W_, K_, N_, DST_, MODE_, SC_, R_) do { const int nblk_ = (N_) / 32, kb_ = (R_) / nblk_, nb_ = (R_) % nblk_, k0_ = 128 * kb_, n0_ = 32 * nb_; \
        const int row_ = tr_row(MODE_, n0_);     \
        d_.src = (W_) + (size_t)k0_ * (N_) + n0_; d_.N = (N_); d_.pitch = 128; d_.f8 = 1; d_.scale = (SC_); d_.gain = nullptr; d_.dst = (unsigned char*)(DST_) + ((size_t)((row_ >> 8) * ((K_) / 128) + kb_) * 256 + (row_ & 255)) * 128; } while (0)
#define TR_DECODE_MOE(it_) do { int r = ((it_) - N_EARLY) % N_MOE; \
        if (r < 8 * I_EG) { const int e = r / I_EG; TR_SET_W(m_gate + (size_t)e * DM * DE, DM, DE, WEGU8 + (size_t)e * 2 * DE * DM, 1, SW_GU, r % I_EG); break; } r -= 8 * I_EG; \
        if (r < 8 * I_EG) { const int e = r / I_EG; TR_SET_W(m_up + (size_t)e * DM * DE, DM, DE, WEGU8 + (size_t)e * 2 * DE * DM, 2, SW_GU, r % I_EG); break; } r -= 8 * I_EG; \
        { const int e = r / I_ED; TR_SET_W(m_down + (size_t)e * DE * DM, DE, DM, WED8 + (size_t)e * DM * DE, 0, SW_D, r % I_ED); } } while (0)
    if (IN(1)) { FRESH_TID();
        SMALLREP_N(101) for (int rc = blockIdx.x; rc < S_ / 64; rc += G) {
            const int t0 = rc * 64;
            LAS float* rs = (LAS float*)(L + 135168);
            for (int jr = wave; jr < 79; jr += NWAVES) { const int tt = t0 - 15 + jr;
                if (tt >= 0) { const f32x4* xr = (const f32x4*)(x + (size_t)tt * DM) + lane; float s = 0.f;
#pragma unroll
                    for (int j = 0; j < 8; ++j) { const f32x4 v = xr[64 * j]; s += dot4(v, v); }
                    s = wave_sum(s); if (lane == 0) rs[jr] = 1.0f / sqrtf(s * (1.0f / DM) + NORM_EPS); } }
            __syncthreads();
            const int c = 4 * tid, g = c >> 9;
            const f32x4 gn = *(const f32x4*)(norm_mix_a + c);
            bf16* mg = MG + ((size_t)g * S_ + t0) * 512 + (c & 511);
            if (g == 0) pool_rows<2>(x + c, rs, gn, t0, mg); else if (g == 1) pool_rows<4>(x + c, rs, gn, t0, mg); else if (g == 2) pool_rows<8>(x + c, rs, gn, t0, mg); else pool_rows<16>(x + c, rs, gn, t0, mg);
            __syncthreads();
        }
        SMALLREP_N(102) for (int idx = blockIdx.x * 512 + tid; idx < S_ * 64; idx += G * 512) {
            const int t = idx >> 6, i = idx & 63;
            double f = 1.0; for (int k = 0; k < i; ++k) f *= 0.8659643233600653;
            const float ang = (float)positions[t] * (float)f;
            const double a = (double)ang, kk = __builtin_rint(a * 0.15915494309189535), r = __builtin_fma(-kk, 6.283185307179586, a);
            double sn, cs; sincos_pi(r, sn, cs);
            f32x2 o; o.x = (float)cs; o.y = (float)sn; ((f32x2*)ROPE)[idx] = o;
        }
        TR_RUN(gw, N_EARLY * REPN(1), NGW);
        if (BOTH(1)) GRID_BAR(1);
    }
    if (IN(2)) { FRESH_TID();
        pg8::GemmOrder S; S.init(S_ / 256, 8, G, (int)blockIdx.x, MG, WPOOL, 512, 1, (size_t)S_ * 512 * 2);
        pg8::EpiResF32N E{x, X1, DM, pool_scale, nullptr, SS1, (LAS float*)(L + RING_BYTES), 1.0f, (unsigned char*)HB, SA_XD};
        pg8::gemm_phase<pg8::EpiResF32N, pg8::GemmOrder, true, true>(L, 512 * 2, S, E, wave);
        if (BOTH(2)) GRID_BAR(2);
    }
    if (IN(4)) { FRESH_TID();
        pg8::GemmOrder S; S.init(S_ / 256, 2 * FF / 256, G, (int)blockIdx.x, HB, WGU, DM / 2, 30, 0); S.rep = REPN(4);
        pg8::EpiSwiGLU E{HID, FF, SS1, 1.0f / DM, NORM_EPS, 1.0f / (SA_XD * SW_GUD)};
        pg8::gemm_phase<pg8::EpiSwiGLU, pg8::GemmOrder, true, true, true>(L, DM, S, E, wave);
        if (BOTH(4)) GRID_BAR(4);
    }
    if (IN(5)) { FRESH_TID();
        pg8::GemmOrder S; S.init(S_ / 256, DM / 256, G, (int)blockIdx.x, HID, WD, FF, 30, 0);
        pg8::EpiResF32N E{X1, X1, DM, nullptr, HB, SS2, (LAS float*)(L + RING_BYTES), 1.0f, nullptr, 0.f};
        pg8::gemm_phase<pg8::EpiResF32N, pg8::GemmOrder, true, true>(L, FF * 2, S, E, wave);
        if (BOTH(5)) GRID_BAR(5);
    }
    if (IN(7)) { FRESH_TID();
        pg8::GemmOrder S; S.init(S_ / 256, 24, G, (int)blockIdx.x, HB, WKVQ, DM, 30, 0); S.rep = REPN(7);
        pg8::EpiKVQ E{K16, V16, Q16, ROPE, S_, SS2, 1.0f / DM, NORM_EPS};
        pg8::gemm_phase<pg8::EpiKVQ, pg8::GemmOrder, true, true>(L, DM * 2, S, E, wave);
#ifdef PAD_NOPS
        asm volatile(".rept " PAD_NOPS "\n\ts_nop 0\n\t.endr" ::: "memory");
#endif
        if (BOTH(7)) GRID_BAR(7);
    }
    if (IN(8)) { FRESH_TID();
        constexpr int NIT = 512 * REPN(8);
        int moe_chunk = 0;
        for (int Li = blockIdx.x; Li < NIT; Li += G) {
            const int vh = (Li & 7) + 8 * ((Li >> 8) & 1), xp = (Li >> 3) & 31;
            for (int pass = 0; pass < 2; ++pass) {
                const int qb = pass ? xp : 63 - xp;
                attn::Block2 cur;
                cur.Q = (const attn::bf16*)Q16 + ((size_t)vh * S_ + (size_t)qb * 256) * 128; cur.K = (const attn::bf16*)K16 + (size_t)vh * S_ * 128;
                cur.V = (const attn::bf16*)V16 + (size_t)(vh >> 1) * S_ * 256; cur.O = O16 + ((size_t)vh * S_ + (size_t)qb * 256) * 256; cur.P0 = qb * 256;
                attn::attn_block2(cur, (char*)lds, L, wave);
                if (pass == 0 && moe_chunk < 2) {
                    const int per_ = (N_MOE + NGW - 1) / NGW, half_ = (per_ + 1) / 2, end_ = N_EARLY + NGW * half_ * (moe_chunk + 1);
                    TR_RUN_XG(TR_DECODE_MOE, tr_load_w, tr_store_w, 17408, N_EARLY + gw + NGW * half_ * moe_chunk, end_ < NITEMS ? end_ : NITEMS, NGW);
                    ++moe_chunk; __syncthreads();
                }
            }
        }
        for (; moe_chunk < 2; ++moe_chunk) {
            const int per_ = (N_MOE + NGW - 1) / NGW, half_ = (per_ + 1) / 2, end_ = N_EARLY + NGW * half_ * (moe_chunk + 1);
            TR_RUN_XG(TR_DECODE_MOE, tr_load_w, tr_store_w, 17408, N_EARLY + gw + NGW * half_ * moe_chunk, end_ < NITEMS ? end_ : NITEMS, NGW); __syncthreads();
        }
        if (BOTH(8)) GRID_BAR(8);
    }
    if (IN(9)) { FRESH_TID();
        const float s1 = wave_sum(lq1[lane] * lk1[lane] + lq1[lane + 64] * lk1[lane + 64]), s2 = wave_sum(lq2[lane] * lk2[lane] + lq2[lane + 64] * lk2[lane + 64]);
        const float lam = expf(s1) - expf(s2) + LAMBDA_INIT;
        const f32x4 sw = *(const f32x4*)(subln_w + 4 * lane) * (1.0f - LAMBDA_INIT);
#define P9_LOAD(m_) do { _Pragma("unroll") for (int h = 0; h < NHEAD; ++h) { \
            u1[h] = __builtin_nontemporal_load((const v2u*)(O16 + ((size_t)(h * 2) * S_ + (m_)) * 256 + 4 * lane)); u2[h] = __builtin_nontemporal_load((const v2u*)(O16 + ((size_t)(h * 2 + 1) * S_ + (m_)) * 256 + 4 * lane)); } } while (0)
        SMALLREP_N(103) { v2u u1[NHEAD], u2[NHEAD];
            if (gw < S_) P9_LOAD(gw);
            for (int m = gw; m < S_; m += NGW) {
                f32x4 o[NHEAD]; float ss[NHEAD];
#pragma unroll
                for (int h = 0; h < NHEAD; ++h) {
                    const f32x4 o1 = {__uint_as_float(u1[h].x << 16), __uint_as_float(u1[h].x & 0xffff0000u), __uint_as_float(u1[h].y << 16), __uint_as_float(u1[h].y & 0xffff0000u)};
                    const f32x4 o2 = {__uint_as_float(u2[h].x << 16), __uint_as_float(u2[h].x & 0xffff0000u), __uint_as_float(u2[h].y << 16), __uint_as_float(u2[h].y & 0xffff0000u)};
                    o[h] = o1 - lam * o2; ss[h] = dot4(o[h], o[h]); }
                { const int mn = m + NGW; const int ml = mn < S_ ? mn : m; P9_LOAD(ml); }
#pragma unroll
                for (int off = 1; off < 64; off <<= 1) { float t[NHEAD];
#pragma unroll
                    for (int h = 0; h < NHEAD; ++h) t[h] = __shfl_xor(ss[h], off);
#pragma unroll
                    for (int h = 0; h < NHEAD; ++h) ss[h] += t[h]; }
#pragma unroll
                for (int h = 0; h < NHEAD; ++h) {
                    const float r = 1.0f / sqrtf(ss[h] * (1.0f / 256.0f) + SUBLN_EPS);
                    const f32x4 y = o[h] * r * sw; v2u w; w.x = pk2(y.x, y.y); w.y = pk2(y.z, y.w);
                    *(v2u*)(ON + (size_t)m * DM + h * 256 + 4 * lane) = w; }
            }
        }
#undef P9_LOAD
        if (BOTH(9)) GRID_BAR(9);
    }
    if (IN(10)) { FRESH_TID();
        pg8::GemmOrder S; S.init(S_ / 256, DM / 256, G, (int)blockIdx.x, ON, WO, DM, 30, 0);
        pg8::EpiResF32 E{X1, X1, DM, nullptr};
        pg8::gemm_phase<pg8::EpiResF32, pg8::GemmOrder, true, true>(L, DM * 2, S, E, wave);
        if (BOTH(10)) GRID_BAR(10);
    }
    if (IN(11)) { FRESH_TID();
        LAS float* rw = (LAS float*)L;
        LAS int* lcnt = (LAS int*)(L + 65536); LAS int* gbase = lcnt + 8; LAS int* rinfo = lcnt + 16;
        LAS float* rgate = (LAS float*)(L + 65536 + 64 + 1024);
        LAS float* rsd = rgate + 128;
        LAS int* part = (LAS int*)(L + 65536 + 4096);
        gu32* bcnt = ctl + CW_BC;
        for (int i = tid; i < DM * NE / 4; i += NWAVES * 64) ((LAS f32x4*)rw)[i] = ((const f32x4*)router_w)[i];
        __syncthreads();
        const float* gn = norm_ffn + DM;
        for (int rb = blockIdx.x; rb < S_ / 64; rb += G) {
            float xv[32];
            { const float* xr0 = X1 + (size_t)(rb * 64 + wave * 8) * DM + lane;
#pragma unroll
              for (int i = 0; i < 32; ++i) xv[i] = xr0[64 * i]; }
            for (int rr = 0; rr < 8; ++rr) {
                const int row = rb * 64 + wave * 8 + rr;
                float xn[32];
                { const float* xr1 = X1 + (size_t)(rr < 7 ? row + 1 : row) * DM + lane;
#pragma unroll
                  for (int i = 0; i < 32; ++i) xn[i] = xr1[64 * i]; }
                float red[9] = {0.f, 0.f, 0.f, 0.f, 0.f, 0.f, 0.f, 0.f, 0.f};
#pragma unroll
                for (int i = 0; i < 32; ++i) { red[8] += xv[i] * xv[i]; const float hv = xv[i] * gn[lane + 64 * i]; const LAS f32x4* wp = (const LAS f32x4*)(rw + (lane + 64 * i) * 8); const f32x4 w0 = wp[0], w1 = wp[1];
                    red[0] += hv * w0.x; red[1] += hv * w0.y; red[2] += hv * w0.z; red[3] += hv * w0.w; red[4] += hv * w1.x; red[5] += hv * w1.y; red[6] += hv * w1.z; red[7] += hv * w1.w; }
#pragma unroll
                for (int off = 1; off < 64; off <<= 1) { float t[9];
#pragma unroll
                    for (int e = 0; e < 9; ++e) t[e] = __shfl_xor(red[e], off);
#pragma unroll
                    for (int e = 0; e < 9; ++e) red[e] += t[e]; }
                const float rstd = 1.0f / sqrtf(red[8] * (1.0f / DM) + NORM_EPS);
                float lg[8];
#pragma unroll
                for (int e = 0; e < 8; ++e) lg[e] = red[e] * rstd;
#pragma unroll
                for (int i = 0; i < 32; ++i) xv[i] = xn[i];
                int e1 = 0; float l1 = lg[0];
#pragma unroll
                for (int e = 1; e < 8; ++e) if (lg[e] > l1) { l1 = lg[e]; e1 = e; }
                int e2 = -1; float l2 = -__builtin_inff();
#pragma unroll
                for (int e = 0; e < 8; ++e) if (e != e1 && lg[e] > l2) { l2 = lg[e]; e2 = e; }
                const float ex = expf(l2 - l1), g1 = 1.0f / (1.0f + ex), g2 = ex / (1.0f + ex);
                if (lane == 0) { const int q = wave * 8 + rr; rinfo[q * 4 + 0] = e1; rinfo[q * 4 + 2] = e2; rgate[q * 2] = g1; rgate[q * 2 + 1] = g2; rsd[q] = rstd; }
            }
            __syncthreads();
            if (tid < 8) { int c = 0; for (int q = 0; q < 64; ++q) c += (rinfo[q * 4] == tid ? 1 : 0) + (rinfo[q * 4 + 2] == tid ? 1 : 0); __hip_atomic_store(bcnt + rb * 8 + tid, (unsigned)c, RLX_AGENT); }
            if (tid < 64) { const int row = rb * 64 + tid; int r1 = 0, r2 = 0; const int e1 = rinfo[tid * 4], e2 = rinfo[tid * 4 + 2];
                for (int q = 0; q < tid; ++q) { const int a1 = rinfo[q * 4], a2 = rinfo[q * 4 + 2]; r1 += (a1 == e1 ? 1 : 0) + (a2 == e1 ? 1 : 0); r2 += (a1 == e2 ? 1 : 0) + (a2 == e2 ? 1 : 0); }
                i32x4 ti; ti.x = e1; ti.y = r1; ti.z = e2; ti.w = r2; TOKI[row] = ti; f32x2 tg; tg.x = rgate[tid * 2]; tg.y = rgate[tid * 2 + 1]; TOKG[row] = tg; RS1[row] = rsd[tid]; }
            __syncthreads();
        }
        if (N_LAUNCHES == 1) xcd_barrier(bar);
        for (int rb = blockIdx.x; rb < S_ / 64; rb += G) {
            { const int e = tid & 7, ch = tid >> 3; int c = 0;
              for (int j = 0; j < 4; ++j) { const int rb2 = ch * 4 + j; if (rb2 < rb) c += (int)__hip_atomic_load(bcnt + rb2 * 8 + e, RLX_AGENT); }
              part[ch * 8 + e] = c; }
            __syncthreads();
            if (tid < 8) { int c = 0; for (int ch = 0; ch < 64; ++ch) c += part[ch * 8 + tid]; gbase[tid] = c;
                if (rb == S_ / 64 - 1) __hip_atomic_store(ctl + CW_CNT + 64 * tid, (unsigned)(c + (int)__hip_atomic_load(bcnt + rb * 8 + tid, RLX_AGENT)), RLX_AGENT); }
            __syncthreads();
            if (tid < 64) { const int row = rb * 64 + tid; i32x4 ti = TOKI[row]; ti.y += gbase[ti.x]; ti.w += gbase[ti.z]; TOKI[row] = ti; rinfo[tid * 4] = ti.x; rinfo[tid * 4 + 1] = ti.y; rinfo[tid * 4 + 2] = ti.z; rinfo[tid * 4 + 3] = ti.w; rsd[tid] = RS1[row]; }
            __syncthreads();
            f32x4 xc[8];
            { const f32x4* x0 = (const f32x4*)(X1 + (size_t)(rb * 64 + wave * 8) * DM) + lane;
#pragma unroll
              for (int j = 0; j < 8; ++j) xc[j] = x0[64 * j]; }
            for (int rr = 0; rr < 8; ++rr) {
                const int q = wave * 8 + rr, row = rb * 64 + q; const int e1 = rinfo[q * 4], e2 = rinfo[q * 4 + 2]; const int sl1 = rinfo[q * 4 + 1], sl2 = rinfo[q * 4 + 3]; const float rstd = rsd[q];
                f32x4 xnx[8];
                { const f32x4* x1p = (const f32x4*)(X1 + (size_t)(rr < 7 ? row + 1 : row) * DM) + lane;
#pragma unroll
                  for (int j = 0; j < 8; ++j) xnx[j] = x1p[64 * j]; }
                unsigned char* o1 = XG8 + (size_t)e1 * S_ * DM + ((size_t)((sl1 >> 8) * 16 + (lane >> 5)) * 256 + (sl1 & 255)) * 128 + 4 * (lane & 31); unsigned char* o2 = XG8 + (size_t)e2 * S_ * DM + ((size_t)((sl2 >> 8) * 16 + (lane >> 5)) * 256 + (sl2 & 255)) * 128 + 4 * (lane & 31);
#pragma unroll
                for (int j = 0; j < 8; ++j) { const f32x4 y = xc[j] * (rstd * SA_X) * ((const f32x4*)gn)[lane + 64 * j]; const unsigned o = pg8::pk4_fp8(y.x, y.y, y.z, y.w); *(unsigned*)(o1 + (size_t)j * 65536) = o; *(unsigned*)(o2 + (size_t)j * 65536) = o; }
#pragma unroll
                for (int j = 0; j < 8; ++j) xc[j] = xnx[j];
            }
            __syncthreads();
        }
        if (BOTH(11)) GRID_BAR(11);
    }
#define MOE_TS(ts_) do { int tot_ = 0; _Pragma("unroll") for (int e_ = 0; e_ < 8; ++e_) { const int c_ = __builtin_amdgcn_readfirstlane((int)__hip_atomic_load(ctl + CW_CNT + 64 * e_, RLX_AGENT)); (ts_)[e_] = tot_; tot_ += (c_ + 255) >> 8; } (ts_)[8] = tot_; } while (0)
    if (IN(13)) { FRESH_TID();
        pg8::MoeOrder S; MOE_TS(S.ts); S.rep = REPN(13); S.nM = S.ts[8]; S.nN = 2 * DE / 256; S.nwg = S.nM * S.nN; S.G = G; S.c = (int)blockIdx.x;
#ifdef PROBE_P13_CUS
        S.G = PROBE_P13_CUS; if ((int)blockIdx.x >= PROBE_P13_CUS) S.nwg = 0;
#endif
        S.A = (const char*)XG8; S.B = (const char*)WEGU8; S.tstepA = (size_t)256 * DM; S.tstepB = (size_t)256 * DM; S.estride = (size_t)2 * DE * DM; S.ecapA = (size_t)S_ * DM;
        pg8::EpiSwiGLU8 E{HIDE8, DE, 1.0f / (SA_X * SW_GU), SA_H, nullptr, 0.f, 0.f};
        pg8::gemm_phase<pg8::EpiSwiGLU8, pg8::MoeOrder, true, true, true>(L, DM, S, E, wave, 0, 1, 1);
        if (BOTH(13)) GRID_BAR(13);
    }
#define MOE_SK(R_) 4
    if (IN(14)) { FRESH_TID();
#ifndef PROBE_NMAIN
#define PROBE_NMAIN 128
#endif
        pg8::MoeOrder S; MOE_TS(S.ts); const int nT = S.ts[8]; const int nMain = PROBE_NMAIN; const bool split = (G == 256) && nT > nMain && REPN(14) == 1;
        S.rep = REPN(14); S.nM = split ? nMain : nT; S.nN = DM / 256; S.nwg = S.nM * S.nN; S.G = G; S.c = (int)blockIdx.x;
        S.A = (const char*)HIDE8; S.B = (const char*)WED8; S.tstepA = (size_t)256 * DE; S.tstepB = (size_t)256 * DE; S.estride = (size_t)DM * DE; S.ecapA = 0;
        pg8::EpiBf16S E{YB, DM, 1.0f / (SA_H * SW_D)};
        pg8::gemm_phase<pg8::EpiBf16S, pg8::MoeOrder, true, true, true>(L, DE, S, E, wave, 0, 1, 1);
        if (split) {
            const int R = nT - nMain, SK = MOE_SK(R);
            pg8::SplitOrder S2; S2.base = nMain; S2.R = R; S2.SK = SK; S2.nsub = 8 * R * SK; S2.G = G; S2.c = (int)blockIdx.x; S2.klen = DE / SK; S2.klenB = (size_t)(S2.klen / 128) * 32768; S2.klenA = S2.klenB;
#pragma unroll
            for (int e_ = 0; e_ < 9; ++e_) S2.ts[e_] = S.ts[e_];
            S2.A = S.A; S2.B = S.B; S2.tstepA = S.tstepA; S2.tstepB = S.tstepB; S2.estride = S.estride;
            pg8::EpiBf16S E2{(bf16*)YPART, DM, 1.0f / (SA_H * SW_D)};
            pg8::gemm_phase<pg8::EpiBf16S, pg8::SplitOrder, true, true, true>(L, DE, S2, E2, wave, S2.klen, 1, 1);
            if ((int)blockIdx.x < S2.nsub) {
                const int sk = (int)blockIdx.x % SK, unit = (int)blockIdx.x / SK, rtl = unit >> 3, pn = unit & 7;
                __syncthreads();
                if (threadIdx.x == 0) {
                    __hip_atomic_fetch_add(ctl + CW_KS + unit, 1u, __ATOMIC_RELEASE, __HIP_MEMORY_SCOPE_AGENT);
                    while (__hip_atomic_load(ctl + CW_KS + unit, __ATOMIC_ACQUIRE, __HIP_MEMORY_SCOPE_AGENT) < (unsigned)SK) __builtin_amdgcn_s_sleep(2);
                }
                __syncthreads();
                const int RS = (256 + SK - 1) / SK, rbeg = sk * RS, rend = rbeg + RS < 256 ? rbeg + RS : 256;
                const int cc = fresh_lane() * 4;
                for (int r = rbeg + wave; r < rend; r += NWAVES) {
                    f32x4 acc = {0.f, 0.f, 0.f, 0.f};
                    for (int k2 = 0; k2 < SK; ++k2) { const v2u u = *(const v2u*)((const bf16*)YPART + ((size_t)(k2 * R + rtl) * 256 + r) * DM + pn * 256 + cc);
                        acc.x += __uint_as_float(u.x << 16); acc.y += __uint_as_float(u.x & 0xffff0000u); acc.z += __uint_as_float(u.y << 16); acc.w += __uint_as_float(u.y & 0xffff0000u); }
                    v2u w; w.x = pk2(acc.x, acc.y); w.y = pk2(acc.z, acc.w);
                    *(v2u*)(YB + ((size_t)(nMain + rtl) * 256 + r) * DM + pn * 256 + cc) = w;
                }
            }
        }
        if (BOTH(14)) GRID_BAR(14);
    }
    if (IN(15)) { FRESH_TID();
        int ts[9]; MOE_TS(ts);
        unsigned poison = __hip_atomic_load(ctl + CW_TMO, RLX_AGENT) | __hip_atomic_load(ctl + CW_BAR + XB_TMO, RLX_AGENT);
#define P15_LOAD(UA, UB, XV, I_) do { const int mc_ = mi_[I_] < S_ ? mi_[I_] : S_ - 1; int t1 = 0, t2 = 0; \
            _Pragma("unroll") for (int e = 0; e < 8; ++e) { t1 = (tis_[I_].x == e) ? ts[e] : t1; t2 = (tis_[I_].z == e) ? ts[e] : t2; } \
            const v2u* y1 = (const v2u*)(YB + (size_t)(256 * t1 + tis_[I_].y) * DM) + lane; const v2u* y2 = (const v2u*)(YB + (size_t)(256 * t2 + tis_[I_].w) * DM) + lane; \
            const f32x4* xr = (const f32x4*)(X1 + (size_t)mc_ * DM) + lane; \
            _Pragma("unroll") for (int j = 0; j < 8; ++j) { UA[j] = __builtin_nontemporal_load(y1 + 64 * j); UB[j] = __builtin_nontemporal_load(y2 + 64 * j); XV[j] = __builtin_nontemporal_load(xr + 64 * j); } } while (0)
#define P15_FIN(UA, UB, XV, I_) do { const bool first_lo = tis_[I_].x < tis_[I_].z; f32x4 v[8]; float s = 0.f; \
            _Pragma("unroll") for (int j = 0; j < 8; ++j) { const v2u ua = UA[j], ub = UB[j]; \
                const f32x4 a = (f32x4){__uint_as_float(ua.x << 16), __uint_as_float(ua.x & 0xffff0000u), __uint_as_float(ua.y << 16), __uint_as_float(ua.y & 0xffff0000u)} * tgs_[I_].x; \
                const f32x4 b = (f32x4){__uint_as_float(ub.x << 16), __uint_as_float(ub.x & 0xffff0000u), __uint_as_float(ub.y << 16), __uint_as_float(ub.y & 0xffff0000u)} * tgs_[I_].y; \
                v[j] = XV[j] + (first_lo ? (a + b) : (b + a)); s += dot4(v[j], v[j]); } \
            float rstd = 1.0f / sqrtf(wave_sum(s) * (1.0f / DM) + NORM_EPS); \
            if (poison) rstd = __builtin_nanf(""); \
            if (mi_[I_] < S_) { f32x4* o = (f32x4*)(args.out + (size_t)mi_[I_] * DM) + lane; \
                _Pragma("unroll") for (int j = 0; j < 8; ++j) __builtin_nontemporal_store(v[j] * rstd * ((const f32x4*)norm_final)[lane + 64 * j], o + 64 * j); } } while (0)
        SMALLREP_N(104) for (int mb = gw; mb < S_; mb += 8 * NGW) {
            int mi_[8]; i32x4 tis_[8]; f32x2 tgs_[8];
#pragma unroll
            for (int i = 0; i < 8; ++i) { mi_[i] = mb + i * NGW; const int mc_ = mi_[i] < S_ ? mi_[i] : S_ - 1; tis_[i] = TOKI[mc_]; tgs_[i] = TOKG[mc_]; }
            v2u ua0[8], ub0[8], ua1[8], ub1[8]; f32x4 xv0[8], xv1[8];
            P15_LOAD(ua0, ub0, xv0, 0);
            P15_LOAD(ua1, ub1, xv1, 1); P15_FIN(ua0, ub0, xv0, 0);
            P15_LOAD(ua0, ub0, xv0, 2); P15_FIN(ua1, ub1, xv1, 1);
            P15_LOAD(ua1, ub1, xv1, 3); P15_FIN(ua0, ub0, xv0, 2);
            P15_LOAD(ua0, ub0, xv0, 4); P15_FIN(ua1, ub1, xv1, 3);
            P15_LOAD(ua1, ub1, xv1, 5); P15_FIN(ua0, ub0, xv0, 4);
            P15_LOAD(ua0, ub0, xv0, 6); P15_FIN(ua1, ub1, xv1, 5);
            P15_LOAD(ua1, ub1, xv1, 7); P15_FIN(ua0, ub0, xv0, 6);
            P15_FIN(ua1, ub1, xv1, 7);
        }
#undef P15_LOAD
#undef P15_FIN
    }
#undef TR_RUN
#undef TR_RUN_X
#undef TR_RUN_XG
#undef TR_SET_W
#undef TR_DECODE_MOE
#undef TR_DECODE
#undef TR_SET
#undef IN
#undef BOTH
#undef GRID_BAR
#undef MOE_TS
}

extern "C" void kernel_launch(void* const* d_in, const int* in_sizes, int n_in, void* d_out, int out_size, void* d_ws, size_t ws_size, hipStream_t stream) {
    static int grid = 0;
    if (grid == 0) {
        if (n_in != 25 || in_sizes[0] != S_ * DM || out_size != S_ * DM || ws_size < WS_END) { fprintf(stderr, "kernel_launch: shape / workspace mismatch (n_in %d, in0 %d, out %d, ws %zu, need %zu); nothing launched\n", n_in, n_in > 0 ? in_sizes[0] : -1, out_size, ws_size, (size_t)WS_END); grid = -1; return; }
        int dev = 0, cus = 0;
        if (hipGetDevice(&dev) != hipSuccess || hipDeviceGetAttribute(&cus, hipDeviceAttributeMultiprocessorCount, dev) != hipSuccess) { fprintf(stderr, "kernel_launch: device query failed\n"); grid = -1; return; }
        if (hipFuncSetAttribute((const void*)yoco_fwd, hipFuncAttributeMaxDynamicSharedMemorySize, LDS_BYTES) != hipSuccess) { fprintf(stderr, "kernel_launch: hipFuncSetAttribute failed\n"); grid = -1; return; }
        int per_cu = 0;
        if (hipOccupancyMaxActiveBlocksPerMultiprocessor(&per_cu, (const void*)yoco_fwd, NWAVES * 64, LDS_BYTES) != hipSuccess || per_cu < 1) { fprintf(stderr, "kernel_launch: occupancy query reports %d workgroups per CU\n", per_cu); }
        (void)hipGetLastError();
        grid = cus;
    }
    if (grid < 0) return;
    if (hipMemsetAsync((char*)d_ws + WS_CTL, 0, CTL_ZERO_BYTES, stream) != hipSuccess) { fprintf(stderr, "kernel_launch: memset failed\n"); return; }
    Args a{};
    for (int i = 0; i < 25; ++i) a.in[i] = d_in[i];
    a.out = (float*)d_out; a.ws = (unsigned char*)d_ws; a.pad = 0;
    if (N_LAUNCHES == 1) { a.ph_lo = 0; a.ph_hi = N_PHASES; a.li = 0; hipLaunchKernelGGL(yoco_fwd, dim3(grid), dim3(NWAVES * 64), LDS_BYTES, stream, a); }
    else { for (int li = 0; li < N_PHASES; ++li) { a.ph_lo = li; a.ph_hi = li + 1; a.li = li; hipLaunchKernelGGL(yoco_fwd, dim3(grid), dim3(NWAVES * 64), LDS_BYTES, stream, a); } }
    const hipError_t le = hipPeekAtLastError();
    if (le != hipSuccess) fprintf(stderr, "kernel_launch: launch failed: %s\n", hipGetErrorName(le));
}
```
